# Optimizing an MI355X kernel written in HIP

```python
import jax, jax.numpy as jnp
from jax import lax
import numpy as np

D_MODEL = 2048
BATCH = 1
SEQ = 8192
DEPTH = 2

GRID_W = 64
CTX_LEN = 256
HEAD_DIM = 128
A_GROUPS = D_MODEL // (4 * HEAD_DIM)
A_GROUP_DIM = HEAD_DIM
A_WIDTH = A_GROUPS * A_GROUP_DIM
CHUNK = 128
B_HEADS = (3 * D_MODEL) // (8 * HEAD_DIM)
B_KV_HEADS = 2
WINDOW = 128
WBLOCK = 128
C_HEADS = (3 * D_MODEL) // (8 * HEAD_DIM)
NA_ROWS = 8
NA_COLS = 16
A_IN = 2 * A_WIDTH
QB_W = B_HEADS * HEAD_DIM
QC_W = C_HEADS * HEAD_DIM
KB_W = B_KV_HEADS * HEAD_DIM
Q_END = A_IN + QB_W + QC_W
IN_WIDTH = Q_END + 2 * KB_W + 2 * QC_W
MIX_WIDTH = A_WIDTH + QB_W + QC_W
FFN_DIM = 7 * D_MODEL // 2
N_EXPERTS = 8
TOP_K = 2
ROPE_BASE = 10000.0
EPS = 1e-6
NEG_INF = -1e30

kernel_name = "hybrid_dit_sgu_swa_natten_moe"


def rms_norm(x, g):
    x32 = x.astype(jnp.float32)
    y = x32 * lax.rsqrt(jnp.mean(x32 * x32, axis=-1, keepdims=True) + EPS)
    return y.astype(x.dtype) * g


def modulate(h, shift, scale):
    return h * (1 + scale) + shift


def rope_1d(x, pos):
    d = x.shape[-1]
    n = d // 2
    inv = ROPE_BASE ** (-(2.0 / d) * jnp.arange(n, dtype=jnp.float32))
    ang = pos.astype(jnp.float32)[:, None] * inv[None, :]
    cos = jnp.cos(ang)[None, :, None, :].astype(x.dtype)
    sin = jnp.sin(ang)[None, :, None, :].astype(x.dtype)
    x1, x2 = x[..., :n], x[..., n:]
    return jnp.concatenate([x1 * cos - x2 * sin, x1 * sin + x2 * cos], axis=-1)


def axial_rope(x, row, col):
    h = x.shape[-1] // 2
    return jnp.concatenate([rope_1d(x[..., :h], row), rope_1d(x[..., h:], col)], axis=-1)


def split_q(p):
    b, t, _ = p.shape
    pa = p[..., :A_IN]
    qb = p[..., A_IN:A_IN + QB_W].reshape(b, t, B_HEADS, HEAD_DIM)
    qc = p[..., A_IN + QB_W:Q_END].reshape(b, t, C_HEADS, HEAD_DIM)
    return pa, qb, qc


def split_kv(p):
    b, t, _ = p.shape
    o = 0
    kb = p[..., o:o + KB_W].reshape(b, t, B_KV_HEADS, HEAD_DIM); o += KB_W
    vb = p[..., o:o + KB_W].reshape(b, t, B_KV_HEADS, HEAD_DIM); o += KB_W
    kc = p[..., o:o + QC_W].reshape(b, t, C_HEADS, HEAD_DIM); o += QC_W
    vc = p[..., o:o + QC_W].reshape(b, t, C_HEADS, HEAD_DIM)
    return kb, vb, kc, vc


def chunk_sgu(p, ln_g, w_s, b_s):
    b, t, _ = p.shape
    z = jax.nn.gelu(p)
    u, v = z[..., :A_WIDTH], z[..., A_WIDTH:]
    v = v.reshape(b, t // CHUNK, CHUNK, A_GROUPS, A_GROUP_DIM)
    v32 = v.astype(jnp.float32)
    mu = jnp.mean(v32, axis=-1, keepdims=True)
    var = jnp.mean(jnp.square(v32 - mu), axis=-1, keepdims=True)
    v = ((v32 - mu) * lax.rsqrt(var + EPS)).astype(p.dtype) * ln_g.reshape(A_GROUPS, A_GROUP_DIM)
    s = jnp.einsum('gij,bnjgc->bnigc', w_s, v) + b_s.T[None, None, :, :, None]
    return u * s.reshape(b, t, A_WIDTH)


def window_attn(q, k, v, k_ctx, v_ctx, sink):
    b, s, h, d = q.shape
    kvh = k.shape[2]
    g = h // kvh
    nb = s // WBLOCK
    lc = k_ctx.shape[1]
    nl = 3 * WBLOCK
    scale = d ** -0.5
    qb = q.reshape(b, nb, WBLOCK, kvh, g, d)

    def band(t):
        tp = jnp.pad(t, ((0, 0), (WBLOCK, WBLOCK), (0, 0), (0, 0))).reshape(b, nb + 2, WBLOCK, kvh, d)
        return jnp.concatenate([tp[:, :-2], tp[:, 1:-1], tp[:, 2:]], axis=2)

    kband, vband = band(k), band(v)
    qi = jnp.arange(WBLOCK)
    kj = jnp.arange(nl)
    rel = (kj[None, :] - WBLOCK) - qi[:, None]
    kpos = (jnp.arange(nb)[:, None] - 1) * WBLOCK + kj[None, :]
    mask = (jnp.abs(rel) <= WINDOW)[None] & ((kpos >= 0) & (kpos < s))[:, None, :]
    s_loc = jnp.einsum('bnqkgd,bnjkd->bnkgqj', qb, kband).astype(jnp.float32) * scale
    s_loc = jnp.where(mask[None, :, None, None], s_loc, NEG_INF)
    s_ctx = jnp.einsum('bnqkgd,blkd->bnkgql', qb, k_ctx).astype(jnp.float32) * scale
    s_sink = jnp.broadcast_to(sink.astype(jnp.float32).reshape(kvh, g)[None, None, :, :, None, None],
                              s_ctx.shape[:-1] + (1,))
    p = jax.nn.softmax(jnp.concatenate([s_loc, s_ctx, s_sink], axis=-1), axis=-1).astype(v.dtype)
    o = (jnp.einsum('bnkgqj,bnjkd->bnqkgd', p[..., :nl], vband)
         + jnp.einsum('bnkgql,blkd->bnqkgd', p[..., nl:nl + lc], v_ctx))
    return o.reshape(b, s, h * d)


def neighborhood_attn(q, k, v, k_ctx, v_ctx, rpb):
    b, s, h, d = q.shape
    rows = s // GRID_W
    kh = min(NA_ROWS, rows)
    scale = d ** -0.5
    qg = q.reshape(b, rows, GRID_W, h, d)
    kg = k.reshape(b, rows, GRID_W, h, d)
    vg = v.reshape(b, rows, GRID_W, h, d)
    r = jnp.arange(rows)
    r0 = jnp.clip(r - kh // 2, 0, rows - kh)
    ridx = r0[:, None] + jnp.arange(kh)[None, :]
    kn = kg[:, ridx]
    vn = vg[:, ridx].reshape(b, rows, kh * GRID_W, h, d)
    cq = jnp.arange(GRID_W)
    c0 = jnp.clip(cq - NA_COLS // 2, 0, GRID_W - NA_COLS)
    cmask = (cq[None, :] >= c0[:, None]) & (cq[None, :] < c0[:, None] + NA_COLS)
    roff = ridx - r[:, None] + (NA_ROWS - 1)
    coff = jnp.clip(cq[None, :] - cq[:, None] + (NA_COLS - 1), 0, 2 * NA_COLS - 2)
    bias = rpb.astype(jnp.float32)[:, roff][..., coff]
    bias = bias.transpose(0, 1, 3, 2, 4)
    s_nb = jnp.einsum('brqhd,brjchd->bhrqjc', qg, kn).astype(jnp.float32) * scale
    s_nb = jnp.where(cmask[None, None, None, :, None, :], s_nb + bias[None], NEG_INF)
    s_nb = s_nb.reshape(b, h, rows, GRID_W, kh * GRID_W)
    s_ctx = jnp.einsum('brqhd,blhd->bhrql', qg, k_ctx).astype(jnp.float32) * scale
    nn_ = kh * GRID_W
    p = jax.nn.softmax(jnp.concatenate([s_nb, s_ctx], axis=-1), axis=-1).astype(v.dtype)
    o = (jnp.einsum('bhrqn,brnhd->brqhd', p[..., :nn_], vn)
         + jnp.einsum('bhrql,blhd->brqhd', p[..., nn_:], v_ctx))
    return o.reshape(b, s, h * d)


def ctx_self_attn(q, k, v, sink):
    b, l, h, d = q.shape
    kvh = k.shape[2]
    g = h // kvh
    qg = q.reshape(b, l, kvh, g, d)
    s = jnp.einsum('bqkgd,bjkd->bkgqj', qg, k).astype(jnp.float32) * (d ** -0.5)
    if sink is not None:
        s_sink = jnp.broadcast_to(sink.astype(jnp.float32).reshape(kvh, g)[None, :, :, None, None],
                                  s.shape[:-1] + (1,))
        s = jnp.concatenate([s, s_sink], axis=-1)
    p = jax.nn.softmax(s, axis=-1)[..., :l].astype(v.dtype)
    o = jnp.einsum('bkgqj,bjkd->bqkgd', p, v)
    return o.reshape(b, l, h * d)


def token_mix(h_lat, h_ctx, w_in, ln_g, sgu_w, sgu_b, sink, rpb, w_out, with_ctx_out):
    b, s, _ = h_lat.shape
    t = jnp.arange(s)
    row, col = t // GRID_W, t % GRID_W
    p_lat = h_lat @ w_in
    pa, qb, qc = split_q(p_lat[..., :Q_END])
    kb, vb, kc, vc = split_kv(p_lat[..., Q_END:])
    qb = axial_rope(qb, row, col)
    kb = axial_rope(kb, row, col)
    if with_ctx_out:
        p_ctx = h_ctx @ w_in
        pa_c, qb_c, qc_c = split_q(p_ctx[..., :Q_END])
        kb_c, vb_c, kc_c, vc_c = split_kv(p_ctx[..., Q_END:])
    else:
        kb_c, vb_c, kc_c, vc_c = split_kv(h_ctx @ w_in[:, Q_END:])
    y_lat = jnp.concatenate([
        chunk_sgu(pa, ln_g, sgu_w, sgu_b),
        window_attn(qb, kb, vb, kb_c, vb_c, sink),
        neighborhood_attn(qc, kc, vc, kc_c, vc_c, rpb),
    ], axis=-1) @ w_out
    y_ctx = None
    if with_ctx_out:
        y_ctx = jnp.concatenate([
            chunk_sgu(pa_c, ln_g, sgu_w, sgu_b),
            ctx_self_attn(qb_c, kb_c, vb_c, sink),
            ctx_self_attn(qc_c, kc_c, vc_c, None),
        ], axis=-1) @ w_out
    return y_lat, y_ctx


def swiglu(h, w_gu, w_down):
    gt, up = jnp.split(h @ w_gu, 2, axis=-1)
    return (jax.nn.silu(gt) * up) @ w_down


def moe_swiglu(h, w_router, w_gu, w_down):
    logits = (h @ w_router).astype(jnp.float32)
    top_v, top_i = lax.top_k(logits, TOP_K)
    weights = jax.nn.softmax(top_v, axis=-1)
    gate = jnp.sum(jax.nn.one_hot(top_i, N_EXPERTS, dtype=jnp.float32) * weights[..., None], axis=-2)
    gate = gate.astype(h.dtype)
    out = jnp.zeros_like(h)
    for e in range(N_EXPERTS):
        out = out + gate[..., e:e + 1] * swiglu(h, w_gu[e], w_down[e])
    return out


def channel_mix(h, l, ffn_w_gu, ffn_w_down, moe_router, moe_w_gu, moe_w_down):
    if l % 2 == 0:
        return swiglu(h, ffn_w_gu[l // 2], ffn_w_down[l // 2])
    return moe_swiglu(h, moe_router[l // 2], moe_w_gu[l // 2], moe_w_down[l // 2])


def setup_inputs(seed: int = 0) -> dict:
    key = jax.random.key(seed)
    ks = jax.random.split(key, 22)
    f32 = jnp.float32
    n_dense = (DEPTH + 1) // 2
    n_moe = DEPTH // 2

    def nrm(k, shape, scale):
        return jax.random.normal(k, shape, f32) * scale

    def gain(k, shape):
        return 1.0 + 0.02 * jax.random.normal(k, shape, f32)

    return {
        "x": nrm(ks[0], (BATCH, SEQ, D_MODEL), 1.0),
        "c": nrm(ks[1], (BATCH, D_MODEL), 1.0),
        "ctx": nrm(ks[2], (BATCH, CTX_LEN, D_MODEL), 1.0),
        "c_ctx": nrm(ks[3], (D_MODEL,), 1.0),
        "w_mod": nrm(ks[4], (DEPTH, D_MODEL, 6 * D_MODEL), D_MODEL ** -0.5),
        "b_mod": nrm(ks[5], (DEPTH, 6 * D_MODEL), 0.02),
        "g_mix_pre": gain(ks[6], (DEPTH, D_MODEL)),
        "g_mix_post": gain(ks[7], (DEPTH, D_MODEL)),
        "g_ffn_pre": gain(ks[8], (DEPTH, D_MODEL)),
        "g_ffn_post": gain(ks[9], (DEPTH, D_MODEL)),
        "w_in": nrm(ks[10], (DEPTH, D_MODEL, IN_WIDTH), D_MODEL ** -0.5),
        "sgu_ln_g": gain(ks[11], (DEPTH, A_WIDTH)),
        "sgu_w": nrm(ks[12], (DEPTH, A_GROUPS, CHUNK, CHUNK), CHUNK ** -0.5),
        "sgu_b": gain(ks[13], (DEPTH, A_GROUPS, CHUNK)),
        "attn_sink": nrm(ks[14], (DEPTH, B_HEADS), 0.5),
        "na_rpb": nrm(ks[15], (DEPTH, C_HEADS, 2 * NA_ROWS - 1, 2 * NA_COLS - 1), 0.1),
        "w_out": nrm(ks[16], (DEPTH, MIX_WIDTH, D_MODEL), MIX_WIDTH ** -0.5),
        "ffn_w_gu": nrm(ks[17], (n_dense, D_MODEL, 2 * FFN_DIM), D_MODEL ** -0.5),
        "ffn_w_down": nrm(ks[18], (n_dense, FFN_DIM, D_MODEL), FFN_DIM ** -0.5),
        "moe_router": nrm(ks[19], (n_moe, D_MODEL, N_EXPERTS), D_MODEL ** -0.5),
        "moe_w_gu": nrm(ks[20], (n_moe, N_EXPERTS, D_MODEL, 2 * FFN_DIM), D_MODEL ** -0.5),
        "moe_w_down": nrm(ks[21], (n_moe, N_EXPERTS, FFN_DIM, D_MODEL), FFN_DIM ** -0.5),
    }


def reference(x, c, ctx, c_ctx, w_mod, b_mod, g_mix_pre, g_mix_post, g_ffn_pre, g_ffn_post,
              w_in, sgu_ln_g, sgu_w, sgu_b, attn_sink, na_rpb, w_out,
              ffn_w_gu, ffn_w_down, moe_router, moe_w_gu, moe_w_down):
    z = ctx
    for l in range(DEPTH):
        last = l == DEPTH - 1
        mod_lat = (jax.nn.silu(c) @ w_mod[l] + b_mod[l])[:, None, :]
        mod_ctx = (jax.nn.silu(c_ctx) @ w_mod[l] + b_mod[l])[None, None, :]
        sh1, sc1, g1, sh2, sc2, g2 = jnp.split(mod_lat, 6, axis=-1)
        sh1c, sc1c, g1c, sh2c, sc2c, g2c = jnp.split(mod_ctx, 6, axis=-1)

        h_lat = modulate(rms_norm(x, g_mix_pre[l]), sh1, sc1)
        h_ctx = modulate(rms_norm(z, g_mix_pre[l]), sh1c, sc1c)
        y_lat, y_ctx = token_mix(h_lat, h_ctx, w_in[l], sgu_ln_g[l], sgu_w[l], sgu_b[l],
                                 attn_sink[l], na_rpb[l], w_out[l], not last)
        x = x + g1 * rms_norm(y_lat, g_mix_post[l])

        h_lat = modulate(rms_norm(x, g_ffn_pre[l]), sh2, sc2)
        x = x + g2 * rms_norm(channel_mix(h_lat, l, ffn_w_gu, ffn_w_down, moe_router, moe_w_gu, moe_w_down),
                              g_ffn_post[l])

        if not last:
            z = z + g1c * rms_norm(y_ctx, g_mix_post[l])
            h_ctx = modulate(rms_norm(z, g_ffn_pre[l]), sh2c, sc2c)
            z = z + g2c * rms_norm(channel_mix(h_ctx, l, ffn_w_gu, ffn_w_down, moe_router, moe_w_gu, moe_w_down),
                                   g_ffn_post[l])
    return x
```

```cpp
#include <hip/hip_runtime.h>
#include <cstdio>
#include <cstdint>
namespace pg8 {
#define PG8_LAS __attribute__((address_space(3)))
typedef unsigned short bf16_t;
typedef short bf16x8 __attribute__((ext_vector_type(8)));
typedef float f32x4 __attribute__((ext_vector_type(4)));
typedef unsigned u32x4 __attribute__((ext_vector_type(4)));
typedef int i32x4 __attribute__((ext_vector_type(4)));
typedef int i32x8 __attribute__((ext_vector_type(8)));
__device__ __forceinline__ bf16x8 as_bf16x8(i32x4 v) { return __builtin_bit_cast(bf16x8, v); }
constexpr int BM = 256, BK = 64, HALF = 128, HTB = HALF * BK * 2  , STAGE_BYTES = 8 * HTB, NXCD = 8, WGM = 8;

__host__ __device__ __forceinline__ int lds_byte(int r, int c) { const int st = (r >> 4) * 2 + (c >> 5), rr = r & 15, cc = c & 31, ob = rr * 64 + cc * 2; return st * 1024 + (ob ^ (((ob >> 9) & 1) << 5)); }
__host__ __device__ __forceinline__ void stage_rc(int b, int& R, int& C) { const int st = b / 1024, sb = b % 1024, swz = sb ^ (((sb >> 9) & 1) << 5); R = (st >> 1) * 16 + swz / 64; C = (st & 1) * 32 + (swz % 64) / 2; }
__host__ __device__ __forceinline__ int perm32(int rho) { const int n = rho >> 4, i = rho & 15; return 8 * (i >> 2) + 4 * n + (i & 3); }

__host__ __device__ __forceinline__ int sigma128(int s) { const int wc = s >> 5, n = (s >> 4) & 1, q4 = s & 15; return 64 * (wc >> 1) + 32 * n + 16 * (wc & 1) + q4; }

struct Unit { int pm, pn, eks, nt; __device__ __host__ __forceinline__ int e() const { return eks & 0xff; } __device__ __host__ __forceinline__ int ks() const { return eks >> 8; } };
struct Gemm { const void* A; const void* Bt; int M, N, K; size_t estride; };

struct StaticOrder {
    int nM, nN, nwg, G, c, ntK;
    __host__ __device__ __forceinline__ void init(int M, int N, int ntK_, int G_, int c_) { nM = M / BM; nN = N / BM; nwg = nM * nN; G = G_; c = c_; ntK = ntK_; }
    __host__ __device__ __forceinline__ bool next(int i, Unit& u) const {
        const long L = (long)i * G + c; if (L >= nwg || c >= G) return false;
        int wgid = (int)L; { const int q = nwg / NXCD, r = nwg % NXCD, xcd = wgid % NXCD, off = wgid / NXCD; wgid = (xcd < r ? xcd * (q + 1) : r * (q + 1) + (xcd - r) * q) + off; }
        const int nig = WGM * nN, gid = wgid / nig, fm = gid * WGM, gsz = (nM - fm) < WGM ? (nM - fm) : WGM;
        u.pm = fm + ((wgid % nig) % gsz); u.pn = (wgid % nig) / gsz; u.eks = 0; u.nt = ntK; return true;
    }
    __device__ __forceinline__ void a_ready(const Unit&) const {}
    __device__ __forceinline__ void done(const Unit&) const {}
};

struct GroupedOrder {
    int nN, nwg, G, c, ntK; const volatile PG8_LAS int* ps;
    __device__ __forceinline__ void init(const int* pstart, volatile PG8_LAS int* tab, int N, int ntK_, int G_, int c_, int plim = 1 << 30) { nN = N / BM; G = G_; c = c_; ntK = ntK_;
        if (threadIdx.x < 9) { const int p = pstart[threadIdx.x]; tab[threadIdx.x] = p < plim ? p : plim; }
        __syncthreads(); ps = tab; nwg = __builtin_amdgcn_readfirstlane(tab[8]) * nN; }
    __device__ __forceinline__ bool next(int i, Unit& u) const {
        const long L = (long)i * G + c; if (L >= nwg) return false;
        int wgid = (int)L; { const int q = nwg / NXCD, r = nwg % NXCD, xcd = wgid % NXCD, off = wgid / NXCD; wgid = (xcd < r ? xcd * (q + 1) : r * (q + 1) + (xcd - r) * q) + off; }
        int e = 0, s0 = 0, np = 1;
#pragma unroll
        for (int k = 0; k < 8; ++k) { const int a = __builtin_amdgcn_readfirstlane(ps[k]), b = __builtin_amdgcn_readfirstlane(ps[k + 1]); if (wgid >= a * nN && wgid < b * nN) { e = k; s0 = a; np = b - a; } }
        const int r = wgid - s0 * nN;
        const int nig = WGM * nN, gid = r / nig, fm = gid * WGM, gsz = (np - fm) < WGM ? (np - fm) : WGM;
        u.pm = s0 + fm + ((r % nig) % gsz); u.pn = (r % nig) / gsz; u.eks = e; u.nt = ntK; return true;
    }
    __device__ __forceinline__ void a_ready(const Unit&) const {}
    __device__ __forceinline__ void done(const Unit&) const {}
};

struct TableOrder {
    const volatile PG8_LAS int* tab;
    template <class Sched> __device__ __forceinline__ void build(const Sched& S, volatile PG8_LAS int* t) {
        if (threadIdx.x < 32) { Unit u; u.pm = 0; u.pn = 0; u.eks = 0; u.nt = 0; const bool ok = S.next((int)threadIdx.x, u);
            t[4 * threadIdx.x + 0] = ok ? u.pm : -1; t[4 * threadIdx.x + 1] = u.pn; t[4 * threadIdx.x + 2] = u.eks; t[4 * threadIdx.x + 3] = u.nt; }
        __syncthreads(); tab = t; }
    __device__ __forceinline__ bool next(int i, Unit& u) const {
        if (i >= 32) return false;
        const i32x4 e = *(const PG8_LAS i32x4*)(tab + 4 * i);
        const int pm = __builtin_amdgcn_readfirstlane(e.x);
        u.pm = pm; u.pn = __builtin_amdgcn_readfirstlane(e.y); u.eks = __builtin_amdgcn_readfirstlane(e.z); u.nt = __builtin_amdgcn_readfirstlane(e.w);
        return pm >= 0; }
    __device__ __forceinline__ void a_ready(const Unit&) const {}
    __device__ __forceinline__ void done(const Unit&) const {}
};

typedef __bf16 bf16v2_t __attribute__((ext_vector_type(2))); typedef float f32v2_t __attribute__((ext_vector_type(2)));
__device__ __forceinline__ unsigned cvt_pk_bf16(float lo, float hi) { const f32v2_t v = {lo, hi}; const bf16v2_t b = __builtin_convertvector(v, bf16v2_t); return __builtin_bit_cast(unsigned, b); }
__device__ __forceinline__ float gelu_tanh(float x) { const float t = x + 0.044715f * x * x * x; const float e = __builtin_amdgcn_exp2f(-2.3022082f * t); return x * __builtin_amdgcn_rcpf(1.0f + e); }
__device__ __forceinline__ float silu_f(float x) { const float e = __builtin_amdgcn_exp2f(-1.44269504f * x); return x * __builtin_amdgcn_rcpf(1.0f + e); }

struct EpiF32 {
    static constexpr int PERM = 0; static constexpr bool AFTER_DRAIN = false;
    float* C; int ldc; float* Cpart; size_t part_stride; int part_row0; float oscale;
    __device__ __forceinline__ void operator()(const f32x4 (&acc)[2][2][4][2], const Unit& u, int wr, int wc, int fr, int fq) const {
        const int row0 = u.pm * BM + wr * 64 + fr, col0 = u.pn * BM + wc * 32 + 4 * fq;
        const int ks = u.ks(); float* base = ks == 0 ? C + (size_t)row0 * ldc : Cpart + (size_t)(ks - 1) * part_stride + (size_t)(row0 - part_row0) * ldc;
#pragma unroll
        for (int ai = 0; ai < 2; ++ai)
#pragma unroll
            for (int m = 0; m < 4; ++m) { float* rowp = base + (size_t)(ai * HALF + m * 16) * ldc + col0;
#pragma unroll
                for (int bj = 0; bj < 2; ++bj)
#pragma unroll
                    for (int n = 0; n < 2; ++n) *(f32x4*)(rowp + bj * HALF + n * 16) = acc[ai][bj][m][n] * oscale; }
    }
};
struct EpiB16 {
    static constexpr int PERM = 1; static constexpr bool AFTER_DRAIN = false;
    bf16_t* C; int ldc; bf16_t* Cpart; size_t part_stride; int part_row0; float oscale;
    __device__ __forceinline__ void operator()(const f32x4 (&acc)[2][2][4][2], const Unit& u, int wr, int wc, int fr, int fq) const {
        const int row0 = u.pm * BM + wr * 64 + fr, col0 = u.pn * BM + wc * 32 + 8 * fq;
        const int ks = u.ks(); bf16_t* base = ks == 0 ? C + (size_t)row0 * ldc : Cpart + (size_t)(ks - 1) * part_stride + (size_t)(row0 - part_row0) * ldc;
#pragma unroll
        for (int ai = 0; ai < 2; ++ai)
#pragma unroll
            for (int m = 0; m < 4; ++m) { bf16_t* rowp = base + (size_t)(ai * HALF + m * 16) * ldc + col0;
#pragma unroll
                for (int bj = 0; bj < 2; ++bj) { const f32x4 v0 = acc[ai][bj][m][0] * oscale, v1 = acc[ai][bj][m][1] * oscale;
                    u32x4 w; w.x = cvt_pk_bf16(v0[0], v0[1]); w.y = cvt_pk_bf16(v0[2], v0[3]); w.z = cvt_pk_bf16(v1[0], v1[1]); w.w = cvt_pk_bf16(v1[2], v1[3]);
                    *(u32x4*)(rowp + bj * HALF) = w; } }
    }
};
struct EpiInProj {
    static constexpr int PERM = 1; static constexpr bool AFTER_DRAIN = false;
    bf16_t* O; int ldc; int gelu_tiles;
    __device__ __forceinline__ void operator()(const f32x4 (&acc)[2][2][4][2], const Unit& u, int wr, int wc, int fr, int fq) const {
        const int row0 = u.pm * BM + wr * 64 + fr, col0 = u.pn * BM + wc * 32 + 8 * fq; const bool act = u.pn < gelu_tiles;
#pragma unroll
        for (int ai = 0; ai < 2; ++ai)
#pragma unroll
            for (int m = 0; m < 4; ++m) { bf16_t* rowp = O + (size_t)(row0 + ai * HALF + m * 16) * ldc + col0;
#pragma unroll
                for (int bj = 0; bj < 2; ++bj) { f32x4 v0 = acc[ai][bj][m][0], v1 = acc[ai][bj][m][1];
                    if (act) {
#pragma unroll
                        for (int j = 0; j < 4; ++j) { v0[j] = gelu_tanh(v0[j]); v1[j] = gelu_tanh(v1[j]); } }
                    u32x4 w; w.x = cvt_pk_bf16(v0[0], v0[1]); w.y = cvt_pk_bf16(v0[2], v0[3]); w.z = cvt_pk_bf16(v1[0], v1[1]); w.w = cvt_pk_bf16(v1[2], v1[3]);
                    *(u32x4*)(rowp + bj * HALF) = w; } }
    }
};
struct EpiSwiGLU {
    static constexpr int PERM = 1; static constexpr bool AFTER_DRAIN = false;
    bf16_t* O; int ldc;
    __device__ __forceinline__ void operator()(const f32x4 (&acc)[2][2][4][2], const Unit& u, int wr, int wc, int fr, int fq) const {
        const int row0 = u.pm * BM + wr * 64 + fr, col0 = u.pn * HALF + wc * 32 + 8 * fq;
#pragma unroll
        for (int ai = 0; ai < 2; ++ai)
#pragma unroll
            for (int m = 0; m < 4; ++m) { bf16_t* rowp = O + (size_t)(row0 + ai * HALF + m * 16) * ldc + col0;
                f32x4 v0, v1;
#pragma unroll
                for (int j = 0; j < 4; ++j) { v0[j] = silu_f(acc[ai][0][m][0][j]) * acc[ai][1][m][0][j]; v1[j] = silu_f(acc[ai][0][m][1][j]) * acc[ai][1][m][1][j]; }
                u32x4 w; w.x = cvt_pk_bf16(v0[0], v0[1]); w.y = cvt_pk_bf16(v0[2], v0[3]); w.z = cvt_pk_bf16(v1[0], v1[1]); w.w = cvt_pk_bf16(v1[2], v1[3]);
                *(u32x4*)rowp = w; }
    }
};

__device__ __forceinline__ float clamp448(float x) { return __builtin_fminf(__builtin_fmaxf(x, -448.f), 448.f); }
__device__ __forceinline__ unsigned pk4_fp8(float a, float b, float c, float d) { int w = 0; w = __builtin_amdgcn_cvt_pk_fp8_f32(clamp448(a), clamp448(b), w, false); w = __builtin_amdgcn_cvt_pk_fp8_f32(clamp448(c), clamp448(d), w, true); return (unsigned)w; }
struct EpiSwiGLU8 {
    static constexpr int PERM = 1; static constexpr bool AFTER_DRAIN = false;
    unsigned char* O; int ldc; float iscale, oscale;
    __device__ __forceinline__ void operator()(const f32x4 (&acc)[2][2][4][2], const Unit& u, int wr, int wc, int fr, int fq) const {
        typedef unsigned u32x2 __attribute__((ext_vector_type(2)));
        const int row0 = u.pm * BM + wr * 64 + fr, col0 = u.pn * HALF + wc * 32 + 8 * fq;
#pragma unroll
        for (int ai = 0; ai < 2; ++ai)
#pragma unroll
            for (int m = 0; m < 4; ++m) { unsigned char* rowp = O + (size_t)(row0 + ai * HALF + m * 16) * ldc + col0;
                f32x4 v0, v1;
#pragma unroll
                for (int j = 0; j < 4; ++j) { v0[j] = silu_f(acc[ai][0][m][0][j] * iscale) * (acc[ai][1][m][0][j] * iscale) * oscale; v1[j] = silu_f(acc[ai][0][m][1][j] * iscale) * (acc[ai][1][m][1][j] * iscale) * oscale; }
                u32x2 w; w.x = pk4_fp8(v0[0], v0[1], v0[2], v0[3]); w.y = pk4_fp8(v1[0], v1[1], v1[2], v1[3]);
                *(u32x2*)rowp = w; }
    }
};
struct EpiInProjRope {
    static constexpr int PERM = 2; static constexpr bool AFTER_DRAIN = false;
    bf16_t* O; int ldc; const float* cosT; const float* sinT; int nlat;
    __device__ __forceinline__ void operator()(const f32x4 (&acc)[2][2][4][2], const Unit& u, int wr, int wc, int fr, int fq) const {
        typedef unsigned u32x2 __attribute__((ext_vector_type(2)));
        const int row0 = u.pm * BM + wr * 64 + fr, col0 = u.pn * BM + 64 * (wc >> 1) + 16 * (wc & 1) + 4 * fq;
        const bool act = u.pn < 4; const bool rope = (u.pn == 4 || u.pn == 5 || u.pn == 6 || u.pn == 10) && (u.pm * BM < nlat);
        const int fi = 16 * (wc & 1) + 4 * fq;
        f32x4 csa[8], sna[8];
#pragma unroll
        for (int q = 0; q < 8; ++q) { csa[q] = (f32x4){1.f, 1.f, 1.f, 1.f}; sna[q] = (f32x4){0.f, 0.f, 0.f, 0.f}; }
        if (rope) {
#pragma unroll
            for (int q = 0; q < 8; ++q) { const int row = row0 + (q >> 2) * HALF + (q & 3) * 16; const int pos = (wc >> 1) ? (row & 63) : (row >> 6); csa[q] = *(const f32x4*)(cosT + pos * 32 + fi); sna[q] = *(const f32x4*)(sinT + pos * 32 + fi); } }
#pragma unroll
        for (int ai = 0; ai < 2; ++ai)
#pragma unroll
            for (int m = 0; m < 4; ++m) { const int row = row0 + ai * HALF + m * 16; bf16_t* rowp = O + (size_t)row * ldc + col0;
                const f32x4 cs = csa[ai * 4 + m], sn = sna[ai * 4 + m];
#pragma unroll
                for (int bj = 0; bj < 2; ++bj) { f32x4 v0 = acc[ai][bj][m][0], v1 = acc[ai][bj][m][1];
                    if (act) {
#pragma unroll
                        for (int j = 0; j < 4; ++j) { v0[j] = gelu_tanh(v0[j]); v1[j] = gelu_tanh(v1[j]); } }
                    const f32x4 o0 = v0 * cs - v1 * sn, o1 = v0 * sn + v1 * cs;
                    u32x2 w0, w1; w0.x = cvt_pk_bf16(o0[0], o0[1]); w0.y = cvt_pk_bf16(o0[2], o0[3]); w1.x = cvt_pk_bf16(o1[0], o1[1]); w1.y = cvt_pk_bf16(o1[2], o1[3]);
                    *(u32x2*)(rowp + bj * HALF) = w0; *(u32x2*)(rowp + bj * HALF + 32) = w1; } }
    }
};
__device__ __forceinline__ int pick_split(int r, int nN, int ntK, int G) {
    int s = 1;
#define PG8_TRY(q) if (ntK % (q) == 0 && ((ntK / (q)) & 1) == 0 && ntK / (q) >= 4 && r * nN * (q) <= G) s = (q)
    PG8_TRY(2); PG8_TRY(4); PG8_TRY(7); PG8_TRY(8); PG8_TRY(14); PG8_TRY(28);
#undef PG8_TRY
    return s;
}
struct DenseSplitOrder {
    StaticOrder so; int nNc, sk, ntsub;
    __device__ __forceinline__ void init(int N, int ntK_, int G_, int c_, int sk_) { so.init(8192, N, ntK_, G_, c_); nNc = N / BM; sk = sk_; ntsub = ntK_ / sk_; }
    __device__ __forceinline__ bool next(int i, Unit& u) const {
        long L = (long)i * so.G + so.c; Unit t; t.pm = 0; t.pn = 0; t.eks = 0; t.nt = 0; bool ok;
        if (L < so.nwg) ok = so.next(i, t);
        else { L -= so.nwg; ok = L < nNc * sk; t.pm = 32; t.pn = (int)(L % nNc); t.eks = (int)(L / nNc) << 8; t.nt = ntsub; }
        u.pm = t.pm; u.pn = t.pn; u.eks = t.eks; u.nt = t.nt; return ok;
    }
    __device__ __forceinline__ void a_ready(const Unit&) const {}
    __device__ __forceinline__ void done(const Unit&) const {}
};
struct GroupedSplitOrder {
    GroupedOrder go; const volatile PG8_LAS int* ps; int Pf, r, sk, ntsub;
    __device__ __forceinline__ void init(const int* pstart, volatile PG8_LAS int* tab  , int N, int ntK_, int G_, int c_) {
        if (threadIdx.x < 9) tab[9 + threadIdx.x] = pstart[threadIdx.x];
        const int P = __builtin_amdgcn_readfirstlane(pstart[8]);
        const int nN = N / BM, ppr = G_ / nN; Pf = (P / ppr) * ppr; r = P - Pf; sk = pick_split(r, nN, ntK_, G_); ntsub = ntK_ / sk;
        go.init(pstart, tab, N, ntK_, G_, c_, Pf); ps = tab + 9;
    }
    __device__ __forceinline__ bool next(int i, Unit& u) const {
        long L = (long)i * go.G + go.c; Unit t; t.pm = 0; t.pn = 0; t.eks = 0; t.nt = 0; bool ok;
        if (L < go.nwg) ok = go.next(i, t);
        else { L -= go.nwg; const int per = go.nN * sk; ok = L < (long)r * per;
            const int pl = (int)(L / per), rem = (int)(L % per); t.pm = Pf + pl; t.pn = rem % go.nN; const int ks = rem / go.nN; t.nt = ntsub;
            int e = 0;
#pragma unroll
            for (int k = 0; k < 8; ++k) { const int a = __builtin_amdgcn_readfirstlane(ps[k]), b = __builtin_amdgcn_readfirstlane(ps[k + 1]); if (t.pm >= a && t.pm < b) e = k; }
            t.eks = e | (ks << 8); }
        u.pm = t.pm; u.pn = t.pn; u.eks = t.eks; u.nt = t.nt; return ok;
    }
    __device__ __forceinline__ void a_ready(const Unit&) const {}
    __device__ __forceinline__ void done(const Unit&) const {}
};
struct InProjLastOrder {
    StaticOrder so;
    __device__ __forceinline__ void init(int G_, int c_) { so.init(8192, 4608, 32, G_, c_); }
    __device__ __forceinline__ bool next(int i, Unit& u) const {
        const long L = (long)i * so.G + so.c; Unit t; t.pm = 0; t.pn = 0; t.eks = 0; t.nt = 0; bool ok;
        if (L < so.nwg) ok = so.next(i, t);
        else { ok = L < so.nwg + 8 && so.c < so.G; t.pm = 32; t.pn = 10 + (int)(L - so.nwg); t.eks = 0; t.nt = so.ntK; }
        u.pm = t.pm; u.pn = t.pn; u.eks = t.eks; u.nt = t.nt; return ok;
    }
    __device__ __forceinline__ void a_ready(const Unit&) const {}
    __device__ __forceinline__ void done(const Unit&) const {}
};

template <class Epi, class Sched, bool ALIGN_EPI = false, bool SP2 = false, int ES = 2>
__device__ __forceinline__ void gemm_phase(PG8_LAS unsigned char* lds, const Gemm g, const Sched& S, const Epi& E) {
    const int tid = threadIdx.x, wid = __builtin_amdgcn_readfirstlane(tid >> 6), lane = tid & 63, wr = wid >> 2, wc = wid & 3, fr = lane & 15, fq = lane >> 4;
    const int K = g.K;
    unsigned voffA[2], voffB[2];
#pragma unroll
    for (int i = 0; i < 2; ++i) { int R, C; stage_rc(tid * 16 + i * 8192, R, C); const int Rb = Epi::PERM == 1 ? ((R & ~31) + perm32(R & 31)) : (Epi::PERM == 2 ? sigma128(R) : R);
        voffA[i] = (unsigned)(R * K * ES + C * 2); voffB[i] = (unsigned)(Rb * K * ES + C * 2); }
    const size_t kstep = (size_t)(BK * 2);
    const size_t hstep = (size_t)HALF * K * ES;
    const size_t tstep = 2 * hstep;
    const unsigned ldsw = (unsigned)wid * 1024u;
    const int aoff = lds_byte(wr * 64 + fr, fq * 8), boff = lds_byte(wc * 32 + fr, fq * 8);
#define PG8_SA(b, h) (((b) * 2 + (h)) * HTB)
#define PG8_SB(b, h) ((4 + (b) * 2 + (h)) * HTB)
#define PG8_STAGE(bufoff, gbase, voff) do { _Pragma("unroll") for (int _i = 0; _i < 2; ++_i) \
        __builtin_amdgcn_global_load_lds((const unsigned*)((const char*)(gbase) + (voff)[_i]), (PG8_LAS unsigned*)(lds + (bufoff) + ldsw + _i * 8192), 16, 0, 0); } while (0)
#define PG8_LDA(dst, b, h) do { _Pragma("unroll") for (int m = 0; m < 4; ++m) { dst[m].lo = *(const PG8_LAS i32x4*)(lds + PG8_SA(b, h) + aoff + m * 2048); dst[m].hi = *(const PG8_LAS i32x4*)(lds + PG8_SA(b, h) + aoff + m * 2048 + 1024); } } while (0)
#define PG8_LDB(dst, b, h) do { _Pragma("unroll") for (int n = 0; n < 2; ++n) { dst[n].lo = *(const PG8_LAS i32x4*)(lds + PG8_SB(b, h) + boff + n * 2048); dst[n].hi = *(const PG8_LAS i32x4*)(lds + PG8_SB(b, h) + boff + n * 2048 + 1024); } } while (0)
#define PG8_MMA(ai, bj, At, Bt) do { __builtin_amdgcn_s_setprio(1); _Pragma("unroll") for (int m = 0; m < 4; ++m) _Pragma("unroll") for (int n = 0; n < 2; ++n) { \
        if constexpr (ES == 2) { acc[ai][bj][m][n] = __builtin_amdgcn_mfma_f32_16x16x32_bf16(as_bf16x8(Bt[n].lo), as_bf16x8(At[m].lo), acc[ai][bj][m][n], 0, 0, 0); \
                                 acc[ai][bj][m][n] = __builtin_amdgcn_mfma_f32_16x16x32_bf16(as_bf16x8(Bt[n].hi), as_bf16x8(At[m].hi), acc[ai][bj][m][n], 0, 0, 0); } \
        else { asm volatile("v_mfma_f32_16x16x128_f8f6f4 %0, %1, %2, %0" : "+v"(acc[ai][bj][m][n]) : "v"(Bt[n]), "v"(At[m])); } } \
        __builtin_amdgcn_s_setprio(0); } while (0)
#define PG8_WAIT_V(n) asm volatile("s_waitcnt vmcnt(" #n ")" ::: "memory")
#define PG8_WAIT_L(n) asm volatile("s_waitcnt lgkmcnt(" #n ")" ::: "memory")
#define PG8_BAR __builtin_amdgcn_s_barrier()
#define PG8_SCHED __builtin_amdgcn_sched_barrier(0)
    Unit cur, nxt; int ui = 0;
    if (!S.next(0, cur)) return;
    f32x4 acc[2][2][4][2];
#pragma unroll
    for (int a = 0; a < 2; ++a)
#pragma unroll
        for (int b = 0; b < 2; ++b)
#pragma unroll
            for (int m = 0; m < 4; ++m)
#pragma unroll
                for (int n = 0; n < 2; ++n) acc[a][b][m][n] = (f32x4){0.f, 0.f, 0.f, 0.f};
    i32x8 At[4], B0[2], B1[2];
    const char* cA = (const char*)g.A + (size_t)cur.pm * tstep + (size_t)(cur.ks() * cur.nt) * kstep; const char* cB = (const char*)g.Bt + (size_t)cur.e() * g.estride * ES + (size_t)cur.pn * tstep + (size_t)(cur.ks() * cur.nt) * kstep;
    S.a_ready(cur);
    if constexpr (SP2) {
        PG8_STAGE(PG8_SB(0, 0), cB, voffB); PG8_STAGE(PG8_SB(0, 1), cB + hstep, voffB); PG8_STAGE(PG8_SA(0, 0), cA, voffA); PG8_STAGE(PG8_SA(0, 1), cA + hstep, voffA);
        if (wr == 1) PG8_BAR;
        PG8_WAIT_V(2); PG8_BAR;
        PG8_STAGE(PG8_SB(1, 0), cB + kstep, voffB); PG8_STAGE(PG8_SA(1, 0), cA + kstep, voffA); PG8_STAGE(PG8_SB(1, 1), cB + hstep + kstep, voffB);
        PG8_WAIT_V(6); PG8_BAR;
    } else {
        PG8_STAGE(PG8_SB(0, 0), cB, voffB); PG8_STAGE(PG8_SA(0, 0), cA, voffA); PG8_STAGE(PG8_SB(0, 1), cB + hstep, voffB); PG8_STAGE(PG8_SA(0, 1), cA + hstep, voffA);
        if (wr == 1) PG8_BAR;
        PG8_WAIT_V(4); PG8_BAR;
        PG8_STAGE(PG8_SB(1, 0), cB + kstep, voffB); PG8_STAGE(PG8_SA(1, 0), cA + kstep, voffA); PG8_STAGE(PG8_SB(1, 1), cB + hstep + kstep, voffB);
        PG8_WAIT_V(6); PG8_BAR;
    }
    for (;;) {
        const bool has_next = S.next(ui + 1, nxt);
        const char* nA = has_next ? (const char*)g.A + (size_t)nxt.pm * tstep + (size_t)(nxt.ks() * nxt.nt) * kstep : cA; const char* nB = has_next ? (const char*)g.Bt + (size_t)nxt.e() * g.estride * ES + (size_t)nxt.pn * tstep + (size_t)(nxt.ks() * nxt.nt) * kstep : cB;
        const int nt = cur.nt;
        for (int t = 0; t < nt; t += 2) {
            const bool last = (t == nt - 2);
            const char* a1 = cA + (size_t)(t + 1) * kstep;
            const char* a2 = last ? nA : cA + (size_t)(t + 2) * kstep; const char* b2 = last ? nB : cB + (size_t)(t + 2) * kstep;
            const char* a3 = a2 + kstep; const char* b3 = b2 + kstep;
            if (last && has_next) S.a_ready(nxt);
            if constexpr (SP2) {
            PG8_LDB(B0, 0, 0); PG8_LDB(B1, 0, 1); PG8_SCHED; PG8_LDA(At, 0, 0); PG8_STAGE(PG8_SA(1, 1), a1 + hstep, voffA);
            PG8_WAIT_V(8); PG8_WAIT_L(0); PG8_BAR; PG8_MMA(0, 0, At, B0); PG8_MMA(0, 1, At, B1); PG8_BAR; PG8_SCHED;
            PG8_LDA(At, 0, 1); PG8_STAGE(PG8_SB(0, 0), b2, voffB); PG8_STAGE(PG8_SB(0, 1), b2 + hstep, voffB); PG8_STAGE(PG8_SA(0, 0), a2, voffA);
            PG8_WAIT_V(8); PG8_WAIT_L(0); PG8_BAR; PG8_MMA(1, 0, At, B0); PG8_MMA(1, 1, At, B1); PG8_BAR; PG8_SCHED;
            PG8_LDB(B0, 1, 0); PG8_LDB(B1, 1, 1); PG8_SCHED; PG8_LDA(At, 1, 0); PG8_STAGE(PG8_SA(0, 1), a2 + hstep, voffA);
            PG8_WAIT_V(8); PG8_WAIT_L(0); PG8_BAR; PG8_MMA(0, 0, At, B0); PG8_MMA(0, 1, At, B1); PG8_BAR; PG8_SCHED;
            PG8_LDA(At, 1, 1); PG8_STAGE(PG8_SB(1, 0), b3, voffB); PG8_STAGE(PG8_SB(1, 1), b3 + hstep, voffB); PG8_STAGE(PG8_SA(1, 0), a3, voffA);
            PG8_WAIT_V(8); PG8_WAIT_L(0); PG8_BAR; PG8_MMA(1, 0, At, B0); PG8_MMA(1, 1, At, B1); PG8_BAR; PG8_SCHED;
            } else {
            PG8_LDB(B0, 0, 0); PG8_SCHED; PG8_LDA(At, 0, 0); PG8_STAGE(PG8_SA(1, 1), a1 + hstep, voffA);
            PG8_WAIT_L(8); PG8_BAR; PG8_WAIT_L(0); PG8_MMA(0, 0, At, B0); PG8_BAR; PG8_SCHED;
            PG8_LDB(B1, 0, 1); PG8_STAGE(PG8_SB(0, 0), b2, voffB);
            PG8_BAR; PG8_WAIT_L(0); PG8_MMA(0, 1, At, B1); PG8_BAR;
            PG8_LDA(At, 0, 1); PG8_STAGE(PG8_SA(0, 0), a2, voffA);
            PG8_BAR; PG8_WAIT_L(0); PG8_MMA(1, 0, At, B0); PG8_BAR; PG8_SCHED;
            PG8_STAGE(PG8_SB(0, 1), b2 + hstep, voffB);
            PG8_WAIT_V(6); PG8_BAR; PG8_MMA(1, 1, At, B1); PG8_BAR;
            PG8_LDB(B0, 1, 0); PG8_SCHED; PG8_LDA(At, 1, 0); PG8_STAGE(PG8_SA(0, 1), a2 + hstep, voffA);
            PG8_WAIT_L(8); PG8_BAR; PG8_WAIT_L(0); PG8_MMA(0, 0, At, B0); PG8_BAR; PG8_SCHED;
            PG8_LDB(B1, 1, 1); PG8_STAGE(PG8_SB(1, 0), b3, voffB);
            PG8_BAR; PG8_WAIT_L(0); PG8_MMA(0, 1, At, B1); PG8_BAR;
            PG8_LDA(At, 1, 1); PG8_STAGE(PG8_SA(1, 0), a3, voffA);
            PG8_BAR; PG8_WAIT_L(0); PG8_MMA(1, 0, At, B0); PG8_BAR; PG8_SCHED;
            PG8_STAGE(PG8_SB(1, 1), b3 + hstep, voffB);
            PG8_WAIT_V(6); PG8_BAR; PG8_MMA(1, 1, At, B1); PG8_BAR;
            }
        }
        if constexpr (ES == 1) asm volatile("s_nop 15\n\ts_nop 15" ::: "memory");
        if constexpr (ALIGN_EPI) { if (wr == 0) PG8_BAR; }
        if constexpr (!Epi::AFTER_DRAIN) { E(acc, cur, wr, wc, fr, fq); S.done(cur); }
        if (!has_next) break;
#pragma unroll
        for (int a = 0; a < 2; ++a)
#pragma unroll
            for (int b = 0; b < 2; ++b)
#pragma unroll
                for (int m = 0; m < 4; ++m)
#pragma unroll
                    for (int n = 0; n < 2; ++n) acc[a][b][m][n] = (f32x4){0.f, 0.f, 0.f, 0.f};
        cur = nxt; cA = nA; cB = nB; ++ui;
        if constexpr (ALIGN_EPI) { if (wr == 1) PG8_BAR; }
    }
    PG8_WAIT_V(0);
    if constexpr (!ALIGN_EPI) { if (wr == 0) PG8_BAR; }
    PG8_BAR;
    if constexpr (Epi::AFTER_DRAIN) { E.fused(acc, cur, wr, wc, fr, fq, lds, wid, lane); S.done(cur); }
#undef PG8_SA
#undef PG8_SB
#undef PG8_STAGE
#undef PG8_LDA
#undef PG8_LDB
#undef PG8_MMA
#undef PG8_WAIT_V
#undef PG8_WAIT_L
#undef PG8_BAR
#undef PG8_SCHED
}
}

constexpr int D = 2048, SEQ = 8192, CTX = 256, MROWS = SEQ + CTX;
constexpr int INW = 4608, FFN = 7168, NEXP = 8;
constexpr int C_QB = 1024, C_QC = 1792, C_KB = 2560, C_VB = 2816, C_KC = 3072, C_VC = 3840;
constexpr int Y_B = 512, Y_C = 1280;
constexpr int MAXPAN = 72, MAXSLOT = MAXPAN * 256;
constexpr float EPS = 1e-6f;
constexpr float S_H8 = 16.f, S_WGU8 = 256.f, S_ACT8 = 8.f, S_WDN8 = 512.f;
constexpr int NWAVES = 8, NTHR = 512;

#define GAS __attribute__((address_space(1)))
#define LAS __attribute__((address_space(3)))
typedef unsigned short bf16;
typedef float f32x4 __attribute__((ext_vector_type(4)));
typedef unsigned v4u __attribute__((ext_vector_type(4)));
typedef unsigned v2u __attribute__((ext_vector_type(2)));
typedef short bf16x8 __attribute__((ext_vector_type(8)));
typedef short s16x4 __attribute__((ext_vector_type(4)));
typedef GAS unsigned gu32;
#define RLX_AGENT __ATOMIC_RELAXED, __HIP_MEMORY_SCOPE_AGENT
__device__ __forceinline__ float bf2f(bf16 v) { return __uint_as_float(((unsigned)v) << 16); }
__device__ __forceinline__ unsigned f2bf(float f) { unsigned u = __float_as_uint(f); return (u + 0x7fffu + ((u >> 16) & 1u)) >> 16; }
__device__ __forceinline__ unsigned pk2(float lo, float hi) { return f2bf(lo) | (f2bf(hi) << 16); }
__device__ __forceinline__ f32x4 ld4bf(const bf16* p) { const v2u u = *(const v2u*)p; return (f32x4){__uint_as_float(u.x << 16), __uint_as_float(u.x & 0xffff0000u), __uint_as_float(u.y << 16), __uint_as_float(u.y & 0xffff0000u)}; }
__device__ __forceinline__ void st4bf(bf16* p, f32x4 v) { v2u o; o.x = pk2(v.x, v.y); o.y = pk2(v.z, v.w); *(GAS v2u*)p = o; }
__device__ __forceinline__ float wave_sum(float v) {
#pragma unroll
    for (int o = 1; o < 64; o <<= 1) v += __shfl_xor(v, o);
    return v;
}

constexpr size_t MiB = 1u << 20;
constexpr size_t al(size_t x) { return (x + MiB - 1) / MiB * MiB; }
constexpr size_t WS_CTL = 0, CTL_ZERO_BYTES = 1 * MiB;
constexpr size_t WS_MOD = 1 * MiB;
constexpr size_t WS_ROPE = WS_MOD + 512 * 1024;
constexpr size_t WS_TOKE = 2 * MiB, WS_TOKW = WS_TOKE + 65536, WS_SLOT = WS_TOKW + 65536, WS_PSTART = WS_SLOT + 65536;
constexpr size_t WS_WIN = 4 * MiB;
constexpr size_t WS_WOUT = WS_WIN + al((size_t)2 * INW * D * 2);
constexpr size_t WS_WGU = WS_WOUT + al((size_t)2 * D * D * 2);
constexpr size_t WS_WDN = WS_WGU + al((size_t)2 * FFN * D * 2);
constexpr size_t WS_MGU = WS_WDN + al((size_t)D * FFN * 2);
constexpr size_t WS_MDN = WS_MGU + al((size_t)NEXP * 2 * FFN * D * 2);
constexpr size_t WS_H = WS_MDN + al((size_t)NEXP * D * FFN * 2);
constexpr size_t WS_P = WS_H + al((size_t)MROWS * D * 2);
constexpr size_t WS_Y = WS_P + al((size_t)MROWS * INW * 2);
constexpr size_t WS_Y2 = WS_Y + al((size_t)MROWS * D * 2);
constexpr size_t WS_ACT = WS_Y2 + al((size_t)MAXSLOT * D * 4);
constexpr size_t WS_HP = WS_ACT + al((size_t)MAXSLOT * FFN * 2);
constexpr size_t WS_Z = WS_HP + al((size_t)MAXSLOT * D * 2);
constexpr size_t WS_PART = WS_Z + al((size_t)CTX * D * 4);
constexpr size_t WS_XB = WS_PART + 64 * MiB;
constexpr size_t WS_END = WS_XB + al((size_t)MROWS * D * 2);
constexpr int CW_TMO = 0, CW_CODE = 1;
constexpr int CW_BAR = 4096;
constexpr int CW_CHEAD = 8192;
constexpr int CW_QUEUE = 16384;

constexpr int RING_BYTES = 131072;
constexpr int LDSCTL_OFF = RING_BYTES, MISC_OFF = LDSCTL_OFF + 320;
constexpr int LDS_BYTES = 147456;

#define XB_TMO      128
#define XB_XCNT(j)  (256  + 64 * (j))
#define XB_XSUB(j)  (1280 + 64 * (j))
#define XB_XGEN(j)  (2304 + 64 * (j))
#define XB_TOP      3328
#define XB_TOPGEN   3392
#define XCD_BAR_WORDS 3456
#define XB_SPIN_CAP (1u << 18)
__device__ __forceinline__ unsigned xb_ld(unsigned* p)              { return __hip_atomic_load(p, __ATOMIC_RELAXED, __HIP_MEMORY_SCOPE_AGENT); }
__device__ __forceinline__ unsigned xb_add(unsigned* p, unsigned v) { return __hip_atomic_fetch_add(p, v, __ATOMIC_RELAXED, __HIP_MEMORY_SCOPE_AGENT); }
__device__ __forceinline__ unsigned xb_xcc_id() { return (unsigned)__builtin_amdgcn_s_getreg((3 << 11) | 20) & 0xFu; }
#define XB_SPIN(cond, bar) do { unsigned _sp = 0; while (cond) { __builtin_amdgcn_s_sleep(1); \
    if ((++_sp & 255u) == 0u) { if (xb_ld(&(bar)[XB_TMO])) break; if (_sp > XB_SPIN_CAP) { atomicAdd(&(bar)[XB_TMO], 1u); break; } } } } while (0)
struct XcdBarrier { unsigned* bar; unsigned x; volatile LAS unsigned* st; };
__device__ __forceinline__ XcdBarrier xcd_barrier_post(unsigned* bar, volatile LAS unsigned* st) {
    XcdBarrier b; b.bar = bar; b.x = xb_xcc_id(); b.st = st;
    if (threadIdx.x == 0) (void)xb_add(&bar[XB_XCNT(b.x)], 1u);
    return b;
}
__device__ __forceinline__ void xcd_barrier_complete(unsigned* bar, unsigned x, unsigned& nloc, unsigned& nx) {
    const unsigned G = gridDim.x * gridDim.y * gridDim.z;
    unsigned sum, cnt, mine, sp = 0u;
    for (;;) {
        sum = 0u; cnt = 0u; mine = 0u;
#pragma unroll
        for (unsigned j = 0; j < 16; ++j) { const unsigned c = xb_ld(&bar[XB_XCNT(j)]); sum += c; cnt += (c > 0u) ? 1u : 0u; mine = (j == x) ? c : mine; }
        if (sum == G) break;
        __builtin_amdgcn_s_sleep(1);
        if ((++sp & 255u) == 0u) { if (xb_ld(&bar[XB_TMO])) break; if (sp > XB_SPIN_CAP) { atomicAdd(&bar[XB_TMO], 1u); break; } }
    }
    nloc = mine > 0u ? mine : 1u; nx = cnt > 0u ? cnt : 1u;
}
__device__ __forceinline__ void xcd_barrier(const XcdBarrier& b) {
    asm volatile("s_waitcnt vmcnt(0)" ::: "memory");
    __syncthreads();
    if (threadIdx.x == 0) {
        unsigned* bar = b.bar;
        __builtin_amdgcn_s_waitcnt(0);
        unsigned nloc = b.st[0], nx = b.st[1];
        if (nloc == 0u) { xcd_barrier_complete(bar, b.x, nloc, nx); b.st[0] = nloc; b.st[1] = nx; }
        const unsigned old = xb_add(&bar[XB_XSUB(b.x)], 1u);
        const unsigned gen = old / nloc;
        if (old + 1u == (gen + 1u) * nloc) {
            __builtin_amdgcn_fence(__ATOMIC_RELEASE, "agent");
            asm volatile("s_waitcnt vmcnt(0)" ::: "memory");
            const unsigned og = xb_add(&bar[XB_TOP], 1u);
            const unsigned tg = og / nx;
            if (og + 1u == (tg + 1u) * nx) xb_add(&bar[XB_TOPGEN], 1u);
            else XB_SPIN(xb_ld(&bar[XB_TOPGEN]) == tg, bar);
            __builtin_amdgcn_fence(__ATOMIC_ACQUIRE, "agent");
            xb_add(&bar[XB_XGEN(b.x)], 1u);
            asm volatile("s_waitcnt vmcnt(0)" ::: "memory");
        } else {
            XB_SPIN(xb_ld(&bar[XB_XGEN(b.x)]) == gen, bar);
            __builtin_amdgcn_fence(__ATOMIC_ACQUIRE, "agent");
            asm volatile("s_waitcnt vmcnt(0)" ::: "memory");
        }
    }
    __syncthreads();
}

struct Frame {
    LAS unsigned char* lds; volatile LAS unsigned* MISC; gu32* ctl;
    int tid, lane, wave, vcu, G;
    const float* in[22]; float* out; unsigned char* ws;
};
#define LDS_WAIT() asm volatile("s_waitcnt lgkmcnt(0)" ::: "memory")

template <int MAP> __device__ __forceinline__ int dest_row(int n) { if (MAP == 0) return n; const int b = n >= FFN, nn = n - b * FFN; return 256 * (nn >> 7) + 128 * b + (nn & 127); }
template <int MAP> __device__ __forceinline__ void conv_item(const float* W, int K, int N, bf16* WT, LAS float* scr, int item, int lane) {
    const int nblk = N / 32, kb = item / nblk, nb = item % nblk, k0 = 64 * kb, n0 = 32 * nb;
    { float t_[32];
#pragma unroll
      for (int i = 0; i < 32; ++i) { const int kk = 2 * i + (lane >> 5); t_[i] = __builtin_nontemporal_load(W + (size_t)(k0 + kk) * N + n0 + (lane & 31)); }
#pragma unroll
      for (int i = 0; i < 32; ++i) { const int kk = 2 * i + (lane >> 5); scr[kk * 33 + (lane & 31)] = t_[i]; } }
    LDS_WAIT(); asm volatile("" ::: "memory");
    const int c = lane & 7; const int r0 = dest_row<MAP>(n0);
#pragma unroll
    for (int j = 0; j < 4; ++j) { const int n = (lane >> 3) + 8 * j; const LAS float* s = scr + (8 * c) * 33 + n;
        v4u o; o.x = pk2(s[0 * 33], s[1 * 33]); o.y = pk2(s[2 * 33], s[3 * 33]); o.z = pk2(s[4 * 33], s[5 * 33]); o.w = pk2(s[6 * 33], s[7 * 33]);
        __builtin_nontemporal_store(o, (GAS v4u*)(WT + (size_t)(r0 + n) * K + k0 + 8 * c)); }
    LDS_WAIT(); asm volatile("" ::: "memory");
}
__device__ __forceinline__ unsigned pk4_fp8s(float a, float b, float c, float d, float sc) { return pg8::pk4_fp8(a * sc, b * sc, c * sc, d * sc); }
template <int MAP> __device__ __forceinline__ void conv_item8(const float* W, int K, int N, unsigned char* WT, float scale, LAS float* scr, int item, int lane) {
    const int nblk = N / 32, kb = item / nblk, nb = item % nblk, k0 = 128 * kb, n0 = 32 * nb;
    const int c = lane & 7; const int r0 = dest_row<MAP>(n0);
    v4u o[4];
    float t0_[32], t1_[32];
#pragma unroll
    for (int i = 0; i < 32; ++i) { const int kk = 2 * i + (lane >> 5); t0_[i] = __builtin_nontemporal_load(W + (size_t)(k0 + kk) * N + n0 + (lane & 31)); }
#pragma unroll
    for (int i = 0; i < 32; ++i) { const int kk = 2 * i + (lane >> 5); t1_[i] = __builtin_nontemporal_load(W + (size_t)(k0 + 64 + kk) * N + n0 + (lane & 31)); }
#pragma unroll
    for (int pass = 0; pass < 2; ++pass) {
#pragma unroll
        for (int i = 0; i < 32; ++i) { const int kk = 2 * i + (lane >> 5); scr[kk * 33 + (lane & 31)] = pass == 0 ? t0_[i] : t1_[i]; }
        LDS_WAIT(); asm volatile("" ::: "memory");
        if ((c >> 2) == pass) {
#pragma unroll
            for (int j = 0; j < 4; ++j) { const int n = (lane >> 3) + 8 * j; const LAS float* sp = scr + (16 * (c & 3)) * 33 + n;
                o[j].x = pk4_fp8s(sp[0 * 33], sp[1 * 33], sp[2 * 33], sp[3 * 33], scale); o[j].y = pk4_fp8s(sp[4 * 33], sp[5 * 33], sp[6 * 33], sp[7 * 33], scale);
                o[j].z = pk4_fp8s(sp[8 * 33], sp[9 * 33], sp[10 * 33], sp[11 * 33], scale); o[j].w = pk4_fp8s(sp[12 * 33], sp[13 * 33], sp[14 * 33], sp[15 * 33], scale); } }
        LDS_WAIT(); asm volatile("" ::: "memory");
    }
#pragma unroll
    for (int j = 0; j < 4; ++j) { const int n = (lane >> 3) + 8 * j; __builtin_nontemporal_store(o[j], (GAS v4u*)(WT + (size_t)(r0 + n) * K + k0 + 16 * c)); }
}
constexpr int I_GU8 = (D / 128) * (2 * FFN / 32), I_DN8 = (FFN / 128) * (D / 32), NCONV8 = NEXP * (I_GU8 + I_DN8);
__device__ __forceinline__ void conv_dispatch8(Frame& F, LAS float* scr, int it) {
    int r = it;
    if (r < NEXP * I_GU8) { const int e = r / I_GU8; conv_item8<1>(F.in[20] + (size_t)e * D * 2 * FFN, D, 2 * FFN, F.ws + WS_MGU + (size_t)e * 2 * FFN * D, S_WGU8, scr, r % I_GU8, F.lane); return; } r -= NEXP * I_GU8;
    { const int e = r / I_DN8; conv_item8<0>(F.in[21] + (size_t)e * FFN * D, FFN, D, F.ws + WS_MDN + (size_t)e * D * FFN, S_WDN8, scr, r % I_DN8, F.lane); }
}
constexpr int I_IN = (D / 64) * (INW / 32), I_OUT = (D / 64) * (D / 32), I_GU = (D / 64) * (2 * FFN / 32), I_DN = (FFN / 64) * (D / 32);
constexpr int NCONV = 2 * I_IN + 2 * I_OUT + I_GU + I_DN;
constexpr int MV_B0 = I_GU, MV_B1 = MV_B0 + I_DN, MV_B2 = MV_B1 + I_IN, MV_B = MV_B2 + I_OUT, MV_ITEMS = MV_B + NCONV8, MV_ENT = MV_ITEMS / NWAVES;
constexpr int Q_G10 = 4020, Q_MX0 = 1600, Q_G30 = 3100, Q_G40 = 950, Q_G11 = 2900, Q_MX1 = MV_ENT - (Q_G10 + Q_MX0 + Q_G30 + Q_G40 + Q_G11);
constexpr int QB_G10 = 0, QB_MX0 = QB_G10 + Q_G10, QB_G30 = QB_MX0 + Q_MX0, QB_G40 = QB_G30 + Q_G30, QB_G11 = QB_G40 + Q_G40, QB_MX1 = QB_G11 + Q_G11;
static_assert(MV_ITEMS % NWAVES == 0 && Q_MX1 > 0 && Q_G10 * NWAVES >= MV_B, "the bf16 items (read from G3_0 / G1_1 on) must all sit in the first queue");
__device__ __forceinline__ void conv_dispatch8(Frame& F, LAS float* scr, int it);
template <int MAP> __device__ __forceinline__ void conv_item(const float* W, int K, int N, bf16* WT, LAS float* scr, int item, int lane);
__device__ __forceinline__ void conv_moved(Frame& F, LAS float* scr, int it) {
    if (it < MV_B0) conv_item<1>(F.in[17], D, 2 * FFN, (bf16*)(F.ws + WS_WGU), scr, it, F.lane);
    else if (it < MV_B1) conv_item<0>(F.in[18], FFN, D, (bf16*)(F.ws + WS_WDN), scr, it - MV_B0, F.lane);
    else if (it < MV_B2) conv_item<0>(F.in[10] + (size_t)D * INW, D, INW, (bf16*)(F.ws + WS_WIN) + (size_t)INW * D, scr, it - MV_B1, F.lane);
    else if (it < MV_B) conv_item<0>(F.in[16] + (size_t)D * D, D, D, (bf16*)(F.ws + WS_WOUT) + (size_t)D * D, scr, it - MV_B2, F.lane);
    else conv_dispatch8(F, scr, it - MV_B);
}
__device__ __forceinline__ void conv_queue(Frame& F, gu32* qw, int base_ent, int nent) {
    LAS float* scr = (LAS float*)(F.lds + 32768 + F.wave * 8704); volatile LAS int* tk = (volatile LAS int*)(F.MISC + 24);
    __syncthreads();
    if (F.tid == 0) tk[0] = (int)__hip_atomic_fetch_add(qw, 1u, RLX_AGENT);
    __syncthreads();
    int cv = tk[0];
    while (cv < nent) {
        unsigned nx = 0u;
        if (F.tid == 0) nx = __hip_atomic_fetch_add(qw, 1u, RLX_AGENT);
        conv_moved(F, scr, (base_ent + cv) * NWAVES + F.wave);
        __syncthreads();
        if (F.tid == 0) tk[0] = (int)nx;
        __syncthreads();
        cv = tk[0];
    }
}
constexpr int NCONV_PRO = I_IN + I_OUT;
__device__ __forceinline__ void conv_dispatch(Frame& F, LAS float* scr, int it) {
    if (it < I_IN) conv_item<0>(F.in[10], D, INW, (bf16*)(F.ws + WS_WIN), scr, it, F.lane);
    else conv_item<0>(F.in[16], D, D, (bf16*)(F.ws + WS_WOUT), scr, it - I_IN, F.lane);
}
__device__ __forceinline__ void p_prologue(Frame& F) {
    const int gw = F.vcu * NWAVES + F.wave, NGW = F.G * NWAVES;
    const int MODEQ = 0;
    for (int task = F.vcu; task < 256; task += F.G) {
        LAS float* sv = (LAS float*)F.lds;
        LAS float* red = (LAS float*)(F.lds + 16384);
        for (int k = F.tid; k < 2 * D; k += NTHR) { const float x = k < D ? F.in[1][k] : F.in[3][k - D]; sv[k] = x / (1.f + __expf(-x)); }
        __syncthreads();
        const int l = task >> 7, chunk = task & 127, rg = F.tid / 24, c4 = F.tid % 24;
        if (rg < 21) {
            const float* W = F.in[4] + (size_t)l * D * 6 * D + chunk * 96 + 4 * c4;
            f32x4 a0 = {0.f, 0.f, 0.f, 0.f}, a1 = {0.f, 0.f, 0.f, 0.f};
#pragma unroll 8
            for (int k = rg; k < D; k += 21) { const f32x4 w = __builtin_nontemporal_load((const f32x4*)(W + (size_t)k * 6 * D)); a0 += sv[k] * w; a1 += sv[D + k] * w; }
            *(LAS f32x4*)(red + (rg * 2 + 0) * 96 + 4 * c4) = a0; *(LAS f32x4*)(red + (rg * 2 + 1) * 96 + 4 * c4) = a1;
        }
        __syncthreads();
        if (F.tid < 192) { const int w = F.tid / 96, cc = F.tid % 96; float sacc = 0.f;
#pragma unroll
          for (int q = 0; q < 21; ++q) sacc += red[(q * 2 + w) * 96 + cc];
          ((float*)(F.ws + WS_MOD))[((size_t)l * 2 + w) * 6 * D + chunk * 96 + cc] = sacc + F.in[5][l * 6 * D + chunk * 96 + cc]; }
        __syncthreads();
    }
    { const int gt = blockIdx.x * NTHR + F.tid;
      if (gt < 128 * 32) { const int pos = gt >> 5, i = gt & 31; const float inv = exp2f(-(float)i * (13.287712379549449f / 32.f)); float sn, cs; sincosf((float)pos * inv, &sn, &cs);
          ((float*)(F.ws + WS_ROPE))[gt] = cs; ((float*)(F.ws + WS_ROPE))[4096 + gt] = sn; } }
    LAS float* scr = (LAS float*)(F.lds + 32768 + F.wave * 8704);
    { gu32* head = F.ctl + CW_CHEAD; volatile LAS int* sh = (volatile LAS int*)(F.MISC + 24); constexpr int N8 = 0; constexpr int NALL = NCONV_PRO, PULL = 16;
      (void)gw; (void)NGW; (void)MODEQ;
      if (F.tid == 0) sh[0] = (int)__hip_atomic_fetch_add(head, (unsigned)PULL, RLX_AGENT);
      __syncthreads();
      int h = sh[0];
      while (h < NALL) {
          unsigned nx = 0u;
          if (F.tid == 0) nx = __hip_atomic_fetch_add(head, (unsigned)PULL, RLX_AGENT);
#pragma unroll 1
          for (int k = 0; k < PULL / NWAVES; ++k) { const int it = h + NWAVES * k + F.wave; if (it < N8) conv_dispatch8(F, scr, it); else if (it < NALL) conv_dispatch(F, scr, it - N8); }
          __syncthreads();
          if (F.tid == 0) sh[0] = (int)nx;
          __syncthreads();
          h = sh[0];
      } }
}

__device__ __forceinline__ void p_prenorm0(Frame& F) {
    const int gw = F.wave * F.G + F.vcu, NGW = F.G * NWAVES; const float* MOD = (const float*)(F.ws + WS_MOD); bf16* H = (bf16*)(F.ws + WS_H); const float* gpre = F.in[6]; const int lane = F.lane;
    LAS float* cf = (LAS float*)F.lds;
    { const int col = 4 * F.tid;
#pragma unroll
      for (int pt = 0; pt < 2; ++pt) { const float* mod = MOD + pt * 6 * D;
          *(LAS f32x4*)(cf + (pt * 2 + 0) * D + col) = *(const f32x4*)(gpre + col) * (1.f + *(const f32x4*)(mod + D + col)); *(LAS f32x4*)(cf + (pt * 2 + 1) * D + col) = *(const f32x4*)(mod + col); }
      __syncthreads(); }
    int row = gw; if (row >= MROWS) return;
    f32x4 xc[8];
#define PN_LOAD(R, X) do { const float* src_ = (R) < SEQ ? F.in[0] + (size_t)(R) * D : F.in[2] + (size_t)((R) - SEQ) * D; _Pragma("unroll") for (int j = 0; j < 8; ++j) X[j] = __builtin_nontemporal_load((const f32x4*)(src_ + 4 * lane + 256 * j)); } while (0)
    PN_LOAD(row, xc);
    for (;;) {
        const int nrow = row + NGW; const bool more = nrow < MROWS;
        f32x4 xn[8]; if (more) PN_LOAD(nrow, xn);
        const int pt = row < SEQ ? 0 : 1; const LAS float* cA = cf + (pt * 2 + 0) * D + 4 * lane; const LAS float* cB = cf + (pt * 2 + 1) * D + 4 * lane;
        float ss = 0.f;
#pragma unroll
        for (int j = 0; j < 8; ++j) ss += (xc[j].x * xc[j].x + xc[j].y * xc[j].y) + (xc[j].z * xc[j].z + xc[j].w * xc[j].w);
        const float r = rsqrtf(wave_sum(ss) * (1.f / D) + EPS);
#pragma unroll
        for (int j = 0; j < 8; ++j) { const int col = 4 * lane + 256 * j; const f32x4 h = (xc[j] * r) * *(const LAS f32x4*)(cA + 256 * j) + *(const LAS f32x4*)(cB + 256 * j);
            v2u o; o.x = pk2(h.x, h.y); o.y = pk2(h.z, h.w); __builtin_nontemporal_store(o, (GAS v2u*)(H + (size_t)row * D + col)); }
        if (!more) break;
#pragma unroll
        for (int j = 0; j < 8; ++j) xc[j] = xn[j];
        row = nrow;
    }
#undef PN_LOAD
}
template <bool XF32> __device__ __forceinline__ void p_post(Frame& F, const bf16* Y2, const float* gpost, int gate_off, const float* gmod  ,
                                       const float* xlat_src, const float* xctx_src, bf16* XB, int nrows,
                                       const float* gpre, const float* pmod  , int sh_off, int sc_off, bf16* H, const float* wrouter, int* tok_e, float* tok_w, const bf16* part, int npart) {
    const int gw = F.wave * F.G + F.vcu, NGW = F.G * NWAVES; const int lane = F.lane;
    LAS float* wrt = (LAS float*)F.lds;
    if (wrouter) { const int t = F.tid; f32x4 rw[8];
#pragma unroll
        for (int q = 0; q < 8; ++q) rw[q] = *(const f32x4*)(wrouter + (size_t)(4 * t) * NEXP + 4 * q);
#pragma unroll
        for (int e = 0; e < 8; ++e) { f32x4 o; o.x = rw[0 + (e >> 2)][e & 3]; o.y = rw[2 + (e >> 2)][e & 3]; o.z = rw[4 + (e >> 2)][e & 3]; o.w = rw[6 + (e >> 2)][e & 3]; *(LAS f32x4*)(wrt + e * D + 4 * t) = o; }
        __syncthreads(); }
    LAS float* cf = (LAS float*)(F.lds + 65536);
    { const int col = 4 * F.tid;
#pragma unroll
      for (int pt = 0; pt < 2; ++pt) { const float* gm = gmod + pt * 6 * D; const float* pm = pmod + pt * 6 * D;
          *(LAS f32x4*)(cf + (pt * 3 + 0) * D + col) = *(const f32x4*)(gm + gate_off + col) * *(const f32x4*)(gpost + col);
          *(LAS f32x4*)(cf + (pt * 3 + 1) * D + col) = *(const f32x4*)(gpre + col) * (1.f + *(const f32x4*)(pm + sc_off + col));
          *(LAS f32x4*)(cf + (pt * 3 + 2) * D + col) = *(const f32x4*)(pm + sh_off + col); }
      __syncthreads(); }
#pragma unroll 1
    for (int part_o = 0; part_o < 2; ++part_o) {
        const int part_i = 1 - part_o; const bool lat = part_i == 0;
        const int rend = lat ? (nrows < SEQ ? nrows : SEQ) : nrows;
        int row = lat ? gw : SEQ + gw;
        if (row >= rend) continue;
        const LAS float* cA1 = cf + (part_i * 3 + 0) * D + 4 * lane; const LAS float* cA2 = cf + (part_i * 3 + 1) * D + 4 * lane; const LAS float* cB2 = cf + (part_i * 3 + 2) * D + 4 * lane;
        v2u yc[8]; f32x4 xcf[XF32 ? 8 : 1]; v2u xcb[XF32 ? 1 : 8];
#define PP_LOAD(R, YD, XF, XBD) do { const bf16* y_ = Y2 + (size_t)(R) * D; _Pragma("unroll") for (int j = 0; j < 8; ++j) { const int col = 4 * lane + 256 * j; YD[j] = *(const v2u*)(y_ + col); \
            if constexpr (XF32) { const float* xs_ = (R) < SEQ ? xlat_src + (size_t)(R) * D : xctx_src + (size_t)((R) - SEQ) * D; XF[j] = *(const f32x4*)(xs_ + col); } \
            else XBD[j] = *(const v2u*)(XB + (size_t)(R) * D + col); } } while (0)
        PP_LOAD(row, yc, xcf, xcb);
        for (;;) {
            const int nrow = row + NGW; const bool more = nrow < rend;
            v2u yn[8]; f32x4 xnf[XF32 ? 8 : 1]; v2u xnb[XF32 ? 1 : 8];
            if constexpr (!XF32) { if (more) PP_LOAD(nrow, yn, xnf, xnb); }
            f32x4 v[8]; float ss = 0.f;
#pragma unroll
            for (int j = 0; j < 8; ++j) v[j] = (f32x4){__uint_as_float(yc[j].x << 16), __uint_as_float(yc[j].x & 0xffff0000u), __uint_as_float(yc[j].y << 16), __uint_as_float(yc[j].y & 0xffff0000u)};
            if (!lat) {
#pragma unroll 1
                for (int p = 0; p < npart; ++p) { const bf16* pp = part + ((size_t)p * CTX + (row - SEQ)) * D + 4 * lane; v2u t[8];
#pragma unroll
                    for (int j = 0; j < 8; ++j) t[j] = *(const v2u*)(pp + 256 * j);
#pragma unroll
                    for (int j = 0; j < 8; ++j) v[j] += (f32x4){__uint_as_float(t[j].x << 16), __uint_as_float(t[j].x & 0xffff0000u), __uint_as_float(t[j].y << 16), __uint_as_float(t[j].y & 0xffff0000u)}; } }
#pragma unroll
            for (int j = 0; j < 8; ++j) ss += (v[j].x * v[j].x + v[j].y * v[j].y) + (v[j].z * v[j].z + v[j].w * v[j].w);
            const float r = rsqrtf(wave_sum(ss) * (1.f / D) + EPS);
            float s2 = 0.f; bf16* xb = XB + (size_t)row * D;
#pragma unroll
            for (int j = 0; j < 8; ++j) { const int col = 4 * lane + 256 * j; f32x4 x;
                if constexpr (XF32) x = xcf[j]; else x = (f32x4){__uint_as_float(xcb[j].x << 16), __uint_as_float(xcb[j].x & 0xffff0000u), __uint_as_float(xcb[j].y << 16), __uint_as_float(xcb[j].y & 0xffff0000u)};
                v[j] = x + *(const LAS f32x4*)(cA1 + 256 * j) * (v[j] * r); { v2u xo_; xo_.x = pk2(v[j].x, v[j].y); xo_.y = pk2(v[j].z, v[j].w); __builtin_nontemporal_store(xo_, (GAS v2u*)(xb + col)); } s2 += (v[j].x * v[j].x + v[j].y * v[j].y) + (v[j].z * v[j].z + v[j].w * v[j].w); }
            const float r2 = rsqrtf(wave_sum(s2) * (1.f / D) + EPS);
            float lg[8] = {0.f, 0.f, 0.f, 0.f, 0.f, 0.f, 0.f, 0.f};
#pragma unroll
            for (int j = 0; j < 8; ++j) { const int col = 4 * lane + 256 * j;
                const f32x4 h = (v[j] * r2) * *(const LAS f32x4*)(cA2 + 256 * j) + *(const LAS f32x4*)(cB2 + 256 * j); v2u o; o.x = pk2(h.x, h.y); o.y = pk2(h.z, h.w); __builtin_nontemporal_store(o, (GAS v2u*)(H + (size_t)row * D + col));
                if (wrouter) {
#pragma unroll
                    for (int e = 0; e < 8; ++e) { const f32x4 we = *(const LAS f32x4*)(wrt + e * D + col); lg[e] += (h.x * we.x + h.y * we.y) + (h.z * we.z + h.w * we.w); } } }
            if (wrouter) {
#pragma unroll
                for (int e = 0; e < 8; ++e) lg[e] = wave_sum(lg[e]);
                int i1 = 0; float v1 = lg[0];
#pragma unroll
                for (int e = 1; e < 8; ++e) if (lg[e] > v1) { v1 = lg[e]; i1 = e; }
                int i2 = -1; float v2 = -3.0e38f;
#pragma unroll
                for (int e = 0; e < 8; ++e) if (e != i1 && lg[e] > v2) { v2 = lg[e]; i2 = e; }
                const float w1 = 1.f / (1.f + __expf(v2 - v1));
                if (lane == 0) { tok_e[2 * row] = i1; tok_e[2 * row + 1] = i2; tok_w[2 * row] = w1; tok_w[2 * row + 1] = 1.f - w1; }
            }
            if (!more) break;
            if constexpr (XF32) { PP_LOAD(nrow, yc, xcf, xcb); }
            else {
#pragma unroll
                for (int j = 0; j < 8; ++j) { yc[j] = yn[j]; xcb[j] = xnb[j]; } }
            row = nrow;
        }
#undef PP_LOAD
    }
}
__device__ __forceinline__ void p_combine(Frame& F, const bf16* Y2e, const int* slot_of, const float* tok_w, const float* gpost, const float* gate, const bf16* xsrc, float* xdst, const bf16* part, const int* pstart) {
    const int gw = F.vcu * NWAVES + F.wave, NGW = F.G * NWAVES; const int lane = F.lane;
    const int Ptot = __builtin_amdgcn_readfirstlane(pstart[8]), ppr = F.G / (D / 256), Pf = (Ptot / ppr) * ppr, rr = Ptot - Pf, sk = pg8::pick_split(rr, D / 256, FFN / 128, F.G);
    const size_t pstride = (size_t)rr * 256 * D; const int slot_f = Pf * 256;
    LAS float* cf = (LAS float*)F.lds;
    { const int col = 4 * F.tid; *(LAS f32x4*)(cf + col) = *(const f32x4*)(gate + col) * *(const f32x4*)(gpost + col); __syncthreads(); }
    const LAS float* cA = cf + 4 * lane;
    int row = gw; if (row >= SEQ) return;
    v2u y1c[8], y2c[8], xc[8]; int s1 = slot_of[2 * row], s2 = slot_of[2 * row + 1]; float w1 = tok_w[2 * row], w2 = tok_w[2 * row + 1];
#define PC_LOAD(R, S1, S2, Y1, Y2_, X) do { _Pragma("unroll") for (int j = 0; j < 8; ++j) { const int col = 4 * lane + 256 * j; Y1[j] = *(const v2u*)(Y2e + (size_t)(S1) * D + col); Y2_[j] = *(const v2u*)(Y2e + (size_t)(S2) * D + col); X[j] = *(const v2u*)(xsrc + (size_t)(R) * D + col); } } while (0)
#define PC_F4(u) ((f32x4){__uint_as_float((u).x << 16), __uint_as_float((u).x & 0xffff0000u), __uint_as_float((u).y << 16), __uint_as_float((u).y & 0xffff0000u)})
    PC_LOAD(row, s1, s2, y1c, y2c, xc);
    for (;;) {
        const int nrow = row + NGW; const bool more = nrow < SEQ;
        v2u y1n[8], y2n[8], xn[8]; int s1n = 0, s2n = 0; float w1n = 0.f, w2n = 0.f;
        if (more) { s1n = slot_of[2 * nrow]; s2n = slot_of[2 * nrow + 1]; w1n = tok_w[2 * nrow]; w2n = tok_w[2 * nrow + 1]; PC_LOAD(nrow, s1n, s2n, y1n, y2n, xn); }
        f32x4 v[8]; float ss = 0.f;
#pragma unroll
        for (int j = 0; j < 8; ++j) v[j] = w1 * PC_F4(y1c[j]) + w2 * PC_F4(y2c[j]);
        if (s1 >= slot_f) {
#pragma unroll 1
            for (int p = 0; p < sk - 1; ++p) { const bf16* pp = part + (size_t)p * pstride + (size_t)(s1 - slot_f) * D + 4 * lane; v2u t[8];
#pragma unroll
                for (int j = 0; j < 8; ++j) t[j] = *(const v2u*)(pp + 256 * j);
#pragma unroll
                for (int j = 0; j < 8; ++j) v[j] += w1 * PC_F4(t[j]); } }
        if (s2 >= slot_f) {
#pragma unroll 1
            for (int p = 0; p < sk - 1; ++p) { const bf16* pp = part + (size_t)p * pstride + (size_t)(s2 - slot_f) * D + 4 * lane; v2u t[8];
#pragma unroll
                for (int j = 0; j < 8; ++j) t[j] = *(const v2u*)(pp + 256 * j);
#pragma unroll
                for (int j = 0; j < 8; ++j) v[j] += w2 * PC_F4(t[j]); } }
#pragma unroll
        for (int j = 0; j < 8; ++j) ss += (v[j].x * v[j].x + v[j].y * v[j].y) + (v[j].z * v[j].z + v[j].w * v[j].w);
        const float r = rsqrtf(wave_sum(ss) * (1.f / D) + EPS);
#pragma unroll
        for (int j = 0; j < 8; ++j) { const int col = 4 * lane + 256 * j;
            __builtin_nontemporal_store(PC_F4(xc[j]) + *(const LAS f32x4*)(cA + 256 * j) * (v[j] * r), (GAS f32x4*)(xdst + (size_t)row * D + col)); }
        if (!more) break;
#pragma unroll
        for (int j = 0; j < 8; ++j) { y1c[j] = y1n[j]; y2c[j] = y2n[j]; xc[j] = xn[j]; }
        s1 = s1n; s2 = s2n; w1 = w1n; w2 = w2n; row = nrow;
    }
#undef PC_LOAD
#undef PC_F4
}

__device__ __forceinline__ void p_route(Frame& F) {
    const int* tok_e = (const int*)(F.ws + WS_TOKE); int* slot_of = (int*)(F.ws + WS_SLOT); int* pstart = (int*)(F.ws + WS_PSTART);
    const bf16* H = (const bf16*)(F.ws + WS_H); unsigned char* HP = F.ws + WS_HP;
    LAS unsigned char* te = F.lds;
    LAS int* cnt = (LAS int*)(F.lds + 16384);
    LAS int* rowtok = (LAS int*)(F.lds + 32768);
    LAS int* ps = (LAS int*)(F.lds + 32768 + MAXSLOT * 4);
    const int t = F.tid;
    int c[8] = {0, 0, 0, 0, 0, 0, 0, 0};
#pragma unroll
    for (int j4 = 0; j4 < 8; ++j4) { const v4u ev = *(const v4u*)(tok_e + 32 * t + 4 * j4); const unsigned ee[4] = {ev.x, ev.y, ev.z, ev.w};
#pragma unroll
        for (int q = 0; q < 4; ++q) { te[32 * t + 4 * j4 + q] = (unsigned char)ee[q];
#pragma unroll
            for (int e = 0; e < 8; ++e) c[e] += (ee[q] == (unsigned)e); } }
#pragma unroll
    for (int e = 0; e < 8; ++e) cnt[t * 8 + e] = c[e];
    for (int s = t; s < MAXSLOT; s += NTHR) rowtok[s] = -1;
    __syncthreads();
    { const int e = F.wave; int loc[8]; int sum = 0;
#pragma unroll
      for (int q = 0; q < 8; ++q) { loc[q] = cnt[(8 * F.lane + q) * 8 + e]; sum += loc[q]; }
      int inc = sum;
#pragma unroll
      for (int o = 1; o < 64; o <<= 1) { const int up = __shfl_up(inc, o); if (F.lane >= o) inc += up; }
      int run = inc - sum;
#pragma unroll
      for (int q = 0; q < 8; ++q) { cnt[(8 * F.lane + q) * 8 + e] = run; run += loc[q]; }
      if (F.lane == 63) ps[9 + e] = inc; }
    __syncthreads();
    if (t == 0) { int p = 0; for (int e = 0; e < 8; ++e) { ps[e] = p; p += (ps[9 + e] + 255) >> 8; } ps[8] = p; }
    __syncthreads();
    if (blockIdx.x == 0 && t < 9) pstart[t] = ps[t];
    { int run[8];
#pragma unroll
      for (int e = 0; e < 8; ++e) run[e] = ps[e] * 256 + cnt[t * 8 + e];
      const bool mine = ((t >> 1) % F.G) == (int)blockIdx.x;
      for (int j = 0; j < 32; ++j) { const int idx = 32 * t + j; const int e = te[idx]; int slot = 0;
#pragma unroll
          for (int q = 0; q < 8; ++q) if (e == q) { slot = run[q]; run[q] = slot + 1; }
          rowtok[slot] = idx >> 1; if (mine) slot_of[idx] = slot; } }
    __syncthreads();
    const int nslot = ps[8] * 256;
    { const int str = F.G * NWAVES;
      for (int s0 = blockIdx.x * NWAVES + F.wave; s0 < nslot; s0 += 4 * str) { v4u rv[4][4]; int tokb[4];
#pragma unroll
        for (int b4 = 0; b4 < 4; ++b4) { const int s = s0 + b4 * str; tokb[b4] = s < nslot ? rowtok[s] : -1; const int tl = tokb[b4] >= 0 ? tokb[b4] : 0;
#pragma unroll
            for (int j = 0; j < 4; ++j) rv[b4][j] = *(const v4u*)(H + (size_t)tl * D + 32 * F.lane + 8 * j); }
#define RT_PK(v) pk4_fp8s(__uint_as_float((v).x << 16), __uint_as_float((v).x & 0xffff0000u), __uint_as_float((v).y << 16), __uint_as_float((v).y & 0xffff0000u), S_H8), pk4_fp8s(__uint_as_float((v).z << 16), __uint_as_float((v).z & 0xffff0000u), __uint_as_float((v).w << 16), __uint_as_float((v).w & 0xffff0000u), S_H8)
#pragma unroll
        for (int b4 = 0; b4 < 4; ++b4) { const int s = s0 + b4 * str;
            if (s < nslot) { v4u o0 = (v4u){RT_PK(rv[b4][0]), RT_PK(rv[b4][1])}, o1 = (v4u){RT_PK(rv[b4][2]), RT_PK(rv[b4][3])};
                if (tokb[b4] < 0) { o0 = (v4u){0u, 0u, 0u, 0u}; o1 = (v4u){0u, 0u, 0u, 0u}; }
                *(GAS v4u*)(HP + (size_t)s * D + 32 * F.lane) = o0; *(GAS v4u*)(HP + (size_t)s * D + 32 * F.lane + 16) = o1; } }
#undef RT_PK
      } }
    __syncthreads();
}

namespace mx {
constexpr int KSTR = 288;
constexpr int TILE_B = 32 * KSTR;
constexpr int OFF_RPB = 6 * TILE_B;
constexpr int OFF_VH = 0;
constexpr float SC_L2 = 0.08838834764831845f * 1.4426950408889634f;
constexpr float L2E = 1.4426950408889634f;
constexpr float NEG = -1e30f;

__device__ __forceinline__ bf16x8 tr_pair(const LAS unsigned char* p, int off0, int off1) {
    const s16x4 a = __builtin_amdgcn_ds_read_tr16_b64_v4i16((LAS s16x4*)(p + off0)); const s16x4 b = __builtin_amdgcn_ds_read_tr16_b64_v4i16((LAS s16x4*)(p + off1));
    return (bf16x8){a[0], a[1], a[2], a[3], b[0], b[1], b[2], b[3]};
}
typedef __bf16 bf16v2 __attribute__((ext_vector_type(2))); typedef float f32v2 __attribute__((ext_vector_type(2)));
__device__ __forceinline__ unsigned cvt_pk(float lo, float hi) { const f32v2 v = {lo, hi}; const bf16v2 b = __builtin_convertvector(v, bf16v2); return __builtin_bit_cast(unsigned, b); }

template <int VAR> __device__ __forceinline__ void attn_unit(Frame& F, const bf16* P, bf16* Y, int u0, int u1, int band, const float* sink, const float* rpb) {
    constexpr int MQ = VAR == 0 ? 3 : 2;
    LAS unsigned char* lds = F.lds;
    int lane_; asm volatile("v_mbcnt_lo_u32_b32 %0, -1, 0\n\tv_mbcnt_hi_u32_b32 %0, -1, %0" : "=v"(lane_));
    const int lane = lane_, w = F.wave, fr = lane & 15, fq = lane >> 4, tid = w * 64 + lane_;
    int qrow[MQ], qcol[MQ], ycol[MQ]; int kcol, vcol;
    int nb = 0, blo = 0;
    int r_w = 0, r0_w = 0, cbase = 0;
    float m[MQ], l[MQ];
    if constexpr (VAR == 0) {
        kcol = C_KB + u1 * 128; vcol = C_VB + u1 * 128;
#pragma unroll
        for (int q = 0; q < MQ; ++q) { const int h = 3 * u1 + q; qrow[q] = u0 + 16 * w + fr; qcol[q] = C_QB + h * 128; ycol[q] = Y_B + h * 128; m[q] = sink[h] * L2E; l[q] = fq == 0 ? 1.f : 0.f; }
        if (band) { const int lo = u0 - 128 < 0 ? 0 : u0 - 128, hi = u0 + 256 > SEQ ? SEQ : u0 + 256; blo = lo; nb = (hi - lo) >> 5; }
    } else {
        kcol = C_KC + u0 * 128; vcol = C_VC + u0 * 128;
        if (band) { r_w = u1 + (w >> 1); cbase = 32 * (w & 1); r0_w = r_w - 4 < 0 ? 0 : (r_w - 4 > 120 ? 120 : r_w - 4);
            const int klo = u1 - 4 < 0 ? 0 : (u1 - 4 > 120 ? 120 : u1 - 4); int khi = u1 + 3 - 4; khi = (khi < 0 ? 0 : (khi > 120 ? 120 : khi)) + 8; blo = klo; nb = 2 * (khi - klo); }
#pragma unroll
        for (int q = 0; q < MQ; ++q) { qrow[q] = band ? 64 * r_w + cbase + 16 * q + fr : SEQ + 32 * w + 16 * q + fr; qcol[q] = C_QC + u0 * 128; ycol[q] = Y_C + u0 * 128; m[q] = NEG; l[q] = 0.f; }
        if (band) { for (int i = tid; i < 15 * 128; i += NTHR) { const int ro = i >> 7, co = (i & 127) - 48; ((LAS float*)(lds + OFF_RPB))[i] = (co >= 0 && co < 31) ? rpb[(u0 * 15 + ro) * 31 + co] * L2E : 0.f; } }
    }
    const int NT = nb + 8;
    bf16x8 qf[MQ][4];
#pragma unroll
    for (int q = 0; q < MQ; ++q)
#pragma unroll
        for (int kk = 0; kk < 4; ++kk) qf[q][kk] = *(const bf16x8*)(P + (size_t)qrow[q] * INW + qcol[q] + 32 * kk + 8 * fq);
    f32x4 o[MQ][8];
#pragma unroll
    for (int q = 0; q < MQ; ++q)
#pragma unroll
        for (int dt = 0; dt < 8; ++dt) o[q][dt] = (f32x4){0.f, 0.f, 0.f, 0.f};
    const int si = tid >> 4, sc16 = tid & 15; const int soff = si * KSTR + sc16 * 16;
#define MX_TILE_ROW(t) (VAR == 0 ? ((t) < nb ? blo + 32 * (t) : SEQ + 32 * ((t) - nb)) : ((t) < 8 ? SEQ + 32 * (t) : 64 * (blo + (((t) - 8) >> 1)) + 32 * (((t) - 8) & 1)))
    constexpr int DEPTH = VAR == 1 ? 2 : 1;
    v4u kA, vA, kB, vB;
    { const int row0 = MX_TILE_ROW(0); kA = *(const v4u*)(P + (size_t)(row0 + si) * INW + kcol + 8 * sc16); vA = *(const v4u*)(P + (size_t)(row0 + si) * INW + vcol + 8 * sc16); }
    if constexpr (DEPTH == 2) { const int row1 = MX_TILE_ROW(1); kB = *(const v4u*)(P + (size_t)(row1 + si) * INW + kcol + 8 * sc16); vB = *(const v4u*)(P + (size_t)(row1 + si) * INW + vcol + 8 * sc16); }
    else { kB = kA; vB = vA; }
    __syncthreads();
    *(LAS v4u*)(lds + soff) = kA; *(LAS v4u*)(lds + TILE_B + soff) = vA;
    __syncthreads();
    const int koff = fr * KSTR + fq * 16;
    const int voff = (4 * fq + (fr >> 2)) * KSTR + (fr & 3) * 8;
    __builtin_amdgcn_s_waitcnt(0);
    for (int t0 = 0; t0 < NT; t0 += DEPTH) {
#pragma unroll
      for (int par = 0; par < DEPTH; ++par) {
        const int t = t0 + par; if (t >= NT) break;
        v4u& kl = par == 0 ? kA : kB; v4u& vl = par == 0 ? vA : vB;
        const v4u& ks_ = (DEPTH == 1 || par == 1) ? kA : kB; const v4u& vs_ = (DEPTH == 1 || par == 1) ? vA : vB;
        const int buf = t % 3, bufn = (t + 1) % 3;
        if (t + DEPTH < NT) { const int row0 = MX_TILE_ROW(t + DEPTH); kl = *(const v4u*)(P + (size_t)(row0 + si) * INW + kcol + 8 * sc16); vl = *(const v4u*)(P + (size_t)(row0 + si) * INW + vcol + 8 * sc16); }
        bool rel = true; int kpos0 = 0, kr = 0, hf = 0;
        const bool is_band = VAR == 0 ? (t < nb) : (t >= 8);
        if constexpr (VAR == 0) { if (is_band) { kpos0 = blo + 32 * t; const int tq0 = u0 + 16 * w; rel = (kpos0 + 31 >= tq0 - 128) && (kpos0 <= tq0 + 15 + 128); } }
        else { if (is_band) { kr = blo + ((t - 8) >> 1); hf = (t - 8) & 1; rel = (kr >= r0_w) && (kr < r0_w + 8); } }
        if (rel) {
            const LAS unsigned char* Kt = lds + buf * 2 * TILE_B; const LAS unsigned char* Vt = Kt + TILE_B;
            float bb[VAR == 1 ? MQ : 1][8]; int c0q[VAR == 1 ? MQ : 1];
            if constexpr (VAR == 1) { if (is_band) {
#pragma unroll
                for (int q = 0; q < MQ; ++q) { const int c = cbase + 16 * q + fr; c0q[q] = c - 8 < 0 ? 0 : (c - 8 > 48 ? 48 : c - 8);
                    const LAS float* bp = (const LAS float*)(lds + OFF_RPB) + (kr - r_w + 7) * 128 + 32 * hf + 4 * fq - c + 63;
#pragma unroll
                    for (int j = 0; j < 8; ++j) bb[q][j] = bp[16 * (j >> 2) + (j & 3)]; } } }
            f32x4 st[MQ][2];
#pragma unroll
            for (int q = 0; q < MQ; ++q) { st[q][0] = (f32x4){0.f, 0.f, 0.f, 0.f}; st[q][1] = (f32x4){0.f, 0.f, 0.f, 0.f}; }
#pragma unroll
            for (int ks = 0; ks < 2; ++ks)
#pragma unroll
                for (int kk = 0; kk < 4; ++kk) { const bf16x8 kf = *(const LAS bf16x8*)(Kt + koff + ks * 16 * KSTR + kk * 64);
#pragma unroll
                    for (int q = 0; q < MQ; ++q) st[q][ks] = __builtin_amdgcn_mfma_f32_16x16x32_bf16(kf, qf[q][kk], st[q][ks], 0, 0, 0); }
            if constexpr (VAR == 1) {
            float s[MQ][8]; float mt[MQ];
#pragma unroll
            for (int q = 0; q < MQ; ++q) {
                if (!is_band) {
#pragma unroll
                    for (int j = 0; j < 8; ++j) s[q][j] = st[q][j >> 2][j & 3] * SC_L2;
                } else if constexpr (VAR == 0) {
                    const int w0 = kpos0 + 4 * fq - qrow[q] + 128;
#pragma unroll
                    for (int j = 0; j < 8; ++j) { const float v = st[q][j >> 2][j & 3] * SC_L2; s[q][j] = ((unsigned)(w0 + 16 * (j >> 2) + (j & 3)) <= 256u) ? v : NEG; }
                } else {
                    const int v0 = 32 * hf + 4 * fq - c0q[q];
#pragma unroll
                    for (int j = 0; j < 8; ++j) { const float v = st[q][j >> 2][j & 3] * SC_L2 + bb[q][j]; s[q][j] = ((unsigned)(v0 + 16 * (j >> 2) + (j & 3)) < 16u) ? v : NEG; }
                }
                float x = fmaxf(fmaxf(fmaxf(s[q][0], s[q][1]), fmaxf(s[q][2], s[q][3])), fmaxf(fmaxf(s[q][4], s[q][5]), fmaxf(s[q][6], s[q][7])));
                x = fmaxf(x, __shfl_xor(x, 16)); x = fmaxf(x, __shfl_xor(x, 32)); mt[q] = x;
            }
            bool grow = false;
#pragma unroll
            for (int q = 0; q < MQ; ++q) grow = grow || (mt[q] > m[q]);
            if (__any(grow)) {
#pragma unroll
                for (int q = 0; q < MQ; ++q) { const float mn = fmaxf(m[q], mt[q]); const float alpha = __builtin_amdgcn_exp2f(m[q] - mn); m[q] = mn; l[q] *= alpha;
#pragma unroll
                    for (int dt = 0; dt < 8; ++dt) o[q][dt] *= alpha; } }
            bf16x8 pb[MQ];
#pragma unroll
            for (int q = 0; q < MQ; ++q) { float ps = 0.f;
#pragma unroll
                for (int j = 0; j < 8; ++j) { s[q][j] = __builtin_amdgcn_exp2f(s[q][j] - m[q]); ps += s[q][j]; }
                l[q] += ps;
                v4u pk; pk.x = cvt_pk(s[q][0], s[q][1]); pk.y = cvt_pk(s[q][2], s[q][3]); pk.z = cvt_pk(s[q][4], s[q][5]); pk.w = cvt_pk(s[q][6], s[q][7]);
                pb[q] = __builtin_bit_cast(bf16x8, pk); }
#pragma unroll
            for (int dt = 0; dt < 8; ++dt) { const bf16x8 vf = tr_pair(Vt + voff, dt * 32, dt * 32 + 16 * KSTR);
#pragma unroll
                for (int q = 0; q < MQ; ++q) o[q][dt] = __builtin_amdgcn_mfma_f32_16x16x32_bf16(vf, pb[q], o[q][dt], 0, 0, 0); }
            } else {
            bf16x8 pb[MQ];
#pragma unroll
            for (int q = 0; q < MQ; ++q) {
                float s[8];
                if (!is_band) {
#pragma unroll
                    for (int j = 0; j < 8; ++j) s[j] = st[q][j >> 2][j & 3] * SC_L2;
                } else if constexpr (VAR == 0) {
                    const int w0 = kpos0 + 4 * fq - qrow[q] + 128;
#pragma unroll
                    for (int j = 0; j < 8; ++j) { const float v = st[q][j >> 2][j & 3] * SC_L2; s[j] = ((unsigned)(w0 + 16 * (j >> 2) + (j & 3)) <= 256u) ? v : NEG; }
                } else {
                    const int c = cbase + 16 * q + fr; const int c0 = c - 8 < 0 ? 0 : (c - 8 > 48 ? 48 : c - 8);
                    const LAS float* bp = (const LAS float*)(lds + OFF_RPB) + (kr - r_w + 7) * 128 + 32 * hf + 4 * fq - c + 63; const int v0 = 32 * hf + 4 * fq - c0;
                    float bb[8];
#pragma unroll
                    for (int j = 0; j < 8; ++j) bb[j] = bp[16 * (j >> 2) + (j & 3)];
#pragma unroll
                    for (int j = 0; j < 8; ++j) { const float v = st[q][j >> 2][j & 3] * SC_L2 + bb[j]; s[j] = ((unsigned)(v0 + 16 * (j >> 2) + (j & 3)) < 16u) ? v : NEG; }
                }
                float mt = fmaxf(fmaxf(fmaxf(s[0], s[1]), fmaxf(s[2], s[3])), fmaxf(fmaxf(s[4], s[5]), fmaxf(s[6], s[7])));
                mt = fmaxf(mt, __shfl_xor(mt, 16)); mt = fmaxf(mt, __shfl_xor(mt, 32));
                if (__any(mt > m[q])) { const float mn = fmaxf(m[q], mt); const float alpha = __builtin_amdgcn_exp2f(m[q] - mn); m[q] = mn; l[q] *= alpha;
#pragma unroll
                    for (int dt = 0; dt < 8; ++dt) o[q][dt] *= alpha; }
                float ps = 0.f;
#pragma unroll
                for (int j = 0; j < 8; ++j) { s[j] = __builtin_amdgcn_exp2f(s[j] - m[q]); ps += s[j]; }
                l[q] += ps;
                v4u pk; pk.x = cvt_pk(s[0], s[1]); pk.y = cvt_pk(s[2], s[3]); pk.z = cvt_pk(s[4], s[5]); pk.w = cvt_pk(s[6], s[7]);
                pb[q] = __builtin_bit_cast(bf16x8, pk);
            }
#pragma unroll
            for (int dt = 0; dt < 8; ++dt) { const bf16x8 vf = tr_pair(Vt + voff, dt * 32, dt * 32 + 16 * KSTR);
#pragma unroll
                for (int q = 0; q < MQ; ++q) o[q][dt] = __builtin_amdgcn_mfma_f32_16x16x32_bf16(vf, pb[q], o[q][dt], 0, 0, 0); }
            }
        }
        if (t + 1 < NT) { *(LAS v4u*)(lds + bufn * 2 * TILE_B + soff) = ks_; *(LAS v4u*)(lds + bufn * 2 * TILE_B + TILE_B + soff) = vs_; }
        __syncthreads();
      }
    }
#undef MX_TILE_ROW
#pragma unroll
    for (int q = 0; q < MQ; ++q) { float lt = l[q]; lt += __shfl_xor(lt, 16); lt += __shfl_xor(lt, 32); const float inv = 1.f / lt;
        bf16* yp = Y + (size_t)qrow[q] * D + ycol[q] + 4 * fq;
#pragma unroll
        for (int dt = 0; dt < 8; ++dt) { v2u w2; w2.x = cvt_pk(o[q][dt][0] * inv, o[q][dt][1] * inv); w2.y = cvt_pk(o[q][dt][2] * inv, o[q][dt][3] * inv); *(GAS v2u*)(yp + 16 * dt) = w2; } }
}

__device__ __forceinline__ void sgu_unit(Frame& F, const bf16* P, bf16* Y, int chunk, int g, const float* lng, const float* Ws, const float* bs) {
    LAS unsigned char* lds = F.lds; const int lane = F.lane, w = F.wave, fr = lane & 15, fq = lane >> 4, tid = F.tid;
    const int row0 = chunk * 128;
    __syncthreads();
    { const int c8 = tid & 15; f32x4 g0 = *(const f32x4*)(lng + g * 128 + 8 * c8), g1 = *(const f32x4*)(lng + g * 128 + 8 * c8 + 4);
#pragma unroll
      for (int p = 0; p < 4; ++p) { const int j = 32 * p + (tid >> 4);
          const v4u raw = *(const v4u*)(P + (size_t)(row0 + j) * INW + 512 + g * 128 + 8 * c8); const unsigned rw[4] = {raw.x, raw.y, raw.z, raw.w};
          float v[8]; float s = 0.f;
#pragma unroll
          for (int q = 0; q < 4; ++q) { v[2 * q] = __uint_as_float(rw[q] << 16); v[2 * q + 1] = __uint_as_float(rw[q] & 0xffff0000u); s += v[2 * q] + v[2 * q + 1]; }
          s += __shfl_xor(s, 1); s += __shfl_xor(s, 2); s += __shfl_xor(s, 4); s += __shfl_xor(s, 8);
          const float mu = s * (1.f / 128.f); float qq = 0.f;
#pragma unroll
          for (int q = 0; q < 8; ++q) { v[q] -= mu; qq += v[q] * v[q]; }
          qq += __shfl_xor(qq, 1); qq += __shfl_xor(qq, 2); qq += __shfl_xor(qq, 4); qq += __shfl_xor(qq, 8);
          const float r = rsqrtf(qq * (1.f / 128.f) + EPS);
          v4u ov; ov.x = pk2(v[0] * r * g0.x, v[1] * r * g0.y); ov.y = pk2(v[2] * r * g0.z, v[3] * r * g0.w); ov.z = pk2(v[4] * r * g1.x, v[5] * r * g1.y); ov.w = pk2(v[6] * r * g1.z, v[7] * r * g1.w);
          *(LAS v4u*)(lds + OFF_VH + j * KSTR + 16 * c8) = ov; } }
    bf16x8 wf[4];
#pragma unroll
    for (int kk = 0; kk < 4; ++kk) { const float* wp = Ws + ((size_t)g * 128 + 16 * w + fr) * 128 + 32 * kk + 8 * fq; const f32x4 a = *(const f32x4*)wp, b = *(const f32x4*)(wp + 4);
        v4u pk; pk.x = pk2(a.x, a.y); pk.y = pk2(a.z, a.w); pk.z = pk2(b.x, b.y); pk.w = pk2(b.z, b.w); wf[kk] = __builtin_bit_cast(bf16x8, pk); }
    __syncthreads();
    const int voff = (8 * fq + (fr >> 2)) * KSTR + (fr & 3) * 8;
    f32x4 acc[8];
#pragma unroll
    for (int ct = 0; ct < 8; ++ct) { acc[ct] = (f32x4){0.f, 0.f, 0.f, 0.f};
#pragma unroll
        for (int kk = 0; kk < 4; ++kk) { const bf16x8 af = tr_pair(lds + OFF_VH + voff, kk * 32 * KSTR + ct * 32, kk * 32 * KSTR + 4 * KSTR + ct * 32);
            acc[ct] = __builtin_amdgcn_mfma_f32_16x16x32_bf16(af, wf[kk], acc[ct], 0, 0, 0); } }
    const int pos = row0 + 16 * w + fr; const float bias = bs[g * 128 + 16 * w + fr];
    v2u uq[8];
#pragma unroll
    for (int ct = 0; ct < 8; ++ct) uq[ct] = *(const v2u*)(P + (size_t)pos * INW + g * 128 + 16 * ct + 4 * fq);
#pragma unroll
    for (int ct = 0; ct < 8; ++ct) { const int col = g * 128 + 16 * ct + 4 * fq; const v2u uu = uq[ct];
        const float u0 = __uint_as_float(uu.x << 16), u1 = __uint_as_float(uu.x & 0xffff0000u), u2 = __uint_as_float(uu.y << 16), u3 = __uint_as_float(uu.y & 0xffff0000u);
        v2u ov; ov.x = cvt_pk(u0 * (acc[ct][0] + bias), u1 * (acc[ct][1] + bias)); ov.y = cvt_pk(u2 * (acc[ct][2] + bias), u3 * (acc[ct][3] + bias));
        *(GAS v2u*)(Y + (size_t)pos * D + col) = ov; }
}
}

template <int L> __device__ __forceinline__ void p_mixers(Frame& F, gu32* qhead) {
    const bf16* P = (const bf16*)(F.ws + WS_P); bf16* Y = (bf16*)(F.ws + WS_Y);
    const float* sink = F.in[14] + L * 6; const float* rpb = F.in[15] + L * 6 * 15 * 31;
    const float* lng = F.in[11] + L * 512; const float* Ws = F.in[12] + (size_t)L * 4 * 128 * 128; const float* bs = F.in[13] + L * 512;
    constexpr int N_NA = 192, N_WA = 128, N_CB = L == 0 ? 4 : 0, N_CC = L == 0 ? 6 : 0, N_SGU = (L == 0 ? 66 : 64) * 4;
    constexpr int NU = N_NA + N_WA + N_CB + N_CC + N_SGU;
    constexpr int CV_BASE = L == 0 ? QB_MX0 : QB_MX1, CV_N = L == 0 ? Q_MX0 : Q_MX1;
    volatile LAS int* tk = (volatile LAS int*)(F.MISC + 16);
    if (F.tid == 0) tk[0] = (int)__hip_atomic_fetch_add(qhead, 1u, RLX_AGENT);
    __syncthreads();
    int cur = tk[0];
    while (cur < NU) {
        unsigned nxt = 0u;
        if (F.tid == 0) nxt = __hip_atomic_fetch_add(qhead, 1u, RLX_AGENT);
        int u = cur;
        if (u < N_NA) { mx::attn_unit<1>(F, P, Y, u / 32, 4 * (u % 32), 1, sink, rpb); }
        else if ((u -= N_NA) < N_WA) { mx::attn_unit<0>(F, P, Y, 128 * (u >> 1), u & 1, 1, sink, rpb); }
        else if ((u -= N_WA) < N_CB) { mx::attn_unit<0>(F, P, Y, SEQ + 128 * (u >> 1), u & 1, 0, sink, rpb); }
        else if ((u -= N_CB) < N_CC) { mx::attn_unit<1>(F, P, Y, u, 0, 0, sink, rpb); }
        else { u -= N_CC; mx::sgu_unit(F, P, Y, u >> 2, u & 3, lng, Ws, bs); }
        __syncthreads();
        if (F.tid == 0) tk[0] = (int)nxt;
        __syncthreads();
        cur = tk[0];
    }
    { gu32* qcv = qhead + 256; LAS float* scr = (LAS float*)(F.lds + 32768 + F.wave * 8704);
      __syncthreads();
      if (F.tid == 0) tk[0] = (int)__hip_atomic_fetch_add(qcv, 1u, RLX_AGENT);
      __syncthreads();
      int cv = tk[0];
      while (cv < CV_N) {
          unsigned nx = 0u;
          if (F.tid == 0) nx = __hip_atomic_fetch_add(qcv, 1u, RLX_AGENT);
          conv_moved(F, scr, (CV_BASE + cv) * NWAVES + F.wave);
          __syncthreads();
          if (F.tid == 0) tk[0] = (int)nx;
          __syncthreads();
          cv = tk[0];
      } }
}

enum { PH_PRO = 0, PH_T0, PH_G1_0, PH_MX_0, PH_G2_0, PH_T2_0, PH_G3_0, PH_G4_0, PH_T3_0, PH_G1_1, PH_MX_1, PH_G2_1, PH_T2_1, PH_RT, PH_G3_1, PH_G4_1, PH_T3_1, NPH };
#ifndef MK_SPLIT
#define MK_SPLIT 0
#endif
struct Args { const float* in[22]; float* out; unsigned char* ws; int ph_lo, ph_hi, li, pad; };
__global__ void __launch_bounds__(NTHR, 2) mk_fwd(Args args) {
    extern __shared__ __attribute__((aligned(16))) unsigned char lds[];
    Frame F;
    F.lds = (LAS unsigned char*)lds; F.MISC = (volatile LAS unsigned*)(F.lds + MISC_OFF);
    F.tid = threadIdx.x; F.lane = F.tid & 63; F.wave = __builtin_amdgcn_readfirstlane(F.tid >> 6);
    F.G = gridDim.x; { const int bx = blockIdx.x; F.vcu = (F.G % 8 == 0) ? (bx % 8) * (F.G / 8) + bx / 8 : bx; }
    F.ws = args.ws; F.out = args.out; F.ctl = (gu32*)(args.ws + WS_CTL);
#pragma unroll
    for (int i = 0; i < 22; ++i) F.in[i] = args.in[i];
    for (int u = F.tid; u < (LDS_BYTES - LDSCTL_OFF) / 4; u += NTHR) ((LAS unsigned*)(F.lds + LDSCTL_OFF))[u] = 0u;
    __syncthreads();
    XcdBarrier bar; bar.bar = (unsigned*)(F.ctl + CW_BAR); bar.x = 0; bar.st = nullptr;
    if (!MK_SPLIT) bar = xcd_barrier_post((unsigned*)(F.ctl + CW_BAR), F.MISC + 8);
    const int lo = args.ph_lo, hi = args.ph_hi;
#define IN(k) (lo <= (k) && (k) < hi)
#define PH_BEGIN() do { int l_; asm volatile("v_mbcnt_lo_u32_b32 %0, -1, 0\n\tv_mbcnt_hi_u32_b32 %0, -1, %0" : "=v"(l_)); F.lane = l_; F.tid = F.wave * 64 + l_; } while (0)
#define SEAM(k) do { if (IN(k) && IN((k) + 1)) xcd_barrier(bar); } while (0)
    float* MOD = (float*)(F.ws + WS_MOD); bf16* H = (bf16*)(F.ws + WS_H); bf16* P = (bf16*)(F.ws + WS_P); bf16* Y = (bf16*)(F.ws + WS_Y); bf16* Y2 = (bf16*)(F.ws + WS_Y2); bf16* XB = (bf16*)(F.ws + WS_XB);
    bf16* PART = (bf16*)(F.ws + WS_PART); bf16* ACT = (bf16*)(F.ws + WS_ACT); unsigned char* HP = F.ws + WS_HP; float* Z = (float*)(F.ws + WS_Z);
    int* tok_e = (int*)(F.ws + WS_TOKE); float* tok_w = (float*)(F.ws + WS_TOKW); int* slot_of = (int*)(F.ws + WS_SLOT); int* pstart = (int*)(F.ws + WS_PSTART);
    const float* cosT = (const float*)(F.ws + WS_ROPE); const float* sinT = cosT + 4096;
    const pg8::bf16_t* Wt_in = (const pg8::bf16_t*)(F.ws + WS_WIN); const pg8::bf16_t* Wt_out = (const pg8::bf16_t*)(F.ws + WS_WOUT);
    PG8_LAS unsigned char* ring = (PG8_LAS unsigned char*)F.lds;

    PH_BEGIN(); if (IN(PH_PRO)) { p_prologue(F); } SEAM(PH_PRO);
    PH_BEGIN(); if (IN(PH_T0)) { p_prenorm0(F); } SEAM(PH_T0);
    PH_BEGIN(); if (IN(PH_G1_0)) { pg8::Gemm g{H, Wt_in, MROWS, INW, D, 0}; pg8::StaticOrder S; S.init(MROWS, INW, D / 64, F.G == 256 ? 200 : F.G, (int)blockIdx.x); pg8::EpiInProjRope E{P, INW, cosT, sinT, SEQ};
        pg8::TableOrder TS; TS.build(S, (volatile PG8_LAS int*)(F.MISC + 64)); pg8::gemm_phase<pg8::EpiInProjRope, pg8::TableOrder, true, true>(ring, g, TS, E); conv_queue(F, F.ctl + CW_QUEUE + 512, QB_G10, Q_G10); } SEAM(PH_G1_0);
    PH_BEGIN(); if (IN(PH_MX_0)) { p_mixers<0>(F, F.ctl + CW_QUEUE); } SEAM(PH_MX_0);
    PH_BEGIN(); if (IN(PH_G2_0)) { pg8::Gemm g{Y, Wt_out, MROWS, D, D, 0}; pg8::DenseSplitOrder S; S.init(D, D / 64, F.G, (int)blockIdx.x, 8); pg8::EpiB16 E{Y2, D, PART, (size_t)CTX * D, SEQ, 1.f};
        pg8::TableOrder TS; TS.build(S, (volatile PG8_LAS int*)(F.MISC + 64)); pg8::gemm_phase<pg8::EpiB16, pg8::TableOrder, true, true>(ring, g, TS, E); } SEAM(PH_G2_0);
    PH_BEGIN(); if (IN(PH_T2_0)) { p_post<true>(F, Y2, F.in[7], 2 * D, MOD, F.in[0], F.in[2], XB, MROWS, F.in[8], MOD, 3 * D, 4 * D, H, nullptr, tok_e, tok_w, PART, 7); } SEAM(PH_T2_0);
    PH_BEGIN(); if (IN(PH_G3_0)) { pg8::Gemm g{H, (const pg8::bf16_t*)(F.ws + WS_WGU), MROWS, 2 * FFN, D, 0}; pg8::StaticOrder S; S.init(MROWS, 2 * FFN, D / 64, F.G == 256 ? 232 : F.G, (int)blockIdx.x); pg8::EpiSwiGLU E{ACT, FFN};
        pg8::TableOrder TS; TS.build(S, (volatile PG8_LAS int*)(F.MISC + 64)); pg8::gemm_phase<pg8::EpiSwiGLU, pg8::TableOrder, true, true>(ring, g, TS, E); conv_queue(F, F.ctl + CW_QUEUE + 576, QB_G30, Q_G30); } SEAM(PH_G3_0);
    PH_BEGIN(); if (IN(PH_G4_0)) { pg8::Gemm g{ACT, (const pg8::bf16_t*)(F.ws + WS_WDN), MROWS, D, FFN, 0}; pg8::DenseSplitOrder S; S.init(D, FFN / 64, F.G, (int)blockIdx.x, 14); pg8::EpiB16 E{Y2, D, PART, (size_t)CTX * D, SEQ, 1.f};
        pg8::TableOrder TS; TS.build(S, (volatile PG8_LAS int*)(F.MISC + 64)); pg8::gemm_phase<pg8::EpiB16, pg8::TableOrder, true, true>(ring, g, TS, E); conv_queue(F, F.ctl + CW_QUEUE + 640, QB_G40, Q_G40); } SEAM(PH_G4_0);
    PH_BEGIN(); if (IN(PH_T3_0)) { p_post<false>(F, Y2, F.in[9], 5 * D, MOD, nullptr, nullptr, XB, MROWS, F.in[6] + D, MOD + 2 * 6 * D, 0 * D, 1 * D, H, nullptr, tok_e, tok_w, PART, 13); } SEAM(PH_T3_0);
    PH_BEGIN(); if (IN(PH_G1_1)) { pg8::Gemm g{H, Wt_in + (size_t)INW * D, MROWS, INW, D, 0}; pg8::InProjLastOrder S; S.init(F.G == 256 ? 200 : F.G, (int)blockIdx.x); pg8::EpiInProjRope E{P, INW, cosT, sinT, SEQ};
        pg8::TableOrder TS; TS.build(S, (volatile PG8_LAS int*)(F.MISC + 64)); pg8::gemm_phase<pg8::EpiInProjRope, pg8::TableOrder, true, true>(ring, g, TS, E); conv_queue(F, F.ctl + CW_QUEUE + 704, QB_G11, Q_G11); } SEAM(PH_G1_1);
    PH_BEGIN(); if (IN(PH_MX_1)) { p_mixers<1>(F, F.ctl + CW_QUEUE + 64); } SEAM(PH_MX_1);
    PH_BEGIN(); if (IN(PH_G2_1)) { pg8::Gemm g{Y, Wt_out + (size_t)D * D, SEQ, D, D, 0}; pg8::StaticOrder S; S.init(SEQ, D, D / 64, F.G, (int)blockIdx.x); pg8::EpiB16 E{Y2, D, PART, 0, 0, 1.f};
        pg8::TableOrder TS; TS.build(S, (volatile PG8_LAS int*)(F.MISC + 64)); pg8::gemm_phase<pg8::EpiB16, pg8::TableOrder, true, true>(ring, g, TS, E); } SEAM(PH_G2_1);
    PH_BEGIN(); if (IN(PH_T2_1)) { p_post<false>(F, Y2, F.in[7] + D, 2 * D, MOD + 2 * 6 * D, nullptr, nullptr, XB, SEQ, F.in[8] + D, MOD + 2 * 6 * D, 3 * D, 4 * D, H, F.in[19], tok_e, tok_w, PART, 0); } SEAM(PH_T2_1);
    PH_BEGIN(); if (IN(PH_RT)) { p_route(F); } SEAM(PH_RT);
    PH_BEGIN(); if (IN(PH_G3_1)) { pg8::Gemm g{HP, F.ws + WS_MGU, MAXSLOT, 2 * FFN, D, (size_t)2 * FFN * D}; pg8::GroupedOrder S; S.init(pstart, (volatile PG8_LAS int*)(F.MISC + 32), 2 * FFN, D / 128, F.G, (int)blockIdx.x);
        pg8::EpiSwiGLU8 E{(unsigned char*)ACT, FFN, 1.f / (S_H8 * S_WGU8), S_ACT8};
        pg8::TableOrder TS; TS.build(S, (volatile PG8_LAS int*)(F.MISC + 64)); pg8::gemm_phase<pg8::EpiSwiGLU8, pg8::TableOrder, true, true, 1>(ring, g, TS, E); } SEAM(PH_G3_1);
    PH_BEGIN(); if (IN(PH_G4_1)) { pg8::Gemm g{ACT, F.ws + WS_MDN, MAXSLOT, D, FFN, (size_t)D * FFN}; pg8::GroupedSplitOrder S; S.init(pstart, (volatile PG8_LAS int*)(F.MISC + 32), D, FFN / 128, F.G, (int)blockIdx.x);
        pg8::EpiB16 E{Y2, D, PART, (size_t)S.r * 256 * D, S.Pf * 256, 1.f / (S_ACT8 * S_WDN8)};
        pg8::TableOrder TS; TS.build(S, (volatile PG8_LAS int*)(F.MISC + 64)); pg8::gemm_phase<pg8::EpiB16, pg8::TableOrder, true, true, 1>(ring, g, TS, E); } SEAM(PH_G4_1);
    PH_BEGIN(); if (IN(PH_T3_1)) { p_combine(F, Y2, slot_of, tok_w, F.in[9] + D, MOD + 2 * 6 * D + 5 * D, XB, F.out, PART, pstart); }
#undef IN
#undef SEAM
}

extern "C" void kernel_launch(void* const* d_in, const int* in_sizes, int n_in, void* d_out, int out_size, void* d_ws, size_t ws_size, hipStream_t stream) {
    static int grid = 0;
    if (grid == 0) {
        if (n_in != 22 || out_size != SEQ * D || ws_size < WS_END) { fprintf(stderr, "kernel_launch: unexpected arguments (n_in %d, out %d, ws %zu < %zu); nothing launched\n", n_in, out_size, ws_size, (size_t)WS_END); grid = -1; return; }
        int dev = 0, cus = 0, per_cu = 0;
        if (hipGetDevice(&dev) != hipSuccess || hipDeviceGetAttribute(&cus, hipDeviceAttributeMultiprocessorCount, dev) != hipSuccess) { grid = -1; return; }
        if (hipFuncSetAttribute((const void*)mk_fwd, hipFuncAttributeMaxDynamicSharedMemorySize, LDS_BYTES) != hipSuccess) { fprintf(stderr, "kernel_launch: hipFuncSetAttribute failed\n"); grid = -1; return; }
        if (hipOccupancyMaxActiveBlocksPerMultiprocessor(&per_cu, (const void*)mk_fwd, NTHR, LDS_BYTES) != hipSuccess || per_cu < 1) { fprintf(stderr, "kernel_launch: occupancy query says %d blocks per CU\n", per_cu); }
        (void)hipGetLastError();
        grid = cus;
    }
    if (grid < 0) return;
    (void)hipMemsetAsync((char*)d_ws + WS_CTL, 0, CTL_ZERO_BYTES, stream);
    Args a{};
    for (int i = 0; i < 22; ++i) a.in[i] = (const float*)d_in[i];
    a.out = (float*)d_out; a.ws = (unsigned char*)d_ws; a.li = 0; a.pad = 0;
#if MK_SPLIT
    for (int p = 0; p < NPH; ++p) { a.ph_lo = p; a.ph_hi = p + 1; hipLaunchKernelGGL(mk_fwd, dim3(grid), dim3(NTHR), LDS_BYTES, stream, a); }
#else
    a.ph_lo = 0; a.ph_hi = NPH; hipLaunchKernelGGL(mk_fwd, dim3(grid), dim3(NTHR), LDS_BYTES, stream, a);
#endif
}
```

```cpp
#include <hip/hip_runtime.h>
#include <cstdio>
#include <cstdint>
namespace pg8 {
#define PG8_LAS __attribute__((address_space(3)))
typedef unsigned short bf16_t;
typedef short bf16x8 __attribute__((ext_vector_type(8)));
typedef float f32x4 __attribute__((ext_vector_type(4)));
typedef unsigned u32x4 __attribute__((ext_vector_type(4)));
typedef int i32x4 __attribute__((ext_vector_type(4)));
typedef int i32x8 __attribute__((ext_vector_type(8)));
__device__ __forceinline__ bf16x8 as_bf16x8(i32x4 v) { return __builtin_bit_cast(bf16x8, v); }
constexpr int BM = 256, BK = 64, HALF = 128, HTB = HALF * BK * 2  , STAGE_BYTES = 8 * HTB, NXCD = 8, WGM = 8;

__host__ __device__ __forceinline__ int lds_byte(int r, int c) { const int st = (r >> 4) * 2 + (c >> 5), rr = r & 15, cc = c & 31, ob = rr * 64 + cc * 2; return st * 1024 + (ob ^ (((ob >> 9) & 1) << 5)); }
__host__ __device__ __forceinline__ void stage_rc(int b, int& R, int& C) { const int st = b / 1024, sb = b % 1024, swz = sb ^ (((sb >> 9) & 1) << 5); R = (st >> 1) * 16 + swz / 64; C = (st & 1) * 32 + (swz % 64) / 2; }
__host__ __device__ __forceinline__ int perm32(int rho) { const int n = rho >> 4, i = rho & 15; return 8 * (i >> 2) + 4 * n + (i & 3); }

__host__ __device__ __forceinline__ int sigma128(int s) { const int wc = s >> 5, n = (s >> 4) & 1, q4 = s & 15; return 64 * (wc >> 1) + 32 * n + 16 * (wc & 1) + q4; }

struct Unit { int pm, pn, eks, nt; __device__ __host__ __forceinline__ int e() const { return eks & 0xff; } __device__ __host__ __forceinline__ int ks() const { return eks >> 8; } };
struct Gemm { const void* A; const void* Bt; int M, N, K; size_t estride; };

struct StaticOrder {
    int nM, nN, nwg, G, c, ntK;
    __host__ __device__ __forceinline__ void init(int M, int N, int ntK_, int G_, int c_) { nM = M / BM; nN = N / BM; nwg = nM * nN; G = G_; c = c_; ntK = ntK_; }
    __host__ __device__ __forceinline__ bool next(int i, Unit& u) const {
        const long L = (long)i * G + c; if (L >= nwg || c >= G) return false;
        int wgid = (int)L; { const int q = nwg / NXCD, r = nwg % NXCD, xcd = wgid % NXCD, off = wgid / NXCD; wgid = (xcd < r ? xcd * (q + 1) : r * (q + 1) + (xcd - r) * q) + off; }
        const int nig = WGM * nN, gid = wgid / nig, fm = gid * WGM, gsz = (nM - fm) < WGM ? (nM - fm) : WGM;
        u.pm = fm + ((wgid % nig) % gsz); u.pn = (wgid % nig) / gsz; u.eks = 0; u.nt = ntK; return true;
    }
    __device__ __forceinline__ void a_ready(const Unit&) const {}
    __device__ __forceinline__ void done(const Unit&) const {}
};

struct GroupedOrder {
    int nN, nwg, G, c, ntK; const volatile PG8_LAS int* ps;
    __device__ __forceinline__ void init(const int* pstart, volatile PG8_LAS int* tab, int N, int ntK_, int G_, int c_, int plim = 1 << 30) { nN = N / BM; G = G_; c = c_; ntK = ntK_;
        if (threadIdx.x < 9) { const int p = pstart[threadIdx.x]; tab[threadIdx.x] = p < plim ? p : plim; }
        __syncthreads(); ps = tab; nwg = __builtin_amdgcn_readfirstlane(tab[8]) * nN; }
    __device__ __forceinline__ bool next(int i, Unit& u) const {
        const long L = (long)i * G + c; if (L >= nwg) return false;
        int wgid = (int)L; { const int q = nwg / NXCD, r = nwg % NXCD, xcd = wgid % NXCD, off = wgid / NXCD; wgid = (xcd < r ? xcd * (q + 1) : r * (q + 1) + (xcd - r) * q) + off; }
        int e = 0, s0 = 0, np = 1;
#pragma unroll
        for (int k = 0; k < 8; ++k) { const int a = __builtin_amdgcn_readfirstlane(ps[k]), b = __builtin_amdgcn_readfirstlane(ps[k + 1]); if (wgid >= a * nN && wgid < b * nN) { e = k; s0 = a; np = b - a; } }
        const int r = wgid - s0 * nN;
        const int nig = WGM * nN, gid = r / nig, fm = gid * WGM, gsz = (np - fm) < WGM ? (np - fm) : WGM;
        u.pm = s0 + fm + ((r % nig) % gsz); u.pn = (r % nig) / gsz; u.eks = e; u.nt = ntK; return true;
    }
    __device__ __forceinline__ void a_ready(const Unit&) const {}
    __device__ __forceinline__ void done(const Unit&) const {}
};

struct TableOrder {
    const volatile PG8_LAS int* tab;
    template <class Sched> __device__ __forceinline__ void build(const Sched& S, volatile PG8_LAS int* t) {
        if (threadIdx.x < 32) { Unit u; u.pm = 0; u.pn = 0; u.eks = 0; u.nt = 0; const bool ok = S.next((int)threadIdx.x, u);
            t[4 * threadIdx.x + 0] = ok ? u.pm : -1; t[4 * threadIdx.x + 1] = u.pn; t[4 * threadIdx.x + 2] = u.eks; t[4 * threadIdx.x + 3] = u.nt; }
        __syncthreads(); tab = t; }
    __device__ __forceinline__ bool next(int i, Unit& u) const {
        if (i >= 32) return false;
        const i32x4 e = *(const PG8_LAS i32x4*)(tab + 4 * i);
        const int pm = __builtin_amdgcn_readfirstlane(e.x);
        u.pm = pm; u.pn = __builtin_amdgcn_readfirstlane(e.y); u.eks = __builtin_amdgcn_readfirstlane(e.z); u.nt = __builtin_amdgcn_readfirstlane(e.w);
        return pm >= 0; }
    __device__ __forceinline__ void a_ready(const Unit&) const {}
    __device__ __forceinline__ void done(const Unit&) const {}
};

typedef __bf16 bf16v2_t __attribute__((ext_vector_type(2))); typedef float f32v2_t __attribute__((ext_vector_type(2)));
__device__ __forceinline__ unsigned cvt_pk_bf16(float lo, float hi) { const f32v2_t v = {lo, hi}; const bf16v2_t b = __builtin_convertvector(v, bf16v2_t); return __builtin_bit_cast(unsigned, b); }
__device__ __forceinline__ float gelu_tanh(float x) { const float t = x + 0.044715f * x * x * x; const float e = __builtin_amdgcn_exp2f(-2.3022082f * t); return x * __builtin_amdgcn_rcpf(1.0f + e); }
__device__ __forceinline__ float silu_f(float x) { const float e = __builtin_amdgcn_exp2f(-1.44269504f * x); return x * __builtin_amdgcn_rcpf(1.0f + e); }

struct EpiF32 {
    static constexpr int PERM = 0; static constexpr bool AFTER_DRAIN = false;
    float* C; int ldc; float* Cpart; size_t part_stride; int part_row0; float oscale;
    __device__ __forceinline__ void operator()(const f32x4 (&acc)[2][2][4][2], const Unit& u, int wr, int wc, int fr, int fq) const {
        const int row0 = u.pm * BM + wr * 64 + fr, col0 = u.pn * BM + wc * 32 + 4 * fq;
        const int ks = u.ks(); float* base = ks == 0 ? C + (size_t)row0 * ldc : Cpart + (size_t)(ks - 1) * part_stride + (size_t)(row0 - part_row0) * ldc;
#pragma unroll
        for (int ai = 0; ai < 2; ++ai)
#pragma unroll
            for (int m = 0; m < 4; ++m) { float* rowp = base + (size_t)(ai * HALF + m * 16) * ldc + col0;
#pragma unroll
                for (int bj = 0; bj < 2; ++bj)
#pragma unroll
                    for (int n = 0; n < 2; ++n) *(f32x4*)(rowp + bj * HALF + n * 16) = acc[ai][bj][m][n] * oscale; }
    }
};
struct EpiB16 {
    static constexpr int PERM = 1; static constexpr bool AFTER_DRAIN = false;
    bf16_t* C; int ldc; bf16_t* Cpart; size_t part_stride; int part_row0; float oscale;
    __device__ __forceinline__ void operator()(const f32x4 (&acc)[2][2][4][2], const Unit& u, int wr, int wc, int fr, int fq) const {
        const int row0 = u.pm * BM + wr * 64 + fr, col0 = u.pn * BM + wc * 32 + 8 * fq;
        const int ks = u.ks(); bf16_t* base = ks == 0 ? C + (size_t)row0 * ldc : Cpart + (size_t)(ks - 1) * part_stride + (size_t)(row0 - part_row0) * ldc;
#pragma unroll
        for (int ai = 0; ai < 2; ++ai)
#pragma unroll
            for (int m = 0; m < 4; ++m) { bf16_t* rowp = base + (size_t)(ai * HALF + m * 16) * ldc + col0;
#pragma unroll
                for (int bj = 0; bj < 2; ++bj) { const f32x4 v0 = acc[ai][bj][m][0] * oscale, v1 = acc[ai][bj][m][1] * oscale;
                    u32x4 w; w.x = cvt_pk_bf16(v0[0], v0[1]); w.y = cvt_pk_bf16(v0[2], v0[3]); w.z = cvt_pk_bf16(v1[0], v1[1]); w.w = cvt_pk_bf16(v1[2], v1[3]);
                    *(u32x4*)(rowp + bj * HALF) = w; } }
    }
};
struct EpiInProj {
    static constexpr int PERM = 1; static constexpr bool AFTER_DRAIN = false;
    bf16_t* O; int ldc; int gelu_tiles;
    __device__ __forceinline__ void operator()(const f32x4 (&acc)[2][2][4][2], const Unit& u, int wr, int wc, int fr, int fq) const {
        const int row0 = u.pm * BM + wr * 64 + fr, col0 = u.pn * BM + wc * 32 + 8 * fq; const bool act = u.pn < gelu_tiles;
#pragma unroll
        for (int ai = 0; ai < 2; ++ai)
#pragma unroll
            for (int m = 0; m < 4; ++m) { bf16_t* rowp = O + (size_t)(row0 + ai * HALF + m * 16) * ldc + col0;
#pragma unroll
                for (int bj = 0; bj < 2; ++bj) { f32x4 v0 = acc[ai][bj][m][0], v1 = acc[ai][bj][m][1];
                    if (act) {
#pragma unroll
                        for (int j = 0; j < 4; ++j) { v0[j] = gelu_tanh(v0[j]); v1[j] = gelu_tanh(v1[j]); } }
                    u32x4 w; w.x = cvt_pk_bf16(v0[0], v0[1]); w.y = cvt_pk_bf16(v0[2], v0[3]); w.z = cvt_pk_bf16(v1[0], v1[1]); w.w = cvt_pk_bf16(v1[2], v1[3]);
                    *(u32x4*)(rowp + bj * HALF) = w; } }
    }
};
struct EpiSwiGLU {
    static constexpr int PERM = 1; static constexpr bool AFTER_DRAIN = false;
    bf16_t* O; int ldc;
    __device__ __forceinline__ void operator()(const f32x4 (&acc)[2][2][4][2], const Unit& u, int wr, int wc, int fr, int fq) const {
        const int row0 = u.pm * BM + wr * 64 + fr, col0 = u.pn * HALF + wc * 32 + 8 * fq;
#pragma unroll
        for (int ai = 0; ai < 2; ++ai)
#pragma unroll
            for (int m = 0; m < 4; ++m) { bf16_t* rowp = O + (size_t)(row0 + ai * HALF + m * 16) * ldc + col0;
                f32x4 v0, v1;
#pragma unroll
                for (int j = 0; j < 4; ++j) { v0[j] = silu_f(acc[ai][0][m][0][j]) * acc[ai][1][m][0][j]; v1[j] = silu_f(acc[ai][0][m][1][j]) * acc[ai][1][m][1][j]; }
                u32x4 w; w.x = cvt_pk_bf16(v0[0], v0[1]); w.y = cvt_pk_bf16(v0[2], v0[3]); w.z = cvt_pk_bf16(v1[0], v1[1]); w.w = cvt_pk_bf16(v1[2], v1[3]);
                *(u32x4*)rowp = w; }
    }
};

__device__ __forceinline__ float clamp448(float x) { return __builtin_fminf(__builtin_fmaxf(x, -448.f), 448.f); }
__device__ __forceinline__ unsigned pk4_fp8(float a, float b, float c, float d) { int w = 0; w = __builtin_amdgcn_cvt_pk_fp8_f32(clamp448(a), clamp448(b), w, false); w = __builtin_amdgcn_cvt_pk_fp8_f32(clamp448(c), clamp448(d), w, true); return (unsigned)w; }
struct EpiSwiGLU8 {
    static constexpr int PERM = 1; static constexpr bool AFTER_DRAIN = false;
    unsigned char* O; int ldc; float iscale, oscale;
    __device__ __forceinline__ void operator()(const f32x4 (&acc)[2][2][4][2], const Unit& u, int wr, int wc, int fr, int fq) const {
        typedef unsigned u32x2 __attribute__((ext_vector_type(2)));
        const int row0 = u.pm * BM + wr * 64 + fr, col0 = u.pn * HALF + wc * 32 + 8 * fq;
#pragma unroll
        for (int ai = 0; ai < 2; ++ai)
#pragma unroll
            for (int m = 0; m < 4; ++m) { unsigned char* rowp = O + (size_t)(row0 + ai * HALF + m * 16) * ldc + col0;
                f32x4 v0, v1;
#pragma unroll
                for (int j = 0; j < 4; ++j) { v0[j] = silu_f(acc[ai][0][m][0][j] * iscale) * (acc[ai][1][m][0][j] * iscale) * oscale; v1[j] = silu_f(acc[ai][0][m][1][j] * iscale) * (acc[ai][1][m][1][j] * iscale) * oscale; }
                u32x2 w; w.x = pk4_fp8(v0[0], v0[1], v0[2], v0[3]); w.y = pk4_fp8(v1[0], v1[1], v1[2], v1[3]);
                *(u32x2*)rowp = w; }
    }
};
struct EpiInProjRope {
    static constexpr int PERM = 2; static constexpr bool AFTER_DRAIN = false;
    bf16_t* O; int ldc; const float* cosT; const float* sinT; int nlat;
    __device__ __forceinline__ void operator()(const f32x4 (&acc)[2][2][4][2], const Unit& u, int wr, int wc, int fr, int fq) const {
        typedef unsigned u32x2 __attribute__((ext_vector_type(2)));
        const int row0 = u.pm * BM + wr * 64 + fr, col0 = u.pn * BM + 64 * (wc >> 1) + 16 * (wc & 1) + 4 * fq;
        const bool act = u.pn < 4; const bool rope = (u.pn == 4 || u.pn == 5 || u.pn == 6 || u.pn == 10) && (u.pm * BM < nlat);
        const int fi = 16 * (wc & 1) + 4 * fq;
        f32x4 csa[8], sna[8];
#pragma unroll
        for (int q = 0; q < 8; ++q) { csa[q] = (f32x4){1.f, 1.f, 1.f, 1.f}; sna[q] = (f32x4){0.f, 0.f, 0.f, 0.f}; }
        if (rope) {
#pragma unroll
            for (int q = 0; q < 8; ++q) { const int row = row0 + (q >> 2) * HALF + (q & 3) * 16; const int pos = (wc >> 1) ? (row & 63) : (row >> 6); csa[q] = *(const f32x4*)(cosT + pos * 32 + fi); sna[q] = *(const f32x4*)(sinT + pos * 32 + fi); } }
#pragma unroll
        for (int ai = 0; ai < 2; ++ai)
#pragma unroll
            for (int m = 0; m < 4; ++m) { const int row = row0 + ai * HALF + m * 16; bf16_t* rowp = O + (size_t)row * ldc + col0;
                const f32x4 cs = csa[ai * 4 + m], sn = sna[ai * 4 + m];
#pragma unroll
                for (int bj = 0; bj < 2; ++bj) { f32x4 v0 = acc[ai][bj][m][0], v1 = acc[ai][bj][m][1];
                    if (act) {
#pragma unroll
                        for (int j = 0; j < 4; ++j) { v0[j] = gelu_tanh(v0[j]); v1[j] = gelu_tanh(v1[j]); } }
                    const f32x4 o0 = v0 * cs - v1 * sn, o1 = v0 * sn + v1 * cs;
                    u32x2 w0, w1; w0.x = cvt_pk_bf16(o0[0], o0[1]); w0.y = cvt_pk_bf16(o0[2], o0[3]); w1.x = cvt_pk_bf16(o1[0], o1[1]); w1.y = cvt_pk_bf16(o1[2], o1[3]);
                    *(u32x2*)(rowp + bj * HALF) = w0; *(u32x2*)(rowp + bj * HALF + 32) = w1; } }
    }
};
__device__ __forceinline__ int pick_split(int r, int nN, int ntK, int G) {
    int s = 1;
#define PG8_TRY(q) if (ntK % (q) == 0 && ((ntK / (q)) & 1) == 0 && ntK / (q) >= 4 && r * nN * (q) <= G) s = (q)
    PG8_TRY(2); PG8_TRY(4); PG8_TRY(7); PG8_TRY(8); PG8_TRY(14); PG8_TRY(28);
#undef PG8_TRY
    return s;
}
struct DenseSplitOrder {
    StaticOrder so; int nNc, sk, ntsub;
    __device__ __forceinline__ void init(int N, int ntK_, int G_, int c_, int sk_) { so.init(8192, N, ntK_, G_, c_); nNc = N / BM; sk = sk_; ntsub = ntK_ / sk_; }
    __device__ __forceinline__ bool next(int i, Unit& u) const {
        long L = (long)i * so.G + so.c; Unit t; t.pm = 0; t.pn = 0; t.eks = 0; t.nt = 0; bool ok;
        if (L < so.nwg) ok = so.next(i, t);
        else { L -= so.nwg; ok = L < nNc * sk; t.pm = 32; t.pn = (int)(L % nNc); t.eks = (int)(L / nNc) << 8; t.nt = ntsub; }
        u.pm = t.pm; u.pn = t.pn; u.eks = t.eks; u.nt = t.nt; return ok;
    }
    __device__ __forceinline__ void a_ready(const Unit&) const {}
    __device__ __forceinline__ void done(const Unit&) const {}
};
struct GroupedSplitOrder {
    GroupedOrder go; const volatile PG8_LAS int* ps; int Pf, r, sk, ntsub;
    __device__ __forceinline__ void init(const int* pstart, volatile PG8_LAS int* tab  , int N, int ntK_, int G_, int c_) {
        if (threadIdx.x < 9) tab[9 + threadIdx.x] = pstart[threadIdx.x];
        const int P = __builtin_amdgcn_readfirstlane(pstart[8]);
        const int nN = N / BM, ppr = G_ / nN; Pf = (P / ppr) * ppr; r = P - Pf; sk = pick_split(r, nN, ntK_, G_); ntsub = ntK_ / sk;
        go.init(pstart, tab, N, ntK_, G_, c_, Pf); ps = tab + 9;
    }
    __device__ __forceinline__ bool next(int i, Unit& u) const {
        long L = (long)i * go.G + go.c; Unit t; t.pm = 0; t.pn = 0; t.eks = 0; t.nt = 0; bool ok;
        if (L < go.nwg) ok = go.next(i, t);
        else { L -= go.nwg; const int per = go.nN * sk; ok = L < (long)r * per;
            const int pl = (int)(L / per), rem = (int)(L % per); t.pm = Pf + pl; t.pn = rem % go.nN; const int ks = rem / go.nN; t.nt = ntsub;
            int e = 0;
#pragma unroll
            for (int k = 0; k < 8; ++k) { const int a = __builtin_amdgcn_readfirstlane(ps[k]), b = __builtin_amdgcn_readfirstlane(ps[k + 1]); if (t.pm >= a && t.pm < b) e = k; }
            t.eks = e | (ks << 8); }
        u.pm = t.pm; u.pn = t.pn; u.eks = t.eks; u.nt = t.nt; return ok;
    }
    __device__ __forceinline__ void a_ready(const Unit&) const {}
    __device__ __forceinline__ void done(const Unit&) const {}
};
struct InProjLastOrder {
    StaticOrder so;
    __device__ __forceinline__ void init(int G_, int c_) { so.init(8192, 4608, 32, G_, c_); }
    __device__ __forceinline__ bool next(int i, Unit& u) const {
        const long L = (long)i * so.G + so.c; Unit t; t.pm = 0; t.pn = 0; t.eks = 0; t.nt = 0; bool ok;
        if (L < so.nwg) ok = so.next(i, t);
        else { ok = L < so.nwg + 8 && so.c < so.G; t.pm = 32; t.pn = 10 + (int)(L - so.nwg); t.eks = 0; t.nt = so.ntK; }
        u.pm = t.pm; u.pn = t.pn; u.eks = t.eks; u.nt = t.nt; return ok;
    }
    __device__ __forceinline__ void a_ready(const Unit&) const {}
    __device__ __forceinline__ void done(const Unit&) const {}
};

template <class Epi, class Sched, bool ALIGN_EPI = false, bool SP2 = false, int ES = 2>
__device__ __forceinline__ void gemm_phase(PG8_LAS unsigned char* lds, const Gemm g, const Sched& S, const Epi& E) {
    const int tid = threadIdx.x, wid = __builtin_amdgcn_readfirstlane(tid >> 6), lane = tid & 63, wr = wid >> 2, wc = wid & 3, fr = lane & 15, fq = lane >> 4;
    const int K = g.K;
    unsigned voffA[2], voffB[2];
#pragma unroll
    for (int i = 0; i < 2; ++i) { int R, C; stage_rc(tid * 16 + i * 8192, R, C); const int Rb = Epi::PERM == 1 ? ((R & ~31) + perm32(R & 31)) : (Epi::PERM == 2 ? sigma128(R) : R);
        voffA[i] = (unsigned)(R * K * ES + C * 2); voffB[i] = (unsigned)(Rb * K * ES + C * 2); }
    const size_t kstep = (size_t)(BK * 2);
    const size_t hstep = (size_t)HALF * K * ES;
    const size_t tstep = 2 * hstep;
    const unsigned ldsw = (unsigned)wid * 1024u;
    const int aoff = lds_byte(wr * 64 + fr, fq * 8), boff = lds_byte(wc * 32 + fr, fq * 8);
#define PG8_SA(b, h) (((b) * 2 + (h)) * HTB)
#define PG8_SB(b, h) ((4 + (b) * 2 + (h)) * HTB)
#define PG8_STAGE(bufoff, gbase, voff) do { _Pragma("unroll") for (int _i = 0; _i < 2; ++_i) \
        __builtin_amdgcn_global_load_lds((const unsigned*)((const char*)(gbase) + (voff)[_i]), (PG8_LAS unsigned*)(lds + (bufoff) + ldsw + _i * 8192), 16, 0, 0); } while (0)
#define PG8_LDA(dst, b, h) do { _Pragma("unroll") for (int m = 0; m < 4; ++m) { dst[m].lo = *(const PG8_LAS i32x4*)(lds + PG8_SA(b, h) + aoff + m * 2048); dst[m].hi = *(const PG8_LAS i32x4*)(lds + PG8_SA(b, h) + aoff + m * 2048 + 1024); } } while (0)
#define PG8_LDB(dst, b, h) do { _Pragma("unroll") for (int n = 0; n < 2; ++n) { dst[n].lo = *(const PG8_LAS i32x4*)(lds + PG8_SB(b, h) + boff + n * 2048); dst[n].hi = *(const PG8_LAS i32x4*)(lds + PG8_SB(b, h) + boff + n * 2048 + 1024); } } while (0)
#define PG8_MMA(ai, bj, At, Bt) do { __builtin_amdgcn_s_setprio(1); _Pragma("unroll") for (int m = 0; m < 4; ++m) _Pragma("unroll") for (int n = 0; n < 2; ++n) { \
        if constexpr (ES == 2) { acc[ai][bj][m][n] = __builtin_amdgcn_mfma_f32_16x16x32_bf16(as_bf16x8(Bt[n].lo), as_bf16x8(At[m].lo), acc[ai][bj][m][n], 0, 0, 0); \
                                 acc[ai][bj][m][n] = __builtin_amdgcn_mfma_f32_16x16x32_bf16(as_bf16x8(Bt[n].hi), as_bf16x8(At[m].hi), acc[ai][bj][m][n], 0, 0, 0); } \
        else { asm volatile("v_mfma_f32_16x16x128_f8f6f4 %0, %1, %2, %0" : "+v"(acc[ai][bj][m][n]) : "v"(Bt[n]), "v"(At[m])); } } \
        __builtin_amdgcn_s_setprio(0); } while (0)
#define PG8_WAIT_V(n) asm volatile("s_waitcnt vmcnt(" #n ")" ::: "memory")
#define PG8_WAIT_L(n) asm volatile("s_waitcnt lgkmcnt(" #n ")" ::: "memory")
#define PG8_BAR __builtin_amdgcn_s_barrier()
#define PG8_SCHED __builtin_amdgcn_sched_barrier(0)
    Unit cur, nxt; int ui = 0;
    if (!S.next(0, cur)) return;
    f32x4 acc[2][2][4][2];
#pragma unroll
    for (int a = 0; a < 2; ++a)
#pragma unroll
        for (int b = 0; b < 2; ++b)
#pragma unroll
            for (int m = 0; m < 4; ++m)
#pragma unroll
                for (int n = 0; n < 2; ++n) acc[a][b][m][n] = (f32x4){0.f, 0.f, 0.f, 0.f};
    i32x8 At[4], B0[2], B1[2];
    const char* cA = (const char*)g.A + (size_t)cur.pm * tstep + (size_t)(cur.ks() * cur.nt) * kstep; const char* cB = (const char*)g.Bt + (size_t)cur.e() * g.estride * ES + (size_t)cur.pn * tstep + (size_t)(cur.ks() * cur.nt) * kstep;
    S.a_ready(cur);
    if constexpr (SP2) {
        PG8_STAGE(PG8_SB(0, 0), cB, voffB); PG8_STAGE(PG8_SB(0, 1), cB + hstep, voffB); PG8_STAGE(PG8_SA(0, 0), cA, voffA); PG8_STAGE(PG8_SA(0, 1), cA + hstep, voffA);
        if (wr == 1) PG8_BAR;
        PG8_WAIT_V(2); PG8_BAR;
        PG8_STAGE(PG8_SB(1, 0), cB + kstep, voffB); PG8_STAGE(PG8_SA(1, 0), cA + kstep, voffA); PG8_STAGE(PG8_SB(1, 1), cB + hstep + kstep, voffB);
        PG8_WAIT_V(6); PG8_BAR;
    } else {
        PG8_STAGE(PG8_SB(0, 0), cB, voffB); PG8_STAGE(PG8_SA(0, 0), cA, voffA); PG8_STAGE(PG8_SB(0, 1), cB + hstep, voffB); PG8_STAGE(PG8_SA(0, 1), cA + hstep, voffA);
        if (wr == 1) PG8_BAR;
        PG8_WAIT_V(4); PG8_BAR;
        PG8_STAGE(PG8_SB(1, 0), cB + kstep, voffB); PG8_STAGE(PG8_SA(1, 0), cA + kstep, voffA); PG8_STAGE(PG8_SB(1, 1), cB + hstep + kstep, voffB);
        PG8_WAIT_V(6); PG8_BAR;
    }
    for (;;) {
        const bool has_next = S.next(ui + 1, nxt);
        const char* nA = has_next ? (const char*)g.A + (size_t)nxt.pm * tstep + (size_t)(nxt.ks() * nxt.nt) * kstep : cA; const char* nB = has_next ? (const char*)g.Bt + (size_t)nxt.e() * g.estride * ES + (size_t)nxt.pn * tstep + (size_t)(nxt.ks() * nxt.nt) * kstep : cB;
        const int nt = cur.nt;
        for (int t = 0; t < nt; t += 2) {
            const bool last = (t == nt - 2);
            const char* a1 = cA + (size_t)(t + 1) * kstep;
            const char* a2 = last ? nA : cA + (size_t)(t + 2) * kstep; const char* b2 = last ? nB : cB + (size_t)(t + 2) * kstep;
            const char* a3 = a2 + kstep; const char* b3 = b2 + kstep;
            if (last && has_next) S.a_ready(nxt);
            if constexpr (SP2) {
            PG8_LDB(B0, 0, 0); PG8_LDB(B1, 0, 1); PG8_SCHED; PG8_LDA(At, 0, 0); PG8_STAGE(PG8_SA(1, 1), a1 + hstep, voffA);
            PG8_WAIT_V(8); PG8_WAIT_L(0); PG8_BAR; PG8_MMA(0, 0, At, B0); PG8_MMA(0, 1, At, B1); PG8_BAR; PG8_SCHED;
            PG8_LDA(At, 0, 1); PG8_STAGE(PG8_SB(0, 0), b2, voffB); PG8_STAGE(PG8_SB(0, 1), b2 + hstep, voffB); PG8_STAGE(PG8_SA(0, 0), a2, voffA);
            PG8_WAIT_V(8); PG8_WAIT_L(0); PG8_BAR; PG8_MMA(1, 0, At, B0); PG8_MMA(1, 1, At, B1); PG8_BAR; PG8_SCHED;
            PG8_LDB(B0, 1, 0); PG8_LDB(B1, 1, 1); PG8_SCHED; PG8_LDA(At, 1, 0); PG8_STAGE(PG8_SA(0, 1), a2 + hstep, voffA);
            PG8_WAIT_V(8); PG8_WAIT_L(0); PG8_BAR; PG8_MMA(0, 0, At, B0); PG8_MMA(0, 1, At, B1); PG8_BAR; PG8_SCHED;
            PG8_LDA(At, 1, 1); PG8_STAGE(PG8_SB(1, 0), b3, voffB); PG8_STAGE(PG8_SB(1, 1), b3 + hstep, voffB); PG8_STAGE(PG8_SA(1, 0), a3, voffA);
            PG8_WAIT_V(8); PG8_WAIT_L(0); PG8_BAR; PG8_MMA(1, 0, At, B0); PG8_MMA(1, 1, At, B1); PG8_BAR; PG8_SCHED;
            } else {
            PG8_LDB(B0, 0, 0); PG8_SCHED; PG8_LDA(At, 0, 0); PG8_STAGE(PG8_SA(1, 1), a1 + hstep, voffA);
            PG8_WAIT_L(8); PG8_BAR; PG8_WAIT_L(0); PG8_MMA(0, 0, At, B0); PG8_BAR; PG8_SCHED;
            PG8_LDB(B1, 0, 1); PG8_STAGE(PG8_SB(0, 0), b2, voffB);
            PG8_BAR; PG8_WAIT_L(0); PG8_MMA(0, 1, At, B1); PG8_BAR;
            PG8_LDA(At, 0, 1); PG8_STAGE(PG8_SA(0, 0), a2, voffA);
            PG8_BAR; PG8_WAIT_L(0); PG8_MMA(1, 0, At, B0); PG8_BAR; PG8_SCHED;
            PG8_STAGE(PG8_SB(0, 1), b2 + hstep, voffB);
            PG8_WAIT_V(6); PG8_BAR; PG8_MMA(1, 1, At, B1); PG8_BAR;
            PG8_LDB(B0, 1, 0); PG8_SCHED; PG8_LDA(At, 1, 0); PG8_STAGE(PG8_SA(0, 1), a2 + hstep, voffA);
            PG8_WAIT_L(8); PG8_BAR; PG8_WAIT_L(0); PG8_MMA(0, 0, At, B0); PG8_BAR; PG8_SCHED;
            PG8_LDB(B1, 1, 1); PG8_STAGE(PG8_SB(1, 0), b3, voffB);
            PG8_BAR; PG8_WAIT_L(0); PG8_MMA(0, 1, At, B1); PG8_BAR;
            PG8_LDA(At, 1, 1); PG8_STAGE(PG8_SA(1, 0), a3, voffA);
            PG8_BAR; PG8_WAIT_L(0); PG8_MMA(1, 0, At, B0); PG8_BAR; PG8_SCHED;
            PG8_STAGE(PG8_SB(1, 1), b3 + hstep, voffB);
            PG8_WAIT_V(6); PG8_BAR; PG8_MMA(1, 1, At, B1); PG8_BAR;
            }
        }
        if constexpr (ES == 1) asm volatile("s_nop 15\n\ts_nop 15" ::: "memory");
        if constexpr (ALIGN_EPI) { if (wr == 0) PG8_BAR; }
        if constexpr (!Epi::AFTER_DRAIN) { E(acc, cur, wr, wc, fr, fq); S.done(cur); }
        if (!has_next) break;
#pragma unroll
        for (int a = 0; a < 2; ++a)
#pragma unroll
            for (int b = 0; b < 2; ++b)
#pragma unroll
                for (int m = 0; m < 4; ++m)
#pragma unroll
                    for (int n = 0; n < 2; ++n) acc[a][b][m][n] = (f32x4){0.f, 0.f, 0.f, 0.f};
        cur = nxt; cA = nA; cB = nB; ++ui;
        if constexpr (ALIGN_EPI) { if (wr == 1) PG8_BAR; }
    }
    PG8_WAIT_V(0);
    if constexpr (!ALIGN_EPI) { if (wr == 0) PG8_BAR; }
    PG8_BAR;
    if constexpr (Epi::AFTER_DRAIN) { E.fused(acc, cur, wr, wc, fr, fq, lds, wid, lane); S.done(cur); }
#undef PG8_SA
#undef PG8_SB
#undef PG8_STAGE
#undef PG8_LDA
#undef PG8_LDB
#undef PG8_MMA
#undef PG8_WAIT_V
#undef PG8_WAIT_L
#undef PG8_BAR
#undef PG8_SCHED
}
}

constexpr int D = 2048, SEQ = 8192, CTX = 256, MROWS = SEQ + CTX;
constexpr int INW = 4608, FFN = 7168, NEXP = 8;
constexpr int C_QB = 1024, C_QC = 1792, C_KB = 2560, C_VB = 2816, C_KC = 3072, C_VC = 3840;
constexpr int Y_B = 512, Y_C = 1280;
constexpr int MAXPAN = 72, MAXSLOT = MAXPAN * 256;
constexpr float EPS = 1e-6f;
constexpr float S_H8 = 16.f, S_WGU8 = 256.f, S_ACT8 = 8.f, S_WDN8 = 512.f;
constexpr int NWAVES = 8, NTHR = 512;

#define GAS __attribute__((address_space(1)))
#define LAS __attribute__((address_space(3)))
typedef unsigned short bf16;
typedef float f32x4 __attribute__((ext_vector_type(4)));
typedef unsigned v4u __attribute__((ext_vector_type(4)));
typedef unsigned v2u __attribute__((ext_vector_type(2)));
typedef short bf16x8 __attribute__((ext_vector_type(8)));
typedef short s16x4 __attribute__((ext_vector_type(4)));
typedef GAS unsigned gu32;
#define RLX_AGENT __ATOMIC_RELAXED, __HIP_MEMORY_SCOPE_AGENT
__device__ __forceinline__ float bf2f(bf16 v) { return __uint_as_float(((unsigned)v) << 16); }
__device__ __forceinline__ unsigned f2bf(float f) { unsigned u = __float_as_uint(f); return (u + 0x7fffu + ((u >> 16) & 1u)) >> 16; }
__device__ __forceinline__ unsigned pk2(float lo, float hi) { return f2bf(lo) | (f2bf(hi) << 16); }
__device__ __forceinline__ f32x4 ld4bf(const bf16* p) { const v2u u = *(const v2u*)p; return (f32x4){__uint_as_float(u.x << 16), __uint_as_float(u.x & 0xffff0000u), __uint_as_float(u.y << 16), __uint_as_float(u.y & 0xffff0000u)}; }
__device__ __forceinline__ void st4bf(bf16* p, f32x4 v) { v2u o; o.x = pk2(v.x, v.y); o.y = pk2(v.z, v.w); *(GAS v2u*)p = o; }
__device__ __forceinline__ float wave_sum(float v) {
#pragma unroll
    for (int o = 1; o < 64; o <<= 1) v += __shfl_xor(v, o);
    return v;
}

constexpr size_t MiB = 1u << 20;
constexpr size_t al(size_t x) { return (x + MiB - 1) / MiB * MiB; }
constexpr size_t WS_CTL = 0, CTL_ZERO_BYTES = 1 * MiB;
constexpr size_t WS_MOD = 1 * MiB;
constexpr size_t WS_ROPE = WS_MOD + 512 * 1024;
constexpr size_t WS_TOKE = 2 * MiB, WS_TOKW = WS_TOKE + 65536, WS_SLOT = WS_TOKW + 65536, WS_PSTART = WS_SLOT + 65536;
constexpr size_t WS_WIN = 4 * MiB;
constexpr size_t WS_WOUT = WS_WIN + al((size_t)2 * INW * D * 2);
constexpr size_t WS_WGU = WS_WOUT + al((size_t)2 * D * D * 2);
constexpr size_t WS_WDN = WS_WGU + al((size_t)2 * FFN * D * 2);
constexpr size_t WS_MGU = WS_WDN + al((size_t)D * FFN * 2);
constexpr size_t WS_MDN = WS_MGU + al((size_t)NEXP * 2 * FFN * D * 2);
constexpr size_t WS_H = WS_MDN + al((size_t)NEXP * D * FFN * 2);
constexpr size_t WS_P = WS_H + al((size_t)MROWS * D * 2);
constexpr size_t WS_Y = WS_P + al((size_t)MROWS * INW * 2);
constexpr size_t WS_Y2 = WS_Y + al((size_t)MROWS * D * 2);
constexpr size_t WS_ACT = WS_Y2 + al((size_t)MAXSLOT * D * 4);
constexpr size_t WS_HP = WS_ACT + al((size_t)MAXSLOT * FFN * 2);
constexpr size_t WS_Z = WS_HP + al((size_t)MAXSLOT * D * 2);
constexpr size_t WS_PART = WS_Z + al((size_t)CTX * D * 4);
constexpr size_t WS_XB = WS_PART + 64 * MiB;
constexpr size_t WS_END = WS_XB + al((size_t)MROWS * D * 2);
constexpr int CW_TMO = 0, CW_CODE = 1;
constexpr int CW_BAR = 4096;
constexpr int CW_CHEAD = 8192;
constexpr int CW_QUEUE = 16384;

constexpr int RING_BYTES = 131072;
constexpr int LDSCTL_OFF = RING_BYTES, MISC_OFF = LDSCTL_OFF + 320;
constexpr int LDS_BYTES = 147456;

#define XB_TMO      128
#define XB_XCNT(j)  (256  + 64 * (j))
#define XB_XSUB(j)  (1280 + 64 * (j))
#define XB_XGEN(j)  (2304 + 64 * (j))
#define XB_TOP      3328
#define XB_TOPGEN   3392
#define XCD_BAR_WORDS 3456
#define XB_SPIN_CAP (1u << 18)
__device__ __forceinline__ unsigned xb_ld(unsigned* p)              { return __hip_atomic_load(p, __ATOMIC_RELAXED, __HIP_MEMORY_SCOPE_AGENT); }
__device__ __forceinline__ unsigned xb_add(unsigned* p, unsigned v) { return __hip_atomic_fetch_add(p, v, __ATOMIC_RELAXED, __HIP_MEMORY_SCOPE_AGENT); }
__device__ __forceinline__ unsigned xb_xcc_id() { return (unsigned)__builtin_amdgcn_s_getreg((3 << 11) | 20) & 0xFu; }
#define XB_SPIN(cond, bar) do { unsigned _sp = 0; while (cond) { __builtin_amdgcn_s_sleep(1); \
    if ((++_sp & 255u) == 0u) { if (xb_ld(&(bar)[XB_TMO])) break; if (_sp > XB_SPIN_CAP) { atomicAdd(&(bar)[XB_TMO], 1u); break; } } } } while (0)
struct XcdBarrier { unsigned* bar; unsigned x; volatile LAS unsigned* st; };
__device__ __forceinline__ XcdBarrier xcd_barrier_post(unsigned* bar, volatile LAS unsigned* st) {
    XcdBarrier b; b.bar = bar; b.x = xb_xcc_id(); b.st = st;
    if (threadIdx.x == 0) (void)xb_add(&bar[XB_XCNT(b.x)], 1u);
    return b;
}
__device__ __forceinline__ void xcd_barrier_complete(unsigned* bar, unsigned x, unsigned& nloc, unsigned& nx) {
    const unsigned G = gridDim.x * gridDim.y * gridDim.z;
    unsigned sum, cnt, mine, sp = 0u;
    for (;;) {
        sum = 0u; cnt = 0u; mine = 0u;
#pragma unroll
        for (unsigned j = 0; j < 16; ++j) { const unsigned c = xb_ld(&bar[XB_XCNT(j)]); sum += c; cnt += (c > 0u) ? 1u : 0u; mine = (j == x) ? c : mine; }
        if (sum == G) break;
        __builtin_amdgcn_s_sleep(1);
        if ((++sp & 255u) == 0u) { if (xb_ld(&bar[XB_TMO])) break; if (sp > XB_SPIN_CAP) { atomicAdd(&bar[XB_TMO], 1u); break; } }
    }
    nloc = mine > 0u ? mine : 1u; nx = cnt > 0u ? cnt : 1u;
}
__device__ __forceinline__ void xcd_barrier(const XcdBarrier& b) {
    asm volatile("s_waitcnt vmcnt(0)" ::: "memory");
    __syncthreads();
    if (threadIdx.x == 0) {
        unsigned* bar = b.bar;
        __builtin_amdgcn_s_waitcnt(0);
        unsigned nloc = b.st[0], nx = b.st[1];
        if (nloc == 0u) { xcd_barrier_complete(bar, b.x, nloc, nx); b.st[0] = nloc; b.st[1] = nx; }
        const unsigned old = xb_add(&bar[XB_XSUB(b.x)], 1u);
        const unsigned gen = old / nloc;
        if (old + 1u == (gen + 1u) * nloc) {
            __builtin_amdgcn_fence(__ATOMIC_RELEASE, "agent");
            asm volatile("s_waitcnt vmcnt(0)" ::: "memory");
            const unsigned og = xb_add(&bar[XB_TOP], 1u);
            const unsigned tg = og / nx;
            if (og + 1u == (tg + 1u) * nx) xb_add(&bar[XB_TOPGEN], 1u);
            else XB_SPIN(xb_ld(&bar[XB_TOPGEN]) == tg, bar);
            __builtin_amdgcn_fence(__ATOMIC_ACQUIRE, "agent");
            xb_add(&bar[XB_XGEN(b.x)], 1u);
            asm volatile("s_waitcnt vmcnt(0)" ::: "memory");
        } else {
            XB_SPIN(xb_ld(&bar[XB_XGEN(b.x)]) == gen, bar);
            __builtin_amdgcn_fence(__ATOMIC_ACQUIRE, "agent");
            asm volatile("s_waitcnt vmcnt(0)" ::: "memory");
        }
    }
    __syncthreads();
}

struct Frame {
    LAS unsigned char* lds; volatile LAS unsigned* MISC; gu32* ctl;
    int tid, lane, wave, vcu, G;
    const float* in[22]; float* out; unsigned char* ws;
};
#define LDS_WAIT() asm volatile("s_waitcnt lgkmcnt(0)" ::: "memory")

template <int MAP> __device__ __forceinline__ int dest_row(int n) { if (MAP == 0) return n; const int b = n >= FFN, nn = n - b * FFN; return 256 * (nn >> 7) + 128 * b + (nn & 127); }
template <int MAP> __device__ __forceinline__ void conv_item(const float* W, int K, int N, bf16* WT, LAS float* scr, int item, int lane) {
    const int nblk = N / 32, kb = item / nblk, nb = item % nblk, k0 = 64 * kb, n0 = 32 * nb;
    { float t_[32];
#pragma unroll
      for (int i = 0; i < 32; ++i) { const int kk = 2 * i + (lane >> 5); t_[i] = __builtin_nontemporal_load(W + (size_t)(k0 + kk) * N + n0 + (lane & 31)); }
#pragma unroll
      for (int i = 0; i < 32; ++i) { const int kk = 2 * i + (lane >> 5); scr[kk * 33 + (lane & 31)] = t_[i]; } }
    LDS_WAIT(); asm volatile("" ::: "memory");
    const int c = lane & 7; const int r0 = dest_row<MAP>(n0);
#pragma unroll
    for (int j = 0; j < 4; ++j) { const int n = (lane >> 3) + 8 * j; const LAS float* s = scr + (8 * c) * 33 + n;
        v4u o; o.x = pk2(s[0 * 33], s[1 * 33]); o.y = pk2(s[2 * 33], s[3 * 33]); o.z = pk2(s[4 * 33], s[5 * 33]); o.w = pk2(s[6 * 33], s[7 * 33]);
        __builtin_nontemporal_store(o, (GAS v4u*)(WT + (size_t)(r0 + n) * K + k0 + 8 * c)); }
    LDS_WAIT(); asm volatile("" ::: "memory");
}
__device__ __forceinline__ unsigned pk4_fp8s(float a, float b, float c, float d, float sc) { return pg8::pk4_fp8(a * sc, b * sc, c * sc, d * sc); }
template <int MAP> __device__ __forceinline__ void conv_item8(const float* W, int K, int N, unsigned char* WT, float scale, LAS float* scr, int item, int lane) {
    const int nblk = N / 32, kb = item / nblk, nb = item % nblk, k0 = 128 * kb, n0 = 32 * nb;
    const int c = lane & 7; const int r0 = dest_row<MAP>(n0);
    v4u o[4];
    float t0_[32], t1_[32];
#pragma unroll
    for (int i = 0; i < 32; ++i) { const int kk = 2 * i + (lane >> 5); t0_[i] = __builtin_nontemporal_load(W + (size_t)(k0 + kk) * N + n0 + (lane & 31)); }
#pragma unroll
    for (int i = 0; i < 32; ++i) { const int kk = 2 * i + (lane >> 5); t1_[i] = __builtin_nontemporal_load(W + (size_t)(k0 + 64 + kk) * N + n0 + (lane & 31)); }
#pragma unroll
    for (int pass = 0; pass < 2; ++pass) {
#pragma unroll
        for (int i = 0; i < 32; ++i) { const int kk = 2 * i + (lane >> 5); scr[kk * 33 + (lane & 31)] = pass == 0 ? t0_[i] : t1_[i]; }
        LDS_WAIT(); asm volatile("" ::: "memory");
        if ((c >> 2) == pass) {
#pragma unroll
            for (int j = 0; j < 4; ++j) { const int n = (lane >> 3) + 8 * j; const LAS float* sp = scr + (16 * (c & 3)) * 33 + n;
                o[j].x = pk4_fp8s(sp[0 * 33], sp[1 * 33], sp[2 * 33], sp[3 * 33], scale); o[j].y = pk4_fp8s(sp[4 * 33], sp[5 * 33], sp[6 * 33], sp[7 * 33], scale);
                o[j].z = pk4_fp8s(sp[8 * 33], sp[9 * 33], sp[10 * 33], sp[11 * 33], scale); o[j].w = pk4_fp8s(sp[12 * 33], sp[13 * 33], sp[14 * 33], sp[15 * 33], scale); } }
        LDS_WAIT(); asm volatile("" ::: "memory");
    }
#pragma unroll
    for (int j = 0; j < 4; ++j) { const int n = (lane >> 3) + 8 * j; __builtin_nontemporal_store(o[j], (GAS v4u*)(WT + (size_t)(r0 + n) * K + k0 + 16 * c)); }
}
constexpr int I_GU8 = (D / 128) * (2 * FFN / 32), I_DN8 = (FFN / 128) * (D / 32), NCONV8 = NEXP * (I_GU8 + I_DN8);
__device__ __forceinline__ void conv_dispatch8(Frame& F, LAS float* scr, int it) {
    int r = it;
    if (r < NEXP * I_GU8) { const int e = r / I_GU8; conv_item8<1>(F.in[20] + (size_t)e * D * 2 * FFN, D, 2 * FFN, F.ws + WS_MGU + (size_t)e * 2 * FFN * D, S_WGU8, scr, r % I_GU8, F.lane); return; } r -= NEXP * I_GU8;
    { const int e = r / I_DN8; conv_item8<0>(F.in[21] + (size_t)e * FFN * D, FFN, D, F.ws + WS_MDN + (size_t)e * D * FFN, S_WDN8, scr, r % I_DN8, F.lane); }
}
constexpr int I_IN = (D / 64) * (INW / 32), I_OUT = (D / 64) * (D / 32), I_GU = (D / 64) * (2 * FFN / 32), I_DN = (FFN / 64) * (D / 32);
constexpr int NCONV = 2 * I_IN + 2 * I_OUT + I_GU + I_DN;
constexpr int MV_B0 = I_GU, MV_B1 = MV_B0 + I_DN, MV_B2 = MV_B1 + I_IN, MV_B = MV_B2 + I_OUT, MV_ITEMS = MV_B + NCONV8, MV_ENT = MV_ITEMS / NWAVES;
constexpr int Q_G10 = 4020, Q_MX0 = 1600, Q_G30 = 3100, Q_G40 = 950, Q_G11 = 2900, Q_MX1 = MV_ENT - (Q_G10 + Q_MX0 + Q_G30 + Q_G40 + Q_G11);
constexpr int QB_G10 = 0, QB_MX0 = QB_G10 + Q_G10, QB_G30 = QB_MX0 + Q_MX0, QB_G40 = QB_G30 + Q_G30, QB_G11 = QB_G40 + Q_G40, QB_MX1 = QB_G11 + Q_G11;
static_assert(MV_ITEMS % NWAVES == 0 && Q_MX1 > 0 && Q_G10 * NWAVES >= MV_B, "the bf16 items (read from G3_0 / G1_1 on) must all sit in the first queue");
__device__ __forceinline__ void conv_dispatch8(Frame& F, LAS float* scr, int it);
template <int MAP> __device__ __forceinline__ void conv_item(const float* W, int K, int N, bf16* WT, LAS float* scr, int item, int lane);
__device__ __forceinline__ void conv_moved(Frame& F, LAS float* scr, int it) {
    if (it < MV_B0) conv_item<1>(F.in[17], D, 2 * FFN, (bf16*)(F.ws + WS_WGU), scr, it, F.lane);
    else if (it < MV_B1) conv_item<0>(F.in[18], FFN, D, (bf16*)(F.ws + WS_WDN), scr, it - MV_B0, F.lane);
    else if (it < MV_B2) conv_item<0>(F.in[10] + (size_t)D * INW, D, INW, (bf16*)(F.ws + WS_WIN) + (size_t)INW * D, scr, it - MV_B1, F.lane);
    else if (it < MV_B) conv_item<0>(F.in[16] + (size_t)D * D, D, D, (bf16*)(F.ws + WS_WOUT) + (size_t)D * D, scr, it - MV_B2, F.lane);
    else conv_dispatch8(F, scr, it - MV_B);
}
__device__ __forceinline__ void conv_queue(Frame& F, gu32* qw, int base_ent, int nent) {
    LAS float* scr = (LAS float*)(F.lds + 32768 + F.wave * 8704); volatile LAS int* tk = (volatile LAS int*)(F.MISC + 24);
    __syncthreads();
    if (F.tid == 0) tk[0] = (int)__hip_atomic_fetch_add(qw, 1u, RLX_AGENT);
    __syncthreads();
    int cv = tk[0];
    while (cv < nent) {
        unsigned nx = 0u;
        if (F.tid == 0) nx = __hip_atomic_fetch_add(qw, 1u, RLX_AGENT);
        conv_moved(F, scr, (base_ent + cv) * NWAVES + F.wave);
        __syncthreads();
        if (F.tid == 0) tk[0] = (int)nx;
        __syncthreads();
        cv = tk[0];
    }
}
constexpr int NCONV_PRO = I_IN + I_OUT;
__device__ __forceinline__ void conv_dispatch(Frame& F, LAS float* scr, int it) {
    if (it < I_IN) conv_item<0>(F.in[10], D, INW, (bf16*)(F.ws + WS_WIN), scr, it, F.lane);
    else conv_item<0>(F.in[16], D, D, (bf16*)(F.ws + WS_WOUT), scr, it - I_IN, F.lane);
}
__device__ __forceinline__ void p_prologue(Frame& F) {
    const int gw = F.vcu * NWAVES + F.wave, NGW = F.G * NWAVES;
    const int MODEQ = 0;
    for (int task = F.vcu; task < 256; task += F.G) {
        LAS float* sv = (LAS float*)F.lds;
        LAS float* red = (LAS float*)(F.lds + 16384);
        for (int k = F.tid; k < 2 * D; k += NTHR) { const float x = k < D ? F.in[1][k] : F.in[3][k - D]; sv[k] = x / (1.f + __expf(-x)); }
        __syncthreads();
        const int l = task >> 7, chunk = task & 127, rg = F.tid / 24, c4 = F.tid % 24;
        if (rg < 21) {
            const float* W = F.in[4] + (size_t)l * D * 6 * D + chunk * 96 + 4 * c4;
            f32x4 a0 = {0.f, 0.f, 0.f, 0.f}, a1 = {0.f, 0.f, 0.f, 0.f};
#pragma unroll 8
            for (int k = rg; k < D; k += 21) { const f32x4 w = __builtin_nontemporal_load((const f32x4*)(W + (size_t)k * 6 * D)); a0 += sv[k] * w; a1 += sv[D + k] * w; }
            *(LAS f32x4*)(red + (rg * 2 + 0) * 96 + 4 * c4) = a0; *(LAS f32x4*)(red + (rg * 2 + 1) * 96 + 4 * c4) = a1;
        }
        __syncthreads();
        if (F.tid < 192) { const int w = F.tid / 96, cc = F.tid % 96; float sacc = 0.f;
#pragma unroll
          for (int q = 0; q < 21; ++q) sacc += red[(q * 2 + w) * 96 + cc];
          ((float*)(F.ws + WS_MOD))[((size_t)l * 2 + w) * 6 * D + chunk * 96 + cc] = sacc + F.in[5][l * 6 * D + chunk * 96 + cc]; }
        __syncthreads();
    }
    { const int gt = blockIdx.x * NTHR + F.tid;
      if (gt < 128 * 32) { const int pos = gt >> 5, i = gt & 31; const float inv = exp2f(-(float)i * (13.287712379549449f / 32.f)); float sn, cs; sincosf((float)pos * inv, &sn, &cs);
          ((float*)(F.ws + WS_ROPE))[gt] = cs; ((float*)(F.ws + WS_ROPE))[4096 + gt] = sn; } }
    LAS float* scr = (LAS float*)(F.lds + 32768 + F.wave * 8704);
    { gu32* head = F.ctl + CW_CHEAD; volatile LAS int* sh = (volatile LAS int*)(F.MISC + 24); constexpr int N8 = 0; constexpr int NALL = NCONV_PRO, PULL = 16;
      (void)gw; (void)NGW; (void)MODEQ;
      if (F.tid == 0) sh[0] = (int)__hip_atomic_fetch_add(head, (unsigned)PULL, RLX_AGENT);
      __syncthreads();
      int h = sh[0];
      while (h < NALL) {
          unsigned nx = 0u;
          if (F.tid == 0) nx = __hip_atomic_fetch_add(head, (unsigned)PULL, RLX_AGENT);
#pragma unroll 1
          for (int k = 0; k < PULL / NWAVES; ++k) { const int it = h + NWAVES * k + F.wave; if (it < N8) conv_dispatch8(F, scr, it); else if (it < NALL) conv_dispatch(F, scr, it - N8); }
          __syncthreads();
          if (F.tid == 0) sh[0] = (int)nx;
          __syncthreads();
          h = sh[0];
      } }
}

__device__ __forceinline__ void p_prenorm0(Frame& F) {
    const int gw = F.wave * F.G + F.vcu, NGW = F.G * NWAVES; const float* MOD = (const float*)(F.ws + WS_MOD); bf16* H = (bf16*)(F.ws + WS_H); const float* gpre = F.in[6]; const int lane = F.lane;
    LAS float* cf = (LAS float*)F.lds;
    { const int col = 4 * F.tid;
#pragma unroll
      for (int pt = 0; pt < 2; ++pt) { const float* mod = MOD + pt * 6 * D;
          *(LAS f32x4*)(cf + (pt * 2 + 0) * D + col) = *(const f32x4*)(gpre + col) * (1.f + *(const f32x4*)(mod + D + col)); *(LAS f32x4*)(cf + (pt * 2 + 1) * D + col) = *(const f32x4*)(mod + col); }
      __syncthreads(); }
    int row = gw; if (row >= MROWS) return;
    f32x4 xc[8];
#define PN_LOAD(R, X) do { const float* src_ = (R) < SEQ ? F.in[0] + (size_t)(R) * D : F.in[2] + (size_t)((R) - SEQ) * D; _Pragma("unroll") for (int j = 0; j < 8; ++j) X[j] = __builtin_nontemporal_load((const f32x4*)(src_ + 4 * lane + 256 * j)); } while (0)
    PN_LOAD(row, xc);
    for (;;) {
        const int nrow = row + NGW; const bool more = nrow < MROWS;
        f32x4 xn[8]; if (more) PN_LOAD(nrow, xn);
        const int pt = row < SEQ ? 0 : 1; const LAS float* cA = cf + (pt * 2 + 0) * D + 4 * lane; const LAS float* cB = cf + (pt * 2 + 1) * D + 4 * lane;
        float ss = 0.f;
#pragma unroll
        for (int j = 0; j < 8; ++j) ss += (xc[j].x * xc[j].x + xc[j].y * xc[j].y) + (xc[j].z * xc[j].z + xc[j].w * xc[j].w);
        const float r = rsqrtf(wave_sum(ss) * (1.f / D) + EPS);
#pragma unroll
        for (int j = 0; j < 8; ++j) { const int col = 4 * lane + 256 * j; const f32x4 h = (xc[j] * r) * *(const LAS f32x4*)(cA + 256 * j) + *(const LAS f32x4*)(cB + 256 * j);
            v2u o; o.x = pk2(h.x, h.y); o.y = pk2(h.z, h.w); __builtin_nontemporal_store(o, (GAS v2u*)(H + (size_t)row * D + col)); }
        if (!more) break;
#pragma unroll
        for (int j = 0; j < 8; ++j) xc[j] = xn[j];
        row = nrow;
    }
#undef PN_LOAD
}
template <bool XF32> __device__ __forceinline__ void p_post(Frame& F, const bf16* Y2, const float* gpost, int gate_off, const float* gmod  ,
                                       const float* xlat_src, const float* xctx_src, bf16* XB, int nrows,
                                       const float* gpre, const float* pmod  , int sh_off, int sc_off, bf16* H, const float* wrouter, int* tok_e, float* tok_w, const bf16* part, int npart) {
    const int gw = F.wave * F.G + F.vcu, NGW = F.G * NWAVES; const int lane = F.lane;
    LAS float* wrt = (LAS float*)F.lds;
    if (wrouter) { const int t = F.tid; f32x4 rw[8];
#pragma unroll
        for (int q = 0; q < 8; ++q) rw[q] = *(const f32x4*)(wrouter + (size_t)(4 * t) * NEXP + 4 * q);
#pragma unroll
        for (int e = 0; e < 8; ++e) { f32x4 o; o.x = rw[0 + (e >> 2)][e & 3]; o.y = rw[2 + (e >> 2)][e & 3]; o.z = rw[4 + (e >> 2)][e & 3]; o.w = rw[6 + (e >> 2)][e & 3]; *(LAS f32x4*)(wrt + e * D + 4 * t) = o; }
        __syncthreads(); }
    LAS float* cf = (LAS float*)(F.lds + 65536);
    { const int col = 4 * F.tid;
#pragma unroll
      for (int pt = 0; pt < 2; ++pt) { const float* gm = gmod + pt * 6 * D; const float* pm = pmod + pt * 6 * D;
          *(LAS f32x4*)(cf + (pt * 3 + 0) * D + col) = *(const f32x4*)(gm + gate_off + col) * *(const f32x4*)(gpost + col);
          *(LAS f32x4*)(cf + (pt * 3 + 1) * D + col) = *(const f32x4*)(gpre + col) * (1.f + *(const f32x4*)(pm + sc_off + col));
          *(LAS f32x4*)(cf + (pt * 3 + 2) * D + col) = *(const f32x4*)(pm + sh_off + col); }
      __syncthreads(); }
#pragma unroll 1
    for (int part_o = 0; part_o < 2; ++part_o) {
        const int part_i = 1 - part_o; const bool lat = part_i == 0;
        const int rend = lat ? (nrows < SEQ ? nrows : SEQ) : nrows;
        int row = lat ? gw : SEQ + gw;
        if (row >= rend) continue;
        const LAS float* cA1 = cf + (part_i * 3 + 0) * D + 4 * lane; const LAS float* cA2 = cf + (part_i * 3 + 1) * D + 4 * lane; const LAS float* cB2 = cf + (part_i * 3 + 2) * D + 4 * lane;
        v2u yc[8]; f32x4 xcf[XF32 ? 8 : 1]; v2u xcb[XF32 ? 1 : 8];
#define PP_LOAD(R, YD, XF, XBD) do { const bf16* y_ = Y2 + (size_t)(R) * D; _Pragma("unroll") for (int j = 0; j < 8; ++j) { const int col = 4 * lane + 256 * j; YD[j] = __builtin_nontemporal_load((const v2u*)(y_ + col)); \
            if constexpr (XF32) { const float* xs_ = (R) < SEQ ? xlat_src + (size_t)(R) * D : xctx_src + (size_t)((R) - SEQ) * D; XF[j] = __builtin_nontemporal_load((const f32x4*)(xs_ + col)); } \
            else XBD[j] = __builtin_nontemporal_load((const v2u*)(XB + (size_t)(R) * D + col)); } } while (0)
        PP_LOAD(row, yc, xcf, xcb);
        for (;;) {
            const int nrow = row + NGW; const bool more = nrow < rend;
            v2u yn[8]; f32x4 xnf[XF32 ? 8 : 1]; v2u xnb[XF32 ? 1 : 8];
            if constexpr (!XF32) { if (more) PP_LOAD(nrow, yn, xnf, xnb); }
            f32x4 v[8]; float ss = 0.f;
#pragma unroll
            for (int j = 0; j < 8; ++j) v[j] = (f32x4){__uint_as_float(yc[j].x << 16), __uint_as_float(yc[j].x & 0xffff0000u), __uint_as_float(yc[j].y << 16), __uint_as_float(yc[j].y & 0xffff0000u)};
            if (!lat) {
#pragma unroll 1
                for (int p = 0; p < npart; ++p) { const bf16* pp = part + ((size_t)p * CTX + (row - SEQ)) * D + 4 * lane; v2u t[8];
#pragma unroll
                    for (int j = 0; j < 8; ++j) t[j] = *(const v2u*)(pp + 256 * j);
#pragma unroll
                    for (int j = 0; j < 8; ++j) v[j] += (f32x4){__uint_as_float(t[j].x << 16), __uint_as_float(t[j].x & 0xffff0000u), __uint_as_float(t[j].y << 16), __uint_as_float(t[j].y & 0xffff0000u)}; } }
#pragma unroll
            for (int j = 0; j < 8; ++j) ss += (v[j].x * v[j].x + v[j].y * v[j].y) + (v[j].z * v[j].z + v[j].w * v[j].w);
            const float r = rsqrtf(wave_sum(ss) * (1.f / D) + EPS);
            float s2 = 0.f; bf16* xb = XB + (size_t)row * D;
#pragma unroll
            for (int j = 0; j < 8; ++j) { const int col = 4 * lane + 256 * j; f32x4 x;
                if constexpr (XF32) x = xcf[j]; else x = (f32x4){__uint_as_float(xcb[j].x << 16), __uint_as_float(xcb[j].x & 0xffff0000u), __uint_as_float(xcb[j].y << 16), __uint_as_float(xcb[j].y & 0xffff0000u)};
                v[j] = x + *(const LAS f32x4*)(cA1 + 256 * j) * (v[j] * r); { v2u xo_; xo_.x = pk2(v[j].x, v[j].y); xo_.y = pk2(v[j].z, v[j].w); __builtin_nontemporal_store(xo_, (GAS v2u*)(xb + col)); } s2 += (v[j].x * v[j].x + v[j].y * v[j].y) + (v[j].z * v[j].z + v[j].w * v[j].w); }
            const float r2 = rsqrtf(wave_sum(s2) * (1.f / D) + EPS);
            float lg[8] = {0.f, 0.f, 0.f, 0.f, 0.f, 0.f, 0.f, 0.f};
#pragma unroll
            for (int j = 0; j < 8; ++j) { const int col = 4 * lane + 256 * j;
                const f32x4 h = (v[j] * r2) * *(const LAS f32x4*)(cA2 + 256 * j) + *(const LAS f32x4*)(cB2 + 256 * j); v2u o; o.x = pk2(h.x, h.y); o.y = pk2(h.z, h.w); __builtin_nontemporal_store(o, (GAS v2u*)(H + (size_t)row * D + col));
                if (wrouter) {
#pragma unroll
                    for (int e = 0; e < 8; ++e) { const f32x4 we = *(const LAS f32x4*)(wrt + e * D + col); lg[e] += (h.x * we.x + h.y * we.y) + (h.z * we.z + h.w * we.w); } } }
            if (wrouter) {
#pragma unroll
                for (int e = 0; e < 8; ++e) lg[e] = wave_sum(lg[e]);
                int i1 = 0; float v1 = lg[0];
#pragma unroll
                for (int e = 1; e < 8; ++e) if (lg[e] > v1) { v1 = lg[e]; i1 = e; }
                int i2 = -1; float v2 = -3.0e38f;
#pragma unroll
                for (int e = 0; e < 8; ++e) if (e != i1 && lg[e] > v2) { v2 = lg[e]; i2 = e; }
                const float w1 = 1.f / (1.f + __expf(v2 - v1));
                if (lane == 0) { tok_e[2 * row] = i1; tok_e[2 * row + 1] = i2; tok_w[2 * row] = w1; tok_w[2 * row + 1] = 1.f - w1; }
            }
            if (!more) break;
            if constexpr (XF32) { PP_LOAD(nrow, yc, xcf, xcb); }
            else {
#pragma unroll
                for (int j = 0; j < 8; ++j) { yc[j] = yn[j]; xcb[j] = xnb[j]; } }
            row = nrow;
        }
#undef PP_LOAD
    }
}
__device__ __forceinline__ void p_combine(Frame& F, const bf16* Y2e, const int* slot_of, const float* tok_w, const float* gpost, const float* gate, const bf16* xsrc, float* xdst, const bf16* part, const int* pstart) {
    const int gw = F.vcu * NWAVES + F.wave, NGW = F.G * NWAVES; const int lane = F.lane;
    const int Ptot = __builtin_amdgcn_readfirstlane(pstart[8]), ppr = F.G / (D / 256), Pf = (Ptot / ppr) * ppr, rr = Ptot - Pf, sk = pg8::pick_split(rr, D / 256, FFN / 128, F.G);
    const size_t pstride = (size_t)rr * 256 * D; const int slot_f = Pf * 256;
    LAS float* cf = (LAS float*)F.lds;
    { const int col = 4 * F.tid; *(LAS f32x4*)(cf + col) = *(const f32x4*)(gate + col) * *(const f32x4*)(gpost + col); __syncthreads(); }
    const LAS float* cA = cf + 4 * lane;
    int row = gw; if (row >= SEQ) return;
    v2u y1c[8], y2c[8], xc[8]; int s1 = slot_of[2 * row], s2 = slot_of[2 * row + 1]; float w1 = tok_w[2 * row], w2 = tok_w[2 * row + 1];
#define PC_LOAD(R, S1, S2, Y1, Y2_, X) do { _Pragma("unroll") for (int j = 0; j < 8; ++j) { const int col = 4 * lane + 256 * j; Y1[j] = __builtin_nontemporal_load((const v2u*)(Y2e + (size_t)(S1) * D + col)); Y2_[j] = __builtin_nontemporal_load((const v2u*)(Y2e + (size_t)(S2) * D + col)); X[j] = __builtin_nontemporal_load((const v2u*)(xsrc + (size_t)(R) * D + col)); } } while (0)
#define PC_F4(u) ((f32x4){__uint_as_float((u).x << 16), __uint_as_float((u).x & 0xffff0000u), __uint_as_float((u).y << 16), __uint_as_float((u).y & 0xffff0000u)})
    PC_LOAD(row, s1, s2, y1c, y2c, xc);
    for (;;) {
        const int nrow = row + NGW; const bool more = nrow < SEQ;
        v2u y1n[8], y2n[8], xn[8]; int s1n = 0, s2n = 0; float w1n = 0.f, w2n = 0.f;
        if (more) { s1n = slot_of[2 * nrow]; s2n = slot_of[2 * nrow + 1]; w1n = tok_w[2 * nrow]; w2n = tok_w[2 * nrow + 1]; PC_LOAD(nrow, s1n, s2n, y1n, y2n, xn); }
        f32x4 v[8]; float ss = 0.f;
#pragma unroll
        for (int j = 0; j < 8; ++j) v[j] = w1 * PC_F4(y1c[j]) + w2 * PC_F4(y2c[j]);
        if (s1 >= slot_f) {
#pragma unroll 1
            for (int p = 0; p < sk - 1; ++p) { const bf16* pp = part + (size_t)p * pstride + (size_t)(s1 - slot_f) * D + 4 * lane; v2u t[8];
#pragma unroll
                for (int j = 0; j < 8; ++j) t[j] = *(const v2u*)(pp + 256 * j);
#pragma unroll
                for (int j = 0; j < 8; ++j) v[j] += w1 * PC_F4(t[j]); } }
        if (s2 >= slot_f) {
#pragma unroll 1
            for (int p = 0; p < sk - 1; ++p) { const bf16* pp = part + (size_t)p * pstride + (size_t)(s2 - slot_f) * D + 4 * lane; v2u t[8];
#pragma unroll
                for (int j = 0; j < 8; ++j) t[j] = *(const v2u*)(pp + 256 * j);
#pragma unroll
                for (int j = 0; j < 8; ++j) v[j] += w2 * PC_F4(t[j]); } }
#pragma unroll
        for (int j = 0; j < 8; ++j) ss += (v[j].x * v[j].x + v[j].y * v[j].y) + (v[j].z * v[j].z + v[j].w * v[j].w);
        const float r = rsqrtf(wave_sum(ss) * (1.f / D) + EPS);
#pragma unroll
        for (int j = 0; j < 8; ++j) { const int col = 4 * lane + 256 * j;
            __builtin_nontemporal_store(PC_F4(xc[j]) + *(const LAS f32x4*)(cA + 256 * j) * (v[j] * r), (GAS f32x4*)(xdst + (size_t)row * D + col)); }
        if (!more) break;
#pragma unroll
        for (int j = 0; j < 8; ++j) { y1c[j] = y1n[j]; y2c[j] = y2n[j]; xc[j] = xn[j]; }
        s1 = s1n; s2 = s2n; w1 = w1n; w2 = w2n; row = nrow;
    }
#undef PC_LOAD
#undef PC_F4
}

__device__ __forceinline__ void p_route(Frame& F) {
    const int* tok_e = (const int*)(F.ws + WS_TOKE); int* slot_of = (int*)(F.ws + WS_SLOT); int* pstart = (int*)(F.ws + WS_PSTART);
    const bf16* H = (const bf16*)(F.ws + WS_H); unsigned char* HP = F.ws + WS_HP;
    LAS unsigned char* te = F.lds;
    LAS int* cnt = (LAS int*)(F.lds + 16384);
    LAS int* rowtok = (LAS int*)(F.lds + 32768);
    LAS int* ps = (LAS int*)(F.lds + 32768 + MAXSLOT * 4);
    const int t = F.tid;
    int c[8] = {0, 0, 0, 0, 0, 0, 0, 0};
#pragma unroll
    for (int j4 = 0; j4 < 8; ++j4) { const v4u ev = *(const v4u*)(tok_e + 32 * t + 4 * j4); const unsigned ee[4] = {ev.x, ev.y, ev.z, ev.w};
#pragma unroll
        for (int q = 0; q < 4; ++q) { te[32 * t + 4 * j4 + q] = (unsigned char)ee[q];
#pragma unroll
            for (int e = 0; e < 8; ++e) c[e] += (ee[q] == (unsigned)e); } }
#pragma unroll
    for (int e = 0; e < 8; ++e) cnt[t * 8 + e] = c[e];
    for (int s = t; s < MAXSLOT; s += NTHR) rowtok[s] = -1;
    __syncthreads();
    { const int e = F.wave; int loc[8]; int sum = 0;
#pragma unroll
      for (int q = 0; q < 8; ++q) { loc[q] = cnt[(8 * F.lane + q) * 8 + e]; sum += loc[q]; }
      int inc = sum;
#pragma unroll
      for (int o = 1; o < 64; o <<= 1) { const int up = __shfl_up(inc, o); if (F.lane >= o) inc += up; }
      int run = inc - sum;
#pragma unroll
      for (int q = 0; q < 8; ++q) { cnt[(8 * F.lane + q) * 8 + e] = run; run += loc[q]; }
      if (F.lane == 63) ps[9 + e] = inc; }
    __syncthreads();
    if (t == 0) { int p = 0; for (int e = 0; e < 8; ++e) { ps[e] = p; p += (ps[9 + e] + 255) >> 8; } ps[8] = p; }
    __syncthreads();
    if (blockIdx.x == 0 && t < 9) pstart[t] = ps[t];
    { int run[8];
#pragma unroll
      for (int e = 0; e < 8; ++e) run[e] = ps[e] * 256 + cnt[t * 8 + e];
      const bool mine = ((t >> 1) % F.G) == (int)blockIdx.x;
      for (int j = 0; j < 32; ++j) { const int idx = 32 * t + j; const int e = te[idx]; int slot = 0;
#pragma unroll
          for (int q = 0; q < 8; ++q) if (e == q) { slot = run[q]; run[q] = slot + 1; }
          rowtok[slot] = idx >> 1; if (mine) slot_of[idx] = slot; } }
    __syncthreads();
    const int nslot = ps[8] * 256;
    { const int str = F.G * NWAVES;
      for (int s0 = blockIdx.x * NWAVES + F.wave; s0 < nslot; s0 += 4 * str) { v4u rv[4][4]; int tokb[4];
#pragma unroll
        for (int b4 = 0; b4 < 4; ++b4) { const int s = s0 + b4 * str; tokb[b4] = s < nslot ? rowtok[s] : -1; const int tl = tokb[b4] >= 0 ? tokb[b4] : 0;
#pragma unroll
            for (int j = 0; j < 4; ++j) rv[b4][j] = *(const v4u*)(H + (size_t)tl * D + 32 * F.lane + 8 * j); }
#define RT_PK(v) pk4_fp8s(__uint_as_float((v).x << 16), __uint_as_float((v).x & 0xffff0000u), __uint_as_float((v).y << 16), __uint_as_float((v).y & 0xffff0000u), S_H8), pk4_fp8s(__uint_as_float((v).z << 16), __uint_as_float((v).z & 0xffff0000u), __uint_as_float((v).w << 16), __uint_as_float((v).w & 0xffff0000u), S_H8)
#pragma unroll
        for (int b4 = 0; b4 < 4; ++b4) { const int s = s0 + b4 * str;
            if (s < nslot) { v4u o0 = (v4u){RT_PK(rv[b4][0]), RT_PK(rv[b4][1])}, o1 = (v4u){RT_PK(rv[b4][2]), RT_PK(rv[b4][3])};
                if (tokb[b4] < 0) { o0 = (v4u){0u, 0u, 0u, 0u}; o1 = (v4u){0u, 0u, 0u, 0u}; }
                *(GAS v4u*)(HP + (size_t)s * D + 32 * F.lane) = o0; *(GAS v4u*)(HP + (size_t)s * D + 32 * F.lane + 16) = o1; } }
#undef RT_PK
      } }
    __syncthreads();
}

namespace mx {
constexpr int KSTR = 288;
constexpr int TILE_B = 32 * KSTR;
constexpr int OFF_RPB = 6 * TILE_B;
constexpr int OFF_VH = 0;
constexpr float SC_L2 = 0.08838834764831845f * 1.4426950408889634f;
constexpr float L2E = 1.4426950408889634f;
constexpr float NEG = -1e30f;

__device__ __forceinline__ bf16x8 tr_pair(const LAS unsigned char* p, int off0, int off1) {
    const s16x4 a = __builtin_amdgcn_ds_read_tr16_b64_v4i16((LAS s16x4*)(p + off0)); const s16x4 b = __builtin_amdgcn_ds_read_tr16_b64_v4i16((LAS s16x4*)(p + off1));
    return (bf16x8){a[0], a[1], a[2], a[3], b[0], b[1], b[2], b[3]};
}
typedef __bf16 bf16v2 __attribute__((ext_vector_type(2))); typedef float f32v2 __attribute__((ext_vector_type(2)));
__device__ __forceinline__ unsigned cvt_pk(float lo, float hi) { const f32v2 v = {lo, hi}; const bf16v2 b = __builtin_convertvector(v, bf16v2); return __builtin_bit_cast(unsigned, b); }

template <int VAR> __device__ __forceinline__ void attn_unit(Frame& F, const bf16* P, bf16* Y, int u0, int u1, int band, const float* sink, const float* rpb) {
    constexpr int MQ = VAR == 0 ? 3 : 2;
    LAS unsigned char* lds = F.lds;
    int lane_; asm volatile("v_mbcnt_lo_u32_b32 %0, -1, 0\n\tv_mbcnt_hi_u32_b32 %0, -1, %0" : "=v"(lane_));
    const int lane = lane_, w = F.wave, fr = lane & 15, fq = lane >> 4, tid = w * 64 + lane_;
    int qrow[MQ], qcol[MQ], ycol[MQ]; int kcol, vcol;
    int nb = 0, blo = 0;
    int r_w = 0, r0_w = 0, cbase = 0;
    float m[MQ], l[MQ];
    if constexpr (VAR == 0) {
        kcol = C_KB + u1 * 128; vcol = C_VB + u1 * 128;
#pragma unroll
        for (int q = 0; q < MQ; ++q) { const int h = 3 * u1 + q; qrow[q] = u0 + 16 * w + fr; qcol[q] = C_QB + h * 128; ycol[q] = Y_B + h * 128; m[q] = sink[h] * L2E; l[q] = fq == 0 ? 1.f : 0.f; }
        if (band) { const int lo = u0 - 128 < 0 ? 0 : u0 - 128, hi = u0 + 256 > SEQ ? SEQ : u0 + 256; blo = lo; nb = (hi - lo) >> 5; }
    } else {
        kcol = C_KC + u0 * 128; vcol = C_VC + u0 * 128;
        if (band) { r_w = u1 + (w >> 1); cbase = 32 * (w & 1); r0_w = r_w - 4 < 0 ? 0 : (r_w - 4 > 120 ? 120 : r_w - 4);
            const int klo = u1 - 4 < 0 ? 0 : (u1 - 4 > 120 ? 120 : u1 - 4); int khi = u1 + 3 - 4; khi = (khi < 0 ? 0 : (khi > 120 ? 120 : khi)) + 8; blo = klo; nb = 2 * (khi - klo); }
#pragma unroll
        for (int q = 0; q < MQ; ++q) { qrow[q] = band ? 64 * r_w + cbase + 16 * q + fr : SEQ + 32 * w + 16 * q + fr; qcol[q] = C_QC + u0 * 128; ycol[q] = Y_C + u0 * 128; m[q] = NEG; l[q] = 0.f; }
        if (band) { for (int i = tid; i < 15 * 128; i += NTHR) { const int ro = i >> 7, co = (i & 127) - 48; ((LAS float*)(lds + OFF_RPB))[i] = (co >= 0 && co < 31) ? rpb[(u0 * 15 + ro) * 31 + co] * L2E : 0.f; } }
    }
    const int NT = nb + 8;
    bf16x8 qf[MQ][4];
#pragma unroll
    for (int q = 0; q < MQ; ++q)
#pragma unroll
        for (int kk = 0; kk < 4; ++kk) qf[q][kk] = *(const bf16x8*)(P + (size_t)qrow[q] * INW + qcol[q] + 32 * kk + 8 * fq);
    f32x4 o[MQ][8];
#pragma unroll
    for (int q = 0; q < MQ; ++q)
#pragma unroll
        for (int dt = 0; dt < 8; ++dt) o[q][dt] = (f32x4){0.f, 0.f, 0.f, 0.f};
    const int si = tid >> 4, sc16 = tid & 15; const int soff = si * KSTR + sc16 * 16;
#define MX_TILE_ROW(t) (VAR == 0 ? ((t) < nb ? blo + 32 * (t) : SEQ + 32 * ((t) - nb)) : ((t) < 8 ? SEQ + 32 * (t) : 64 * (blo + (((t) - 8) >> 1)) + 32 * (((t) - 8) & 1)))
    constexpr int DEPTH = VAR == 1 ? 2 : 1;
    v4u kA, vA, kB, vB;
    { const int row0 = MX_TILE_ROW(0); kA = *(const v4u*)(P + (size_t)(row0 + si) * INW + kcol + 8 * sc16); vA = *(const v4u*)(P + (size_t)(row0 + si) * INW + vcol + 8 * sc16); }
    if constexpr (DEPTH == 2) { const int row1 = MX_TILE_ROW(1); kB = *(const v4u*)(P + (size_t)(row1 + si) * INW + kcol + 8 * sc16); vB = *(const v4u*)(P + (size_t)(row1 + si) * INW + vcol + 8 * sc16); }
    else { kB = kA; vB = vA; }
    __syncthreads();
    *(LAS v4u*)(lds + soff) = kA; *(LAS v4u*)(lds + TILE_B + soff) = vA;
    __syncthreads();
    const int koff = fr * KSTR + fq * 16;
    const int voff = (4 * fq + (fr >> 2)) * KSTR + (fr & 3) * 8;
    __builtin_amdgcn_s_waitcnt(0);
    for (int t0 = 0; t0 < NT; t0 += DEPTH) {
#pragma unroll
      for (int par = 0; par < DEPTH; ++par) {
        const int t = t0 + par; if (t >= NT) break;
        v4u& kl = par == 0 ? kA : kB; v4u& vl = par == 0 ? vA : vB;
        const v4u& ks_ = (DEPTH == 1 || par == 1) ? kA : kB; const v4u& vs_ = (DEPTH == 1 || par == 1) ? vA : vB;
        const int buf = t % 3, bufn = (t + 1) % 3;
        if (t + DEPTH < NT) { const int row0 = MX_TILE_ROW(t + DEPTH); kl = *(const v4u*)(P + (size_t)(row0 + si) * INW + kcol + 8 * sc16); vl = *(const v4u*)(P + (size_t)(row0 + si) * INW + vcol + 8 * sc16); }
        bool rel = true; int kpos0 = 0, kr = 0, hf = 0;
        const bool is_band = VAR == 0 ? (t < nb) : (t >= 8);
        if constexpr (VAR == 0) { if (is_band) { kpos0 = blo + 32 * t; const int tq0 = u0 + 16 * w; rel = (kpos0 + 31 >= tq0 - 128) && (kpos0 <= tq0 + 15 + 128); } }
        else { if (is_band) { kr = blo + ((t - 8) >> 1); hf = (t - 8) & 1; rel = (kr >= r0_w) && (kr < r0_w + 8); } }
        if (rel) {
            const LAS unsigned char* Kt = lds + buf * 2 * TILE_B; const LAS unsigned char* Vt = Kt + TILE_B;
            float bb[VAR == 1 ? MQ : 1][8]; int c0q[VAR == 1 ? MQ : 1];
            if constexpr (VAR == 1) { if (is_band) {
#pragma unroll
                for (int q = 0; q < MQ; ++q) { const int c = cbase + 16 * q + fr; c0q[q] = c - 8 < 0 ? 0 : (c - 8 > 48 ? 48 : c - 8);
                    const LAS float* bp = (const LAS float*)(lds + OFF_RPB) + (kr - r_w + 7) * 128 + 32 * hf + 4 * fq - c + 63;
#pragma unroll
                    for (int j = 0; j < 8; ++j) bb[q][j] = bp[16 * (j >> 2) + (j & 3)]; } } }
            f32x4 st[MQ][2];
#pragma unroll
            for (int q = 0; q < MQ; ++q) { st[q][0] = (f32x4){0.f, 0.f, 0.f, 0.f}; st[q][1] = (f32x4){0.f, 0.f, 0.f, 0.f}; }
#pragma unroll
            for (int ks = 0; ks < 2; ++ks)
#pragma unroll
                for (int kk = 0; kk < 4; ++kk) { const bf16x8 kf = *(const LAS bf16x8*)(Kt + koff + ks * 16 * KSTR + kk * 64);
#pragma unroll
                    for (int q = 0; q < MQ; ++q) st[q][ks] = __builtin_amdgcn_mfma_f32_16x16x32_bf16(kf, qf[q][kk], st[q][ks], 0, 0, 0); }
            if constexpr (VAR == 1) {
            float s[MQ][8]; float mt[MQ];
#pragma unroll
            for (int q = 0; q < MQ; ++q) {
                if (!is_band) {
#pragma unroll
                    for (int j = 0; j < 8; ++j) s[q][j] = st[q][j >> 2][j & 3] * SC_L2;
                } else if constexpr (VAR == 0) {
                    const int w0 = kpos0 + 4 * fq - qrow[q] + 128;
#pragma unroll
                    for (int j = 0; j < 8; ++j) { const float v = st[q][j >> 2][j & 3] * SC_L2; s[q][j] = ((unsigned)(w0 + 16 * (j >> 2) + (j & 3)) <= 256u) ? v : NEG; }
                } else {
                    const int v0 = 32 * hf + 4 * fq - c0q[q];
#pragma unroll
                    for (int j = 0; j < 8; ++j) { const float v = st[q][j >> 2][j & 3] * SC_L2 + bb[q][j]; s[q][j] = ((unsigned)(v0 + 16 * (j >> 2) + (j & 3)) < 16u) ? v : NEG; }
                }
                float x = fmaxf(fmaxf(fmaxf(s[q][0], s[q][1]), fmaxf(s[q][2], s[q][3])), fmaxf(fmaxf(s[q][4], s[q][5]), fmaxf(s[q][6], s[q][7])));
                x = fmaxf(x, __shfl_xor(x, 16)); x = fmaxf(x, __shfl_xor(x, 32)); mt[q] = x;
            }
            bool grow = false;
#pragma unroll
            for (int q = 0; q < MQ; ++q) grow = grow || (mt[q] > m[q]);
            if (__any(grow)) {
#pragma unroll
                for (int q = 0; q < MQ; ++q) { const float mn = fmaxf(m[q], mt[q]); const float alpha = __builtin_amdgcn_exp2f(m[q] - mn); m[q] = mn; l[q] *= alpha;
#pragma unroll
                    for (int dt = 0; dt < 8; ++dt) o[q][dt] *= alpha; } }
            bf16x8 pb[MQ];
#pragma unroll
            for (int q = 0; q < MQ; ++q) { float ps = 0.f;
#pragma unroll
                for (int j = 0; j < 8; ++j) { s[q][j] = __builtin_amdgcn_exp2f(s[q][j] - m[q]); ps += s[q][j]; }
                l[q] += ps;
                v4u pk; pk.x = cvt_pk(s[q][0], s[q][1]); pk.y = cvt_pk(s[q][2], s[q][3]); pk.z = cvt_pk(s[q][4], s[q][5]); pk.w = cvt_pk(s[q][6], s[q][7]);
                pb[q] = __builtin_bit_cast(bf16x8, pk); }
#pragma unroll
            for (int dt = 0; dt < 8; ++dt) { const bf16x8 vf = tr_pair(Vt + voff, dt * 32, dt * 32 + 16 * KSTR);
#pragma unroll
                for (int q = 0; q < MQ; ++q) o[q][dt] = __builtin_amdgcn_mfma_f32_16x16x32_bf16(vf, pb[q], o[q][dt], 0, 0, 0); }
            } else {
            bf16x8 pb[MQ];
#pragma unroll
            for (int q = 0; q < MQ; ++q) {
                float s[8];
                if (!is_band) {
#pragma unroll
                    for (int j = 0; j < 8; ++j) s[j] = st[q][j >> 2][j & 3] * SC_L2;
                } else if constexpr (VAR == 0) {
                    const int w0 = kpos0 + 4 * fq - qrow[q] + 128;
#pragma unroll
                    for (int j = 0; j < 8; ++j) { const float v = st[q][j >> 2][j & 3] * SC_L2; s[j] = ((unsigned)(w0 + 16 * (j >> 2) + (j & 3)) <= 256u) ? v : NEG; }
                } else {
                    const int c = cbase + 16 * q + fr; const int c0 = c - 8 < 0 ? 0 : (c - 8 > 48 ? 48 : c - 8);
                    const LAS float* bp = (const LAS float*)(lds + OFF_RPB) + (kr - r_w + 7) * 128 + 32 * hf + 4 * fq - c + 63; const int v0 = 32 * hf + 4 * fq - c0;
                    float bb[8];
#pragma unroll
                    for (int j = 0; j < 8; ++j) bb[j] = bp[16 * (j >> 2) + (j & 3)];
#pragma unroll
                    for (int j = 0; j < 8; ++j) { const float v = st[q][j >> 2][j & 3] * SC_L2 + bb[j]; s[j] = ((unsigned)(v0 + 16 * (j >> 2) + (j & 3)) < 16u) ? v : NEG; }
                }
                float mt = fmaxf(fmaxf(fmaxf(s[0], s[1]), fmaxf(s[2], s[3])), fmaxf(fmaxf(s[4], s[5]), fmaxf(s[6], s[7])));
                mt = fmaxf(mt, __shfl_xor(mt, 16)); mt = fmaxf(mt, __shfl_xor(mt, 32));
                if (__any(mt > m[q])) { const float mn = fmaxf(m[q], mt); const float alpha = __builtin_amdgcn_exp2f(m[q] - mn); m[q] = mn; l[q] *= alpha;
#pragma unroll
                    for (int dt = 0; dt < 8; ++dt) o[q][dt] *= alpha; }
                float ps = 0.f;
#pragma unroll
                for (int j = 0; j < 8; ++j) { s[j] = __builtin_amdgcn_exp2f(s[j] - m[q]); ps += s[j]; }
                l[q] += ps;
                v4u pk; pk.x = cvt_pk(s[0], s[1]); pk.y = cvt_pk(s[2], s[3]); pk.z = cvt_pk(s[4], s[5]); pk.w = cvt_pk(s[6], s[7]);
                pb[q] = __builtin_bit_cast(bf16x8, pk);
            }
#pragma unroll
            for (int dt = 0; dt < 8; ++dt) { const bf16x8 vf = tr_pair(Vt + voff, dt * 32, dt * 32 + 16 * KSTR);
#pragma unroll
                for (int q = 0; q < MQ; ++q) o[q][dt] = __builtin_amdgcn_mfma_f32_16x16x32_bf16(vf, pb[q], o[q][dt], 0, 0, 0); }
            }
        }
        if (t + 1 < NT) { *(LAS v4u*)(lds + bufn * 2 * TILE_B + soff) = ks_; *(LAS v4u*)(lds + bufn * 2 * TILE_B + TILE_B + soff) = vs_; }
        __syncthreads();
      }
    }
#undef MX_TILE_ROW
#pragma unroll
    for (int q = 0; q < MQ; ++q) { float lt = l[q]; lt += __shfl_xor(lt, 16); lt += __shfl_xor(lt, 32); const float inv = 1.f / lt;
        bf16* yp = Y + (size_t)qrow[q] * D + ycol[q] + 4 * fq;
#pragma unroll
        for (int dt = 0; dt < 8; ++dt) { v2u w2; w2.x = cvt_pk(o[q][dt][0] * inv, o[q][dt][1] * inv); w2.y = cvt_pk(o[q][dt][2] * inv, o[q][dt][3] * inv); *(GAS v2u*)(yp + 16 * dt) = w2; } }
}

__device__ __forceinline__ void sgu_unit(Frame& F, const bf16* P, bf16* Y, int chunk, int g, const float* lng, const float* Ws, const float* bs) {
    LAS unsigned char* lds = F.lds; const int lane = F.lane, w = F.wave, fr = lane & 15, fq = lane >> 4, tid = F.tid;
    const int row0 = chunk * 128;
    __syncthreads();
    { const int c8 = tid & 15; f32x4 g0 = *(const f32x4*)(lng + g * 128 + 8 * c8), g1 = *(const f32x4*)(lng + g * 128 + 8 * c8 + 4);
#pragma unroll
      for (int p = 0; p < 4; ++p) { const int j = 32 * p + (tid >> 4);
          const v4u raw = *(const v4u*)(P + (size_t)(row0 + j) * INW + 512 + g * 128 + 8 * c8); const unsigned rw[4] = {raw.x, raw.y, raw.z, raw.w};
          float v[8]; float s = 0.f;
#pragma unroll
          for (int q = 0; q < 4; ++q) { v[2 * q] = __uint_as_float(rw[q] << 16); v[2 * q + 1] = __uint_as_float(rw[q] & 0xffff0000u); s += v[2 * q] + v[2 * q + 1]; }
          s += __shfl_xor(s, 1); s += __shfl_xor(s, 2); s += __shfl_xor(s, 4); s += __shfl_xor(s, 8);
          const float mu = s * (1.f / 128.f); float qq = 0.f;
#pragma unroll
          for (int q = 0; q < 8; ++q) { v[q] -= mu; qq += v[q] * v[q]; }
          qq += __shfl_xor(qq, 1); qq += __shfl_xor(qq, 2); qq += __shfl_xor(qq, 4); qq += __shfl_xor(qq, 8);
          const float r = rsqrtf(qq * (1.f / 128.f) + EPS);
          v4u ov; ov.x = pk2(v[0] * r * g0.x, v[1] * r * g0.y); ov.y = pk2(v[2] * r * g0.z, v[3] * r * g0.w); ov.z = pk2(v[4] * r * g1.x, v[5] * r * g1.y); ov.w = pk2(v[6] * r * g1.z, v[7] * r * g1.w);
          *(LAS v4u*)(lds + OFF_VH + j * KSTR + 16 * c8) = ov; } }
    bf16x8 wf[4];
#pragma unroll
    for (int kk = 0; kk < 4; ++kk) { const float* wp = Ws + ((size_t)g * 128 + 16 * w + fr) * 128 + 32 * kk + 8 * fq; const f32x4 a = *(const f32x4*)wp, b = *(const f32x4*)(wp + 4);
        v4u pk; pk.x = pk2(a.x, a.y); pk.y = pk2(a.z, a.w); pk.z = pk2(b.x, b.y); pk.w = pk2(b.z, b.w); wf[kk] = __builtin_bit_cast(bf16x8, pk); }
    __syncthreads();
    const int voff = (8 * fq + (fr >> 2)) * KSTR + (fr & 3) * 8;
    f32x4 acc[8];
#pragma unroll
    for (int ct = 0; ct < 8; ++ct) { acc[ct] = (f32x4){0.f, 0.f, 0.f, 0.f};
#pragma unroll
        for (int kk = 0; kk < 4; ++kk) { const bf16x8 af = tr_pair(lds + OFF_VH + voff, kk * 32 * KSTR + ct * 32, kk * 32 * KSTR + 4 * KSTR + ct * 32);
            acc[ct] = __builtin_amdgcn_mfma_f32_16x16x32_bf16(af, wf[kk], acc[ct], 0, 0, 0); } }
    const int pos = row0 + 16 * w + fr; const float bias = bs[g * 128 + 16 * w + fr];
    v2u uq[8];
#pragma unroll
    for (int ct = 0; ct < 8; ++ct) uq[ct] = *(const v2u*)(P + (size_t)pos * INW + g * 128 + 16 * ct + 4 * fq);
#pragma unroll
    for (int ct = 0; ct < 8; ++ct) { const int col = g * 128 + 16 * ct + 4 * fq; const v2u uu = uq[ct];
        const float u0 = __uint_as_float(uu.x << 16), u1 = __uint_as_float(uu.x & 0xffff0000u), u2 = __uint_as_float(uu.y << 16), u3 = __uint_as_float(uu.y & 0xffff0000u);
        v2u ov; ov.x = cvt_pk(u0 * (acc[ct][0] + bias), u1 * (acc[ct][1] + bias)); ov.y = cvt_pk(u2 * (acc[ct][2] + bias), u3 * (acc[ct][3] + bias));
        *(GAS v2u*)(Y + (size_t)pos * D + col) = ov; }
}
}

template <int L> __device__ __forceinline__ void p_mixers(Frame& F, gu32* qhead) {
    const bf16* P = (const bf16*)(F.ws + WS_P); bf16* Y = (bf16*)(F.ws + WS_Y);
    const float* sink = F.in[14] + L * 6; const float* rpb = F.in[15] + L * 6 * 15 * 31;
    const float* lng = F.in[11] + L * 512; const float* Ws = F.in[12] + (size_t)L * 4 * 128 * 128; const float* bs = F.in[13] + L * 512;
    constexpr int N_NA = 192, N_WA = 128, N_CB = L == 0 ? 4 : 0, N_CC = L == 0 ? 6 : 0, N_SGU = (L == 0 ? 66 : 64) * 4;
    constexpr int NU = N_NA + N_WA + N_CB + N_CC + N_SGU;
    constexpr int CV_BASE = L == 0 ? QB_MX0 : QB_MX1, CV_N = L == 0 ? Q_MX0 : Q_MX1;
    volatile LAS int* tk = (volatile LAS int*)(F.MISC + 16);
    if (F.tid == 0) tk[0] = (int)__hip_atomic_fetch_add(qhead, 1u, RLX_AGENT);
    __syncthreads();
    int cur = tk[0];
    while (cur < NU) {
        unsigned nxt = 0u;
        if (F.tid == 0) nxt = __hip_atomic_fetch_add(qhead, 1u, RLX_AGENT);
        int u = cur;
        if (u < N_NA) { mx::attn_unit<1>(F, P, Y, u / 32, 4 * (u % 32), 1, sink, rpb); }
        else if ((u -= N_NA) < N_WA) { mx::attn_unit<0>(F, P, Y, 128 * (u >> 1), u & 1, 1, sink, rpb); }
        else if ((u -= N_WA) < N_CB) { mx::attn_unit<0>(F, P, Y, SEQ + 128 * (u >> 1), u & 1, 0, sink, rpb); }
        else if ((u -= N_CB) < N_CC) { mx::attn_unit<1>(F, P, Y, u, 0, 0, sink, rpb); }
        else { u -= N_CC; mx::sgu_unit(F, P, Y, u >> 2, u & 3, lng, Ws, bs); }
        __syncthreads();
        if (F.tid == 0) tk[0] = (int)nxt;
        __syncthreads();
        cur = tk[0];
    }
    { gu32* qcv = qhead + 256; LAS float* scr = (LAS float*)(F.lds + 32768 + F.wave * 8704);
      __syncthreads();
      if (F.tid == 0) tk[0] = (int)__hip_atomic_fetch_add(qcv, 1u, RLX_AGENT);
      __syncthreads();
      int cv = tk[0];
      while (cv < CV_N) {
          unsigned nx = 0u;
          if (F.tid == 0) nx = __hip_atomic_fetch_add(qcv, 1u, RLX_AGENT);
          conv_moved(F, scr, (CV_BASE + cv) * NWAVES + F.wave);
          __syncthreads();
          if (F.tid == 0) tk[0] = (int)nx;
          __syncthreads();
          cv = tk[0];
      } }
}

enum { PH_PRO = 0, PH_T0, PH_G1_0, PH_MX_0, PH_G2_0, PH_T2_0, PH_G3_0, PH_G4_0, PH_T3_0, PH_G1_1, PH_MX_1, PH_G2_1, PH_T2_1, PH_RT, PH_G3_1, PH_G4_1, PH_T3_1, NPH };
#ifndef MK_SPLIT
#define MK_SPLIT 0
#endif
struct Args { const float* in[22]; float* out; unsigned char* ws; int ph_lo, ph_hi, li, pad; };
__global__ void __launch_bounds__(NTHR, 2) mk_fwd(Args args) {
    extern __shared__ __attribute__((aligned(16))) unsigned char lds[];
    Frame F;
    F.lds = (LAS unsigned char*)lds; F.MISC = (volatile LAS unsigned*)(F.lds + MISC_OFF);
    F.tid = threadIdx.x; F.lane = F.tid & 63; F.wave = __builtin_amdgcn_readfirstlane(F.tid >> 6);
    F.G = gridDim.x; { const int bx = blockIdx.x; F.vcu = (F.G % 8 == 0) ? (bx % 8) * (F.G / 8) + bx / 8 : bx; }
    F.ws = args.ws; F.out = args.out; F.ctl = (gu32*)(args.ws + WS_CTL);
#pragma unroll
    for (int i = 0; i < 22; ++i) F.in[i] = args.in[i];
    for (int u = F.tid; u < (LDS_BYTES - LDSCTL_OFF) / 4; u += NTHR) ((LAS unsigned*)(F.lds + LDSCTL_OFF))[u] = 0u;
    __syncthreads();
    XcdBarrier bar; bar.bar = (unsigned*)(F.ctl + CW_BAR); bar.x = 0; bar.st = nullptr;
    if (!MK_SPLIT) bar = xcd_barrier_post((unsigned*)(F.ctl + CW_BAR), F.MISC + 8);
    const int lo = args.ph_lo, hi = args.ph_hi;
#define IN(k) (lo <= (k) && (k) < hi)
#define PH_BEGIN() do { int l_; asm volatile("v_mbcnt_lo_u32_b32 %0, -1, 0\n\tv_mbcnt_hi_u32_b32 %0, -1, %0" : "=v"(l_)); F.lane = l_; F.tid = F.wave * 64 + l_; } while (0)
#define SEAM(k) do { if (IN(k) && IN((k) + 1)) xcd_barrier(bar); } while (0)
    float* MOD = (float*)(F.ws + WS_MOD); bf16* H = (bf16*)(F.ws + WS_H); bf16* P = (bf16*)(F.ws + WS_P); bf16* Y = (bf16*)(F.ws + WS_Y); bf16* Y2 = (bf16*)(F.ws + WS_Y2); bf16* XB = (bf16*)(F.ws + WS_XB);
    bf16* PART = (bf16*)(F.ws + WS_PART); bf16* ACT = (bf16*)(F.ws + WS_ACT); unsigned char* HP = F.ws + WS_HP; float* Z = (float*)(F.ws + WS_Z);
    int* tok_e = (int*)(F.ws + WS_TOKE); float* tok_w = (float*)(F.ws + WS_TOKW); int* slot_of = (int*)(F.ws + WS_SLOT); int* pstart = (int*)(F.ws + WS_PSTART);
    const float* cosT = (const float*)(F.ws + WS_ROPE); const float* sinT = cosT + 4096;
    const pg8::bf16_t* Wt_in = (const pg8::bf16_t*)(F.ws + WS_WIN); const pg8::bf16_t* Wt_out = (const pg8::bf16_t*)(F.ws + WS_WOUT);
    PG8_LAS unsigned char* ring = (PG8_LAS unsigned char*)F.lds;

    PH_BEGIN(); if (IN(PH_PRO)) { p_prologue(F); } SEAM(PH_PRO);
    PH_BEGIN(); if (IN(PH_T0)) { p_prenorm0(F); } SEAM(PH_T0);
    PH_BEGIN(); if (IN(PH_G1_0)) { pg8::Gemm g{H, Wt_in, MROWS, INW, D, 0}; pg8::StaticOrder S; S.init(MROWS, INW, D / 64, F.G == 256 ? 200 : F.G, (int)blockIdx.x); pg8::EpiInProjRope E{P, INW, cosT, sinT, SEQ};
        pg8::TableOrder TS; TS.build(S, (volatile PG8_LAS int*)(F.MISC + 64)); pg8::gemm_phase<pg8::EpiInProjRope, pg8::TableOrder, true, true>(ring, g, TS, E); conv_queue(F, F.ctl + CW_QUEUE + 512, QB_G10, Q_G10); } SEAM(PH_G1_0);
    PH_BEGIN(); if (IN(PH_MX_0)) { p_mixers<0>(F, F.ctl + CW_QUEUE); } SEAM(PH_MX_0);
    PH_BEGIN(); if (IN(PH_G2_0)) { pg8::Gemm g{Y, Wt_out, MROWS, D, D, 0}; pg8::DenseSplitOrder S; S.init(D, D / 64, F.G, (int)blockIdx.x, 8); pg8::EpiB16 E{Y2, D, PART, (size_t)CTX * D, SEQ, 1.f};
        pg8::TableOrder TS; TS.build(S, (volatile PG8_LAS int*)(F.MISC + 64)); pg8::gemm_phase<pg8::EpiB16, pg8::TableOrder, true, true>(ring, g, TS, E); } SEAM(PH_G2_0);
    PH_BEGIN(); if (IN(PH_T2_0)) { p_post<true>(F, Y2, F.in[7], 2 * D, MOD, F.in[0], F.in[2], XB, MROWS, F.in[8], MOD, 3 * D, 4 * D, H, nullptr, tok_e, tok_w, PART, 7); } SEAM(PH_T2_0);
    PH_BEGIN(); if (IN(PH_G3_0)) { pg8::Gemm g{H, (const pg8::bf16_t*)(F.ws + WS_WGU), MROWS, 2 * FFN, D, 0}; pg8::StaticOrder S; S.init(MROWS, 2 * FFN, D / 64, F.G == 256 ? 232 : F.G, (int)blockIdx.x); pg8::EpiSwiGLU E{ACT, FFN};
        pg8::TableOrder TS; TS.build(S, (volatile PG8_LAS int*)(F.MISC + 64)); pg8::gemm_phase<pg8::EpiSwiGLU, pg8::TableOrder, true, true>(ring, g, TS, E); conv_queue(F, F.ctl + CW_QUEUE + 576, QB_G30, Q_G30); } SEAM(PH_G3_0);
    PH_BEGIN(); if (IN(PH_G4_0)) { pg8::Gemm g{ACT, (const pg8::bf16_t*)(F.ws + WS_WDN), MROWS, D, FFN, 0}; pg8::DenseSplitOrder S; S.init(D, FFN / 64, F.G, (int)blockIdx.x, 14); pg8::EpiB16 E{Y2, D, PART, (size_t)CTX * D, SEQ, 1.f};
        pg8::TableOrder TS; TS.build(S, (volatile PG8_LAS int*)(F.MISC + 64)); pg8::gemm_phase<pg8::EpiB16, pg8::TableOrder, true, true>(ring, g, TS, E); conv_queue(F, F.ctl + CW_QUEUE + 640, QB_G40, Q_G40); } SEAM(PH_G4_0);
    PH_BEGIN(); if (IN(PH_T3_0)) { p_post<false>(F, Y2, F.in[9], 5 * D, MOD, nullptr, nullptr, XB, MROWS, F.in[6] + D, MOD + 2 * 6 * D, 0 * D, 1 * D, H, nullptr, tok_e, tok_w, PART, 13); } SEAM(PH_T3_0);
    PH_BEGIN(); if (IN(PH_G1_1)) { pg8::Gemm g{H, Wt_in + (size_t)INW * D, MROWS, INW, D, 0}; pg8::InProjLastOrder S; S.init(F.G == 256 ? 200 : F.G, (int)blockIdx.x); pg8::EpiInProjRope E{P, INW, cosT, sinT, SEQ};
        pg8::TableOrder TS; TS.build(S, (volatile PG8_LAS int*)(F.MISC + 64)); pg8::gemm_phase<pg8::EpiInProjRope, pg8::TableOrder, true, true>(ring, g, TS, E); conv_queue(F, F.ctl + CW_QUEUE + 704, QB_G11, Q_G11); } SEAM(PH_G1_1);
    PH_BEGIN(); if (IN(PH_MX_1)) { p_mixers<1>(F, F.ctl + CW_QUEUE + 64); } SEAM(PH_MX_1);
    PH_BEGIN(); if (IN(PH_G2_1)) { pg8::Gemm g{Y, Wt_out + (size_t)D * D, SEQ, D, D, 0}; pg8::StaticOrder S; S.init(SEQ, D, D / 64, F.G, (int)blockIdx.x); pg8::EpiB16 E{Y2, D, PART, 0, 0, 1.f};
        pg8::TableOrder TS; TS.build(S, (volatile PG8_LAS int*)(F.MISC + 64)); pg8::gemm_phase<pg8::EpiB16, pg8::TableOrder, true, true>(ring, g, TS, E); } SEAM(PH_G2_1);
    PH_BEGIN(); if (IN(PH_T2_1)) { p_post<false>(F, Y2, F.in[7] + D, 2 * D, MOD + 2 * 6 * D, nullptr, nullptr, XB, SEQ, F.in[8] + D, MOD + 2 * 6 * D, 3 * D, 4 * D, H, F.in[19], tok_e, tok_w, PART, 0); } SEAM(PH_T2_1);
    PH_BEGIN(); if (IN(PH_RT)) { p_route(F); } SEAM(PH_RT);
    PH_BEGIN(); if (IN(PH_G3_1)) { pg8::Gemm g{HP, F.ws + WS_MGU, MAXSLOT, 2 * FFN, D, (size_t)2 * FFN * D}; pg8::GroupedOrder S; S.init(pstart, (volatile PG8_LAS int*)(F.MISC + 32), 2 * FFN, D / 128, F.G, (int)blockIdx.x);
        pg8::EpiSwiGLU8 E{(unsigned char*)ACT, FFN, 1.f / (S_H8 * S_WGU8), S_ACT8};
        pg8::TableOrder TS; TS.build(S, (volatile PG8_LAS int*)(F.MISC + 64)); pg8::gemm_phase<pg8::EpiSwiGLU8, pg8::TableOrder, true, true, 1>(ring, g, TS, E); } SEAM(PH_G3_1);
    PH_BEGIN(); if (IN(PH_G4_1)) { pg8::Gemm g{ACT, F.ws + WS_MDN, MAXSLOT, D, FFN, (size_t)D * FFN}; pg8::GroupedSplitOrder S; S.init(pstart, (volatile PG8_LAS int*)(F.MISC + 32), D, FFN / 128, F.G, (int)blockIdx.x);
        pg8::EpiB16 E{Y2, D, PART, (size_t)S.r * 256 * D, S.Pf * 256, 1.f / (S_ACT8 * S_WDN8)};
        pg8::TableOrder TS; TS.build(S, (volatile PG8_LAS int*)(F.MISC + 64)); pg8::gemm_phase<pg8::EpiB16, pg8::TableOrder, true, true, 1>(ring, g, TS, E); } SEAM(PH_G4_1);
    PH_BEGIN(); if (IN(PH_T3_1)) { p_combine(F, Y2, slot_of, tok_w, F.in[9] + D, MOD + 2 * 6 * D + 5 * D, XB, F.out, PART, pstart); }
#undef IN
#undef SEAM
}

extern "C" void kernel_launch(void* const* d_in, const int* in_sizes, int n_in, void* d_out, int out_size, void* d_ws, size_t ws_size, hipStream_t stream) {
    static int grid = 0;
    if (grid == 0) {
        if (n_in != 22 || out_size != SEQ * D || ws_size < WS_END) { fprintf(stderr, "kernel_launch: unexpected arguments (n_in %d, out %d, ws %zu < %zu); nothing launched\n", n_in, out_size, ws_size, (size_t)WS_END); grid = -1; return; }
        int dev = 0, cus = 0, per_cu = 0;
        if (hipGetDevice(&dev) != hipSuccess || hipDeviceGetAttribute(&cus, hipDeviceAttributeMultiprocessorCount, dev) != hipSuccess) { grid = -1; return; }
        if (hipFuncSetAttribute((const void*)mk_fwd, hipFuncAttributeMaxDynamicSharedMemorySize, LDS_BYTES) != hipSuccess) { fprintf(stderr, "kernel_launch: hipFuncSetAttribute failed\n"); grid = -1; return; }
        if (hipOccupancyMaxActiveBlocksPerMultiprocessor(&per_cu, (const void*)mk_fwd, NTHR, LDS_BYTES) != hipSuccess || per_cu < 1) { fprintf(stderr, "kernel_launch: occupancy query says %d blocks per CU\n", per_cu); }
        (void)hipGetLastError();
        grid = cus;
    }
    if (grid < 0) return;
    (void)hipMemsetAsync((char*)d_ws + WS_CTL, 0, CTL_ZERO_BYTES, stream);
    Args a{};
    for (int i = 0; i < 22; ++i) a.in[i] = (const float*)d_in[i];
    a.out = (float*)d_out; a.ws = (unsigned char*)d_ws; a.li = 0; a.pad = 0;
#if MK_SPLIT
    for (int p = 0; p < NPH; ++p) { a.ph_lo = p; a.ph_hi = p + 1; hipLaunchKernelGGL(mk_fwd, dim3(grid), dim3(NTHR), LDS_BYTES, stream, a); }
#else
    a.ph_lo = 0; a.ph_hi = NPH; hipLaunchKernelGGL(mk_fwd, dim3(grid), dim3(NTHR), LDS_BYTES, stream, a);
#endif
}
```

```cpp
#include <hip/hip_runtime.h>
#include <cstdio>
#include <cstdint>
namespace pg8 {
#define PG8_LAS __attribute__((address_space(3)))
typedef unsigned short bf16_t;
typedef short bf16x8 __attribute__((ext_vector_type(8)));
typedef float f32x4 __attribute__((ext_vector_type(4)));
typedef unsigned u32x4 __attribute__((ext_vector_type(4)));
typedef int i32x4 __attribute__((ext_vector_type(4)));
typedef int i32x8 __attribute__((ext_vector_type(8)));
__device__ __forceinline__ bf16x8 as_bf16x8(i32x4 v) { return __builtin_bit_cast(bf16x8, v); }
constexpr int BM = 256, BK = 64, HALF = 128, HTB = HALF * BK * 2  , STAGE_BYTES = 8 * HTB, NXCD = 8, WGM = 4;

__host__ __device__ __forceinline__ int lds_byte(int r, int c) { const int st = (r >> 4) * 2 + (c >> 5), rr = r & 15, cc = c & 31, ob = rr * 64 + cc * 2; return st * 1024 + (ob ^ (((ob >> 9) & 1) << 5)); }
__host__ __device__ __forceinline__ void stage_rc(int b, int& R, int& C) { const int st = b / 1024, sb = b % 1024, swz = sb ^ (((sb >> 9) & 1) << 5); R = (st >> 1) * 16 + swz / 64; C = (st & 1) * 32 + (swz % 64) / 2; }
__host__ __device__ __forceinline__ int perm32(int rho) { const int n = rho >> 4, i = rho & 15; return 8 * (i >> 2) + 4 * n + (i & 3); }

__host__ __device__ __forceinline__ int sigma128(int s) { const int wc = s >> 5, n = (s >> 4) & 1, q4 = s & 15; return 64 * (wc >> 1) + 32 * n + 16 * (wc & 1) + q4; }

struct Unit { int pm, pn, eks, nt; __device__ __host__ __forceinline__ int e() const { return eks & 0xff; } __device__ __host__ __forceinline__ int ks() const { return eks >> 8; } };
struct Gemm { const void* A; const void* Bt; int M, N, K; size_t estride; };

struct StaticOrder {
    int nM, nN, nwg, G, c, ntK;
    __host__ __device__ __forceinline__ void init(int M, int N, int ntK_, int G_, int c_) { nM = M / BM; nN = N / BM; nwg = nM * nN; G = G_; c = c_; ntK = ntK_; }
    __host__ __device__ __forceinline__ bool next(int i, Unit& u) const {
        const long L = (long)i * G + c; if (L >= nwg || c >= G) return false;
        int wgid = (int)L; { const int q = nwg / NXCD, r = nwg % NXCD, xcd = wgid % NXCD, off = wgid / NXCD; wgid = (xcd < r ? xcd * (q + 1) : r * (q + 1) + (xcd - r) * q) + off; }
        const int nig = WGM * nN, gid = wgid / nig, fm = gid * WGM, gsz = (nM - fm) < WGM ? (nM - fm) : WGM;
        u.pm = fm + ((wgid % nig) % gsz); u.pn = (wgid % nig) / gsz; u.eks = 0; u.nt = ntK; return true;
    }
    __device__ __forceinline__ void a_ready(const Unit&) const {}
    __device__ __forceinline__ void done(const Unit&) const {}
};

struct GroupedOrder {
    int nN, nwg, G, c, ntK; const volatile PG8_LAS int* ps;
    __device__ __forceinline__ void init(const int* pstart, volatile PG8_LAS int* tab, int N, int ntK_, int G_, int c_, int plim = 1 << 30) { nN = N / BM; G = G_; c = c_; ntK = ntK_;
        if (threadIdx.x < 9) { const int p = pstart[threadIdx.x]; tab[threadIdx.x] = p < plim ? p : plim; }
        __syncthreads(); ps = tab; nwg = __builtin_amdgcn_readfirstlane(tab[8]) * nN; }
    __device__ __forceinline__ bool next(int i, Unit& u) const {
        const long L = (long)i * G + c; if (L >= nwg) return false;
        int wgid = (int)L; { const int q = nwg / NXCD, r = nwg % NXCD, xcd = wgid % NXCD, off = wgid / NXCD; wgid = (xcd < r ? xcd * (q + 1) : r * (q + 1) + (xcd - r) * q) + off; }
        int e = 0, s0 = 0, np = 1;
#pragma unroll
        for (int k = 0; k < 8; ++k) { const int a = __builtin_amdgcn_readfirstlane(ps[k]), b = __builtin_amdgcn_readfirstlane(ps[k + 1]); if (wgid >= a * nN && wgid < b * nN) { e = k; s0 = a; np = b - a; } }
        const int r = wgid - s0 * nN;
        const int nig = WGM * nN, gid = r / nig, fm = gid * WGM, gsz = (np - fm) < WGM ? (np - fm) : WGM;
        u.pm = s0 + fm + ((r % nig) % gsz); u.pn = (r % nig) / gsz; u.eks = e; u.nt = ntK; return true;
    }
    __device__ __forceinline__ void a_ready(const Unit&) const {}
    __device__ __forceinline__ void done(const Unit&) const {}
};

struct TableOrder {
    const volatile PG8_LAS int* tab;
    template <class Sched> __device__ __forceinline__ void build(const Sched& S, volatile PG8_LAS int* t) {
        if (threadIdx.x < 32) { Unit u; u.pm = 0; u.pn = 0; u.eks = 0; u.nt = 0; const bool ok = S.next((int)threadIdx.x, u);
            t[4 * threadIdx.x + 0] = ok ? u.pm : -1; t[4 * threadIdx.x + 1] = u.pn; t[4 * threadIdx.x + 2] = u.eks; t[4 * threadIdx.x + 3] = u.nt; }
        __syncthreads(); tab = t; }
    __device__ __forceinline__ bool next(int i, Unit& u) const {
        if (i >= 32) return false;
        const i32x4 e = *(const PG8_LAS i32x4*)(tab + 4 * i);
        const int pm = __builtin_amdgcn_readfirstlane(e.x);
        u.pm = pm; u.pn = __builtin_amdgcn_readfirstlane(e.y); u.eks = __builtin_amdgcn_readfirstlane(e.z); u.nt = __builtin_amdgcn_readfirstlane(e.w);
        return pm >= 0; }
    __device__ __forceinline__ void a_ready(const Unit&) const {}
    __device__ __forceinline__ void done(const Unit&) const {}
};

typedef __bf16 bf16v2_t __attribute__((ext_vector_type(2))); typedef float f32v2_t __attribute__((ext_vector_type(2)));
__device__ __forceinline__ unsigned cvt_pk_bf16(float lo, float hi) { const f32v2_t v = {lo, hi}; const bf16v2_t b = __builtin_convertvector(v, bf16v2_t); return __builtin_bit_cast(unsigned, b); }
__device__ __forceinline__ float gelu_tanh(float x) { const float t = x + 0.044715f * x * x * x; const float e = __builtin_amdgcn_exp2f(-2.3022082f * t); return x * __builtin_amdgcn_rcpf(1.0f + e); }
__device__ __forceinline__ float silu_f(float x) { const float e = __builtin_amdgcn_exp2f(-1.44269504f * x); return x * __builtin_amdgcn_rcpf(1.0f + e); }

struct EpiF32 {
    static constexpr int PERM = 0; static constexpr bool AFTER_DRAIN = false;
    float* C; int ldc; float* Cpart; size_t part_stride; int part_row0; float oscale;
    __device__ __forceinline__ void operator()(const f32x4 (&acc)[2][2][4][2], const Unit& u, int wr, int wc, int fr, int fq) const {
        const int row0 = u.pm * BM + wr * 64 + fr, col0 = u.pn * BM + wc * 32 + 4 * fq;
        const int ks = u.ks(); float* base = ks == 0 ? C + (size_t)row0 * ldc : Cpart + (size_t)(ks - 1) * part_stride + (size_t)(row0 - part_row0) * ldc;
#pragma unroll
        for (int ai = 0; ai < 2; ++ai)
#pragma unroll
            for (int m = 0; m < 4; ++m) { float* rowp = base + (size_t)(ai * HALF + m * 16) * ldc + col0;
#pragma unroll
                for (int bj = 0; bj < 2; ++bj)
#pragma unroll
                    for (int n = 0; n < 2; ++n) *(f32x4*)(rowp + bj * HALF + n * 16) = acc[ai][bj][m][n] * oscale; }
    }
};
struct EpiB16 {
    static constexpr int PERM = 1; static constexpr bool AFTER_DRAIN = false;
    bf16_t* C; int ldc; bf16_t* Cpart; size_t part_stride; int part_row0; float oscale;
    __device__ __forceinline__ void operator()(const f32x4 (&acc)[2][2][4][2], const Unit& u, int wr, int wc, int fr, int fq) const {
        const int row0 = u.pm * BM + wr * 64 + fr, col0 = u.pn * BM + wc * 32 + 8 * fq;
        const int ks = u.ks(); bf16_t* base = ks == 0 ? C + (size_t)row0 * ldc : Cpart + (size_t)(ks - 1) * part_stride + (size_t)(row0 - part_row0) * ldc;
#pragma unroll
        for (int ai = 0; ai < 2; ++ai)
#pragma unroll
            for (int m = 0; m < 4; ++m) { bf16_t* rowp = base + (size_t)(ai * HALF + m * 16) * ldc + col0;
#pragma unroll
                for (int bj = 0; bj < 2; ++bj) { const f32x4 v0 = acc[ai][bj][m][0] * oscale, v1 = acc[ai][bj][m][1] * oscale;
                    u32x4 w; w.x = cvt_pk_bf16(v0[0], v0[1]); w.y = cvt_pk_bf16(v0[2], v0[3]); w.z = cvt_pk_bf16(v1[0], v1[1]); w.w = cvt_pk_bf16(v1[2], v1[3]);
                    *(u32x4*)(rowp + bj * HALF) = w; } }
    }
};
struct EpiInProj {
    static constexpr int PERM = 1; static constexpr bool AFTER_DRAIN = false;
    bf16_t* O; int ldc; int gelu_tiles;
    __device__ __forceinline__ void operator()(const f32x4 (&acc)[2][2][4][2], const Unit& u, int wr, int wc, int fr, int fq) const {
        const int row0 = u.pm * BM + wr * 64 + fr, col0 = u.pn * BM + wc * 32 + 8 * fq; const bool act = u.pn < gelu_tiles;
#pragma unroll
        for (int ai = 0; ai < 2; ++ai)
#pragma unroll
            for (int m = 0; m < 4; ++m) { bf16_t* rowp = O + (size_t)(row0 + ai * HALF + m * 16) * ldc + col0;
#pragma unroll
                for (int bj = 0; bj < 2; ++bj) { f32x4 v0 = acc[ai][bj][m][0], v1 = acc[ai][bj][m][1];
                    if (act) {
#pragma unroll
                        for (int j = 0; j < 4; ++j) { v0[j] = gelu_tanh(v0[j]); v1[j] = gelu_tanh(v1[j]); } }
                    u32x4 w; w.x = cvt_pk_bf16(v0[0], v0[1]); w.y = cvt_pk_bf16(v0[2], v0[3]); w.z = cvt_pk_bf16(v1[0], v1[1]); w.w = cvt_pk_bf16(v1[2], v1[3]);
                    *(u32x4*)(rowp + bj * HALF) = w; } }
    }
};
struct EpiSwiGLU {
    static constexpr int PERM = 1; static constexpr bool AFTER_DRAIN = false;
    bf16_t* O; int ldc;
    __device__ __forceinline__ void operator()(const f32x4 (&acc)[2][2][4][2], const Unit& u, int wr, int wc, int fr, int fq) const {
        const int row0 = u.pm * BM + wr * 64 + fr, col0 = u.pn * HALF + wc * 32 + 8 * fq;
#pragma unroll
        for (int ai = 0; ai < 2; ++ai)
#pragma unroll
            for (int m = 0; m < 4; ++m) { bf16_t* rowp = O + (size_t)(row0 + ai * HALF + m * 16) * ldc + col0;
                f32x4 v0, v1;
#pragma unroll
                for (int j = 0; j < 4; ++j) { v0[j] = silu_f(acc[ai][0][m][0][j]) * acc[ai][1][m][0][j]; v1[j] = silu_f(acc[ai][0][m][1][j]) * acc[ai][1][m][1][j]; }
                u32x4 w; w.x = cvt_pk_bf16(v0[0], v0[1]); w.y = cvt_pk_bf16(v0[2], v0[3]); w.z = cvt_pk_bf16(v1[0], v1[1]); w.w = cvt_pk_bf16(v1[2], v1[3]);
                *(u32x4*)rowp = w; }
    }
};

__device__ __forceinline__ float clamp448(float x) { return __builtin_fminf(__builtin_fmaxf(x, -448.f), 448.f); }
__device__ __forceinline__ unsigned pk4_fp8(float a, float b, float c, float d) { int w = 0; w = __builtin_amdgcn_cvt_pk_fp8_f32(clamp448(a), clamp448(b), w, false); w = __builtin_amdgcn_cvt_pk_fp8_f32(clamp448(c), clamp448(d), w, true); return (unsigned)w; }
struct EpiSwiGLU8 {
    static constexpr int PERM = 1; static constexpr bool AFTER_DRAIN = false;
    unsigned char* O; int ldc; float iscale, oscale;
    __device__ __forceinline__ void operator()(const f32x4 (&acc)[2][2][4][2], const Unit& u, int wr, int wc, int fr, int fq) const {
        typedef unsigned u32x2 __attribute__((ext_vector_type(2)));
        const int row0 = u.pm * BM + wr * 64 + fr, col0 = u.pn * HALF + wc * 32 + 8 * fq;
#pragma unroll
        for (int ai = 0; ai < 2; ++ai)
#pragma unroll
            for (int m = 0; m < 4; ++m) { unsigned char* rowp = O + (size_t)(row0 + ai * HALF + m * 16) * ldc + col0;
                f32x4 v0, v1;
#pragma unroll
                for (int j = 0; j < 4; ++j) { v0[j] = silu_f(acc[ai][0][m][0][j] * iscale) * (acc[ai][1][m][0][j] * iscale) * oscale; v1[j] = silu_f(acc[ai][0][m][1][j] * iscale) * (acc[ai][1][m][1][j] * iscale) * oscale; }
                u32x2 w; w.x = pk4_fp8(v0[0], v0[1], v0[2], v0[3]); w.y = pk4_fp8(v1[0], v1[1], v1[2], v1[3]);
                *(u32x2*)rowp = w; }
    }
};
struct EpiInProjRope {
    static constexpr int PERM = 2; static constexpr bool AFTER_DRAIN = false;
    bf16_t* O; int ldc; const float* cosT; const float* sinT; int nlat;
    __device__ __forceinline__ void operator()(const f32x4 (&acc)[2][2][4][2], const Unit& u, int wr, int wc, int fr, int fq) const {
        typedef unsigned u32x2 __attribute__((ext_vector_type(2)));
        const int row0 = u.pm * BM + wr * 64 + fr, col0 = u.pn * BM + 64 * (wc >> 1) + 16 * (wc & 1) + 4 * fq;
        const bool act = u.pn < 4; const bool rope = (u.pn == 4 || u.pn == 5 || u.pn == 6 || u.pn == 10) && (u.pm * BM < nlat);
        const int fi = 16 * (wc & 1) + 4 * fq;
        f32x4 csa[8], sna[8];
#pragma unroll
        for (int q = 0; q < 8; ++q) { csa[q] = (f32x4){1.f, 1.f, 1.f, 1.f}; sna[q] = (f32x4){0.f, 0.f, 0.f, 0.f}; }
        if (rope) {
#pragma unroll
            for (int q = 0; q < 8; ++q) { const int row = row0 + (q >> 2) * HALF + (q & 3) * 16; const int pos = (wc >> 1) ? (row & 63) : (row >> 6); csa[q] = *(const f32x4*)(cosT + pos * 32 + fi); sna[q] = *(const f32x4*)(sinT + pos * 32 + fi); } }
#pragma unroll
        for (int ai = 0; ai < 2; ++ai)
#pragma unroll
            for (int m = 0; m < 4; ++m) { const int row = row0 + ai * HALF + m * 16; bf16_t* rowp = O + (size_t)row * ldc + col0;
                const f32x4 cs = csa[ai * 4 + m], sn = sna[ai * 4 + m];
#pragma unroll
                for (int bj = 0; bj < 2; ++bj) { f32x4 v0 = acc[ai][bj][m][0], v1 = acc[ai][bj][m][1];
                    if (act) {
#pragma unroll
                        for (int j = 0; j < 4; ++j) { v0[j] = gelu_tanh(v0[j]); v1[j] = gelu_tanh(v1[j]); } }
                    const f32x4 o0 = v0 * cs - v1 * sn, o1 = v0 * sn + v1 * cs;
                    u32x2 w0, w1; w0.x = cvt_pk_bf16(o0[0], o0[1]); w0.y = cvt_pk_bf16(o0[2], o0[3]); w1.x = cvt_pk_bf16(o1[0], o1[1]); w1.y = cvt_pk_bf16(o1[2], o1[3]);
                    *(u32x2*)(rowp + bj * HALF) = w0; *(u32x2*)(rowp + bj * HALF + 32) = w1; } }
    }
};
__device__ __forceinline__ int pick_split(int r, int nN, int ntK, int G) {
    int s = 1;
#define PG8_TRY(q) if (ntK % (q) == 0 && ((ntK / (q)) & 1) == 0 && ntK / (q) >= 4 && r * nN * (q) <= G) s = (q)
    PG8_TRY(2); PG8_TRY(4); PG8_TRY(7); PG8_TRY(8); PG8_TRY(14); PG8_TRY(28);
#undef PG8_TRY
    return s;
}
struct DenseSplitOrder {
    StaticOrder so; int nNc, sk, ntsub;
    __device__ __forceinline__ void init(int N, int ntK_, int G_, int c_, int sk_) { so.init(8192, N, ntK_, G_, c_); nNc = N / BM; sk = sk_; ntsub = ntK_ / sk_; }
    __device__ __forceinline__ bool next(int i, Unit& u) const {
        long L = (long)i * so.G + so.c; Unit t; t.pm = 0; t.pn = 0; t.eks = 0; t.nt = 0; bool ok;
        if (L < so.nwg) ok = so.next(i, t);
        else { L -= so.nwg; ok = L < nNc * sk; t.pm = 32; t.pn = (int)(L % nNc); t.eks = (int)(L / nNc) << 8; t.nt = ntsub; }
        u.pm = t.pm; u.pn = t.pn; u.eks = t.eks; u.nt = t.nt; return ok;
    }
    __device__ __forceinline__ void a_ready(const Unit&) const {}
    __device__ __forceinline__ void done(const Unit&) const {}
};
struct GroupedSplitOrder {
    GroupedOrder go; const volatile PG8_LAS int* ps; int Pf, r, sk, ntsub;
    __device__ __forceinline__ void init(const int* pstart, volatile PG8_LAS int* tab  , int N, int ntK_, int G_, int c_) {
        if (threadIdx.x < 9) tab[9 + threadIdx.x] = pstart[threadIdx.x];
        const int P = __builtin_amdgcn_readfirstlane(pstart[8]);
        const int nN = N / BM, ppr = G_ / nN; Pf = (P / ppr) * ppr; r = P - Pf; sk = pick_split(r, nN, ntK_, G_); ntsub = ntK_ / sk;
        go.init(pstart, tab, N, ntK_, G_, c_, Pf); ps = tab + 9;
    }
    __device__ __forceinline__ bool next(int i, Unit& u) const {
        long L = (long)i * go.G + go.c; Unit t; t.pm = 0; t.pn = 0; t.eks = 0; t.nt = 0; bool ok;
        if (L < go.nwg) ok = go.next(i, t);
        else { L -= go.nwg; const int per = go.nN * sk; ok = L < (long)r * per;
            const int pl = (int)(L / per), rem = (int)(L % per); t.pm = Pf + pl; t.pn = rem % go.nN; const int ks = rem / go.nN; t.nt = ntsub;
            int e = 0;
#pragma unroll
            for (int k = 0; k < 8; ++k) { const int a = __builtin_amdgcn_readfirstlane(ps[k]), b = __builtin_amdgcn_readfirstlane(ps[k + 1]); if (t.pm >= a && t.pm < b) e = k; }
            t.eks = e | (ks << 8); }
        u.pm = t.pm; u.pn = t.pn; u.eks = t.eks; u.nt = t.nt; return ok;
    }
    __device__ __forceinline__ void a_ready(const Unit&) const {}
    __device__ __forceinline__ void done(const Unit&) const {}
};
struct InProjLastOrder {
    StaticOrder so;
    __device__ __forceinline__ void init(int G_, int c_) { so.init(8192, 4608, 32, G_, c_); }
    __device__ __forceinline__ bool next(int i, Unit& u) const {
        const long L = (long)i * so.G + so.c; Unit t; t.pm = 0; t.pn = 0; t.eks = 0; t.nt = 0; bool ok;
        if (L < so.nwg) ok = so.next(i, t);
        else { ok = L < so.nwg + 8 && so.c < so.G; t.pm = 32; t.pn = 10 + (int)(L - so.nwg); t.eks = 0; t.nt = so.ntK; }
        u.pm = t.pm; u.pn = t.pn; u.eks = t.eks; u.nt = t.nt; return ok;
    }
    __device__ __forceinline__ void a_ready(const Unit&) const {}
    __device__ __forceinline__ void done(const Unit&) const {}
};

template <class Epi, class Sched, bool ALIGN_EPI = false, bool SP2 = false, int ES = 2>
__device__ __forceinline__ void gemm_phase(PG8_LAS unsigned char* lds, const Gemm g, const Sched& S, const Epi& E) {
    const int tid = threadIdx.x, wid = __builtin_amdgcn_readfirstlane(tid >> 6), lane = tid & 63, wr = wid >> 2, wc = wid & 3, fr = lane & 15, fq = lane >> 4;
    const int K = g.K;
    unsigned voffA[2], voffB[2];
#pragma unroll
    for (int i = 0; i < 2; ++i) { int R, C; stage_rc(tid * 16 + i * 8192, R, C); const int Rb = Epi::PERM == 1 ? ((R & ~31) + perm32(R & 31)) : (Epi::PERM == 2 ? sigma128(R) : R);
        voffA[i] = (unsigned)(R * K * ES + C * 2); voffB[i] = (unsigned)(Rb * K * ES + C * 2); }
    const size_t kstep = (size_t)(BK * 2);
    const size_t hstep = (size_t)HALF * K * ES;
    const size_t tstep = 2 * hstep;
    const unsigned ldsw = (unsigned)wid * 1024u;
    const int aoff = lds_byte(wr * 64 + fr, fq * 8), boff = lds_byte(wc * 32 + fr, fq * 8);
#define PG8_SA(b, h) (((b) * 2 + (h)) * HTB)
#define PG8_SB(b, h) ((4 + (b) * 2 + (h)) * HTB)
#define PG8_STAGE(bufoff, gbase, voff) do { _Pragma("unroll") for (int _i = 0; _i < 2; ++_i) \
        __builtin_amdgcn_global_load_lds((const unsigned*)((const char*)(gbase) + (voff)[_i]), (PG8_LAS unsigned*)(lds + (bufoff) + ldsw + _i * 8192), 16, 0, 0); } while (0)
#define PG8_LDA(dst, b, h) do { _Pragma("unroll") for (int m = 0; m < 4; ++m) { dst[m].lo = *(const PG8_LAS i32x4*)(lds + PG8_SA(b, h) + aoff + m * 2048); dst[m].hi = *(const PG8_LAS i32x4*)(lds + PG8_SA(b, h) + aoff + m * 2048 + 1024); } } while (0)
#define PG8_LDB(dst, b, h) do { _Pragma("unroll") for (int n = 0; n < 2; ++n) { dst[n].lo = *(const PG8_LAS i32x4*)(lds + PG8_SB(b, h) + boff + n * 2048); dst[n].hi = *(const PG8_LAS i32x4*)(lds + PG8_SB(b, h) + boff + n * 2048 + 1024); } } while (0)
#define PG8_MMA(ai, bj, At, Bt) do { __builtin_amdgcn_s_setprio(1); _Pragma("unroll") for (int m = 0; m < 4; ++m) _Pragma("unroll") for (int n = 0; n < 2; ++n) { \
        if constexpr (ES == 2) { acc[ai][bj][m][n] = __builtin_amdgcn_mfma_f32_16x16x32_bf16(as_bf16x8(Bt[n].lo), as_bf16x8(At[m].lo), acc[ai][bj][m][n], 0, 0, 0); \
                                 acc[ai][bj][m][n] = __builtin_amdgcn_mfma_f32_16x16x32_bf16(as_bf16x8(Bt[n].hi), as_bf16x8(At[m].hi), acc[ai][bj][m][n], 0, 0, 0); } \
        else { asm volatile("v_mfma_f32_16x16x128_f8f6f4 %0, %1, %2, %0" : "+v"(acc[ai][bj][m][n]) : "v"(Bt[n]), "v"(At[m])); } } \
        __builtin_amdgcn_s_setprio(0); } while (0)
#define PG8_WAIT_V(n) asm volatile("s_waitcnt vmcnt(" #n ")" ::: "memory")
#define PG8_WAIT_L(n) asm volatile("s_waitcnt lgkmcnt(" #n ")" ::: "memory")
#define PG8_BAR __builtin_amdgcn_s_barrier()
#define PG8_SCHED __builtin_amdgcn_sched_barrier(0)
    Unit cur, nxt; int ui = 0;
    if (!S.next(0, cur)) return;
    f32x4 acc[2][2][4][2];
#pragma unroll
    for (int a = 0; a < 2; ++a)
#pragma unroll
        for (int b = 0; b < 2; ++b)
#pragma unroll
            for (int m = 0; m < 4; ++m)
#pragma unroll
                for (int n = 0; n < 2; ++n) acc[a][b][m][n] = (f32x4){0.f, 0.f, 0.f, 0.f};
    i32x8 At[4], B0[2], B1[2];
    const char* cA = (const char*)g.A + (size_t)cur.pm * tstep + (size_t)(cur.ks() * cur.nt) * kstep; const char* cB = (const char*)g.Bt + (size_t)cur.e() * g.estride * ES + (size_t)cur.pn * tstep + (size_t)(cur.ks() * cur.nt) * kstep;
    S.a_ready(cur);
    if constexpr (SP2) {
        PG8_STAGE(PG8_SB(0, 0), cB, voffB); PG8_STAGE(PG8_SB(0, 1), cB + hstep, voffB); PG8_STAGE(PG8_SA(0, 0), cA, voffA); PG8_STAGE(PG8_SA(0, 1), cA + hstep, voffA);
        if (wr == 1) PG8_BAR;
        PG8_WAIT_V(2); PG8_BAR;
        PG8_STAGE(PG8_SB(1, 0), cB + kstep, voffB); PG8_STAGE(PG8_SA(1, 0), cA + kstep, voffA); PG8_STAGE(PG8_SB(1, 1), cB + hstep + kstep, voffB);
        PG8_WAIT_V(6); PG8_BAR;
    } else {
        PG8_STAGE(PG8_SB(0, 0), cB, voffB); PG8_STAGE(PG8_SA(0, 0), cA, voffA); PG8_STAGE(PG8_SB(0, 1), cB + hstep, voffB); PG8_STAGE(PG8_SA(0, 1), cA + hstep, voffA);
        if (wr == 1) PG8_BAR;
        PG8_WAIT_V(4); PG8_BAR;
        PG8_STAGE(PG8_SB(1, 0), cB + kstep, voffB); PG8_STAGE(PG8_SA(1, 0), cA + kstep, voffA); PG8_STAGE(PG8_SB(1, 1), cB + hstep + kstep, voffB);
        PG8_WAIT_V(6); PG8_BAR;
    }
    for (;;) {
        const bool has_next = S.next(ui + 1, nxt);
        const char* nA = has_next ? (const char*)g.A + (size_t)nxt.pm * tstep + (size_t)(nxt.ks() * nxt.nt) * kstep : cA; const char* nB = has_next ? (const char*)g.Bt + (size_t)nxt.e() * g.estride * ES + (size_t)nxt.pn * tstep + (size_t)(nxt.ks() * nxt.nt) * kstep : cB;
        const int nt = cur.nt;
        for (int t = 0; t < nt; t += 2) {
            const bool last = (t == nt - 2);
            const char* a1 = cA + (size_t)(t + 1) * kstep;
            const char* a2 = last ? nA : cA + (size_t)(t + 2) * kstep; const char* b2 = last ? nB : cB + (size_t)(t + 2) * kstep;
            const char* a3 = a2 + kstep; const char* b3 = b2 + kstep;
            if (last && has_next) S.a_ready(nxt);
            if constexpr (SP2) {
            PG8_LDB(B0, 0, 0); PG8_LDB(B1, 0, 1); PG8_SCHED; PG8_LDA(At, 0, 0); PG8_STAGE(PG8_SA(1, 1), a1 + hstep, voffA);
            PG8_WAIT_V(8); PG8_WAIT_L(0); PG8_BAR; PG8_MMA(0, 0, At, B0); PG8_MMA(0, 1, At, B1); PG8_BAR; PG8_SCHED;
            PG8_LDA(At, 0, 1); PG8_STAGE(PG8_SB(0, 0), b2, voffB); PG8_STAGE(PG8_SB(0, 1), b2 + hstep, voffB); PG8_STAGE(PG8_SA(0, 0), a2, voffA);
            PG8_WAIT_V(8); PG8_WAIT_L(0); PG8_BAR; PG8_MMA(1, 0, At, B0); PG8_MMA(1, 1, At, B1); PG8_BAR; PG8_SCHED;
            PG8_LDB(B0, 1, 0); PG8_LDB(B1, 1, 1); PG8_SCHED; PG8_LDA(At, 1, 0); PG8_STAGE(PG8_SA(0, 1), a2 + hstep, voffA);
            PG8_WAIT_V(8); PG8_WAIT_L(0); PG8_BAR; PG8_MMA(0, 0, At, B0); PG8_MMA(0, 1, At, B1); PG8_BAR; PG8_SCHED;
            PG8_LDA(At, 1, 1); PG8_STAGE(PG8_SB(1, 0), b3, voffB); PG8_STAGE(PG8_SB(1, 1), b3 + hstep, voffB); PG8_STAGE(PG8_SA(1, 0), a3, voffA);
            PG8_WAIT_V(8); PG8_WAIT_L(0); PG8_BAR; PG8_MMA(1, 0, At, B0); PG8_MMA(1, 1, At, B1); PG8_BAR; PG8_SCHED;
            } else {
            PG8_LDB(B0, 0, 0); PG8_SCHED; PG8_LDA(At, 0, 0); PG8_STAGE(PG8_SA(1, 1), a1 + hstep, voffA);
            PG8_WAIT_L(8); PG8_BAR; PG8_WAIT_L(0); PG8_MMA(0, 0, At, B0); PG8_BAR; PG8_SCHED;
            PG8_LDB(B1, 0, 1); PG8_STAGE(PG8_SB(0, 0), b2, voffB);
            PG8_BAR; PG8_WAIT_L(0); PG8_MMA(0, 1, At, B1); PG8_BAR;
            PG8_LDA(At, 0, 1); PG8_STAGE(PG8_SA(0, 0), a2, voffA);
            PG8_BAR; PG8_WAIT_L(0); PG8_MMA(1, 0, At, B0); PG8_BAR; PG8_SCHED;
            PG8_STAGE(PG8_SB(0, 1), b2 + hstep, voffB);
            PG8_WAIT_V(6); PG8_BAR; PG8_MMA(1, 1, At, B1); PG8_BAR;
            PG8_LDB(B0, 1, 0); PG8_SCHED; PG8_LDA(At, 1, 0); PG8_STAGE(PG8_SA(0, 1), a2 + hstep, voffA);
            PG8_WAIT_L(8); PG8_BAR; PG8_WAIT_L(0); PG8_MMA(0, 0, At, B0); PG8_BAR; PG8_SCHED;
            PG8_LDB(B1, 1, 1); PG8_STAGE(PG8_SB(1, 0), b3, voffB);
            PG8_BAR; PG8_WAIT_L(0); PG8_MMA(0, 1, At, B1); PG8_BAR;
            PG8_LDA(At, 1, 1); PG8_STAGE(PG8_SA(1, 0), a3, voffA);
            PG8_BAR; PG8_WAIT_L(0); PG8_MMA(1, 0, At, B0); PG8_BAR; PG8_SCHED;
            PG8_STAGE(PG8_SB(1, 1), b3 + hstep, voffB);
            PG8_WAIT_V(6); PG8_BAR; PG8_MMA(1, 1, At, B1); PG8_BAR;
            }
        }
        if constexpr (ES == 1) asm volatile("s_nop 15\n\ts_nop 15" ::: "memory");
        if constexpr (ALIGN_EPI) { if (wr == 0) PG8_BAR; }
        if constexpr (!Epi::AFTER_DRAIN) { E(acc, cur, wr, wc, fr, fq); S.done(cur); }
        if (!has_next) break;
#pragma unroll
        for (int a = 0; a < 2; ++a)
#pragma unroll
            for (int b = 0; b < 2; ++b)
#pragma unroll
                for (int m = 0; m < 4; ++m)
#pragma unroll
                    for (int n = 0; n < 2; ++n) acc[a][b][m][n] = (f32x4){0.f, 0.f, 0.f, 0.f};
        cur = nxt; cA = nA; cB = nB; ++ui;
        if constexpr (ALIGN_EPI) { if (wr == 1) PG8_BAR; }
    }
    PG8_WAIT_V(0);
    if constexpr (!ALIGN_EPI) { if (wr == 0) PG8_BAR; }
    PG8_BAR;
    if constexpr (Epi::AFTER_DRAIN) { E.fused(acc, cur, wr, wc, fr, fq, lds, wid, lane); S.done(cur); }
#undef PG8_SA
#undef PG8_SB
#undef PG8_STAGE
#undef PG8_LDA
#undef PG8_LDB
#undef PG8_MMA
#undef PG8_WAIT_V
#undef PG8_WAIT_L
#undef PG8_BAR
#undef PG8_SCHED
}
}

constexpr int D = 2048, SEQ = 8192, CTX = 256, MROWS = SEQ + CTX;
constexpr int INW = 4608, FFN = 7168, NEXP = 8;
constexpr int C_QB = 1024, C_QC = 1792, C_KB = 2560, C_VB = 2816, C_KC = 3072, C_VC = 3840;
constexpr int Y_B = 512, Y_C = 1280;
constexpr int MAXPAN = 72, MAXSLOT = MAXPAN * 256;
constexpr float EPS = 1e-6f;
constexpr float S_H8 = 16.f, S_WGU8 = 256.f, S_ACT8 = 8.f, S_WDN8 = 512.f;
constexpr int NWAVES = 8, NTHR = 512;

#define GAS __attribute__((address_space(1)))
#define LAS __attribute__((address_space(3)))
typedef unsigned short bf16;
typedef float f32x4 __attribute__((ext_vector_type(4)));
typedef unsigned v4u __attribute__((ext_vector_type(4)));
typedef unsigned v2u __attribute__((ext_vector_type(2)));
typedef short bf16x8 __attribute__((ext_vector_type(8)));
typedef short s16x4 __attribute__((ext_vector_type(4)));
typedef GAS unsigned gu32;
#define RLX_AGENT __ATOMIC_RELAXED, __HIP_MEMORY_SCOPE_AGENT
__device__ __forceinline__ float bf2f(bf16 v) { return __uint_as_float(((unsigned)v) << 16); }
__device__ __forceinline__ unsigned f2bf(float f) { unsigned u = __float_as_uint(f); return (u + 0x7fffu + ((u >> 16) & 1u)) >> 16; }
__device__ __forceinline__ unsigned pk2(float lo, float hi) { return f2bf(lo) | (f2bf(hi) << 16); }
__device__ __forceinline__ f32x4 ld4bf(const bf16* p) { const v2u u = *(const v2u*)p; return (f32x4){__uint_as_float(u.x << 16), __uint_as_float(u.x & 0xffff0000u), __uint_as_float(u.y << 16), __uint_as_float(u.y & 0xffff0000u)}; }
__device__ __forceinline__ void st4bf(bf16* p, f32x4 v) { v2u o; o.x = pk2(v.x, v.y); o.y = pk2(v.z, v.w); *(GAS v2u*)p = o; }
__device__ __forceinline__ float wave_sum(float v) {
#pragma unroll
    for (int o = 1; o < 64; o <<= 1) v += __shfl_xor(v, o);
    return v;
}

constexpr size_t MiB = 1u << 20;
constexpr size_t al(size_t x) { return (x + MiB - 1) / MiB * MiB; }
constexpr size_t WS_CTL = 0, CTL_ZERO_BYTES = 1 * MiB;
constexpr size_t WS_MOD = 1 * MiB;
constexpr size_t WS_ROPE = WS_MOD + 512 * 1024;
constexpr size_t WS_TOKE = 2 * MiB, WS_TOKW = WS_TOKE + 65536, WS_SLOT = WS_TOKW + 65536, WS_PSTART = WS_SLOT + 65536;
constexpr size_t WS_WIN = 4 * MiB;
constexpr size_t WS_WOUT = WS_WIN + al((size_t)2 * INW * D * 2);
constexpr size_t WS_WGU = WS_WOUT + al((size_t)2 * D * D * 2);
constexpr size_t WS_WDN = WS_WGU + al((size_t)2 * FFN * D * 2);
constexpr size_t WS_MGU = WS_WDN + al((size_t)D * FFN * 2);
constexpr size_t WS_MDN = WS_MGU + al((size_t)NEXP * 2 * FFN * D * 2);
constexpr size_t WS_H = WS_MDN + al((size_t)NEXP * D * FFN * 2);
constexpr size_t WS_P = WS_H + al((size_t)MROWS * D * 2);
constexpr size_t WS_Y = WS_P + al((size_t)MROWS * INW * 2);
constexpr size_t WS_Y2 = WS_Y + al((size_t)MROWS * D * 2);
constexpr size_t WS_ACT = WS_Y2 + al((size_t)MAXSLOT * D * 4);
constexpr size_t WS_HP = WS_ACT + al((size_t)MAXSLOT * FFN * 2);
constexpr size_t WS_Z = WS_HP + al((size_t)MAXSLOT * D * 2);
constexpr size_t WS_PART = WS_Z + al((size_t)CTX * D * 4);
constexpr size_t WS_XB = WS_PART + 64 * MiB;
constexpr size_t WS_END = WS_XB + al((size_t)MROWS * D * 2);
constexpr int CW_TMO = 0, CW_CODE = 1;
constexpr int CW_BAR = 4096;
constexpr int CW_CHEAD = 8192;
constexpr int CW_QUEUE = 16384;

constexpr int RING_BYTES = 131072;
constexpr int LDSCTL_OFF = RING_BYTES, MISC_OFF = LDSCTL_OFF + 320;
constexpr int LDS_BYTES = 147456;

#define XB_TMO      128
#define XB_XCNT(j)  (256  + 64 * (j))
#define XB_XSUB(j)  (1280 + 64 * (j))
#define XB_XGEN(j)  (2304 + 64 * (j))
#define XB_TOP      3328
#define XB_TOPGEN   3392
#define XCD_BAR_WORDS 3456
#define XB_SPIN_CAP (1u << 18)
__device__ __forceinline__ unsigned xb_ld(unsigned* p)              { return __hip_atomic_load(p, __ATOMIC_RELAXED, __HIP_MEMORY_SCOPE_AGENT); }
__device__ __forceinline__ unsigned xb_add(unsigned* p, unsigned v) { return __hip_atomic_fetch_add(p, v, __ATOMIC_RELAXED, __HIP_MEMORY_SCOPE_AGENT); }
__device__ __forceinline__ unsigned xb_xcc_id() { return (unsigned)__builtin_amdgcn_s_getreg((3 << 11) | 20) & 0xFu; }
#define XB_SPIN(cond, bar) do { unsigned _sp = 0; while (cond) { __builtin_amdgcn_s_sleep(1); \
    if ((++_sp & 255u) == 0u) { if (xb_ld(&(bar)[XB_TMO])) break; if (_sp > XB_SPIN_CAP) { atomicAdd(&(bar)[XB_TMO], 1u); break; } } } } while (0)
struct XcdBarrier { unsigned* bar; unsigned x; volatile LAS unsigned* st; };
__device__ __forceinline__ XcdBarrier xcd_barrier_post(unsigned* bar, volatile LAS unsigned* st) {
    XcdBarrier b; b.bar = bar; b.x = xb_xcc_id(); b.st = st;
    if (threadIdx.x == 0) (void)xb_add(&bar[XB_XCNT(b.x)], 1u);
    return b;
}
__device__ __forceinline__ void xcd_barrier_complete(unsigned* bar, unsigned x, unsigned& nloc, unsigned& nx) {
    const unsigned G = gridDim.x * gridDim.y * gridDim.z;
    unsigned sum, cnt, mine, sp = 0u;
    for (;;) {
        sum = 0u; cnt = 0u; mine = 0u;
#pragma unroll
        for (unsigned j = 0; j < 16; ++j) { const unsigned c = xb_ld(&bar[XB_XCNT(j)]); sum += c; cnt += (c > 0u) ? 1u : 0u; mine = (j == x) ? c : mine; }
        if (sum == G) break;
        __builtin_amdgcn_s_sleep(1);
        if ((++sp & 255u) == 0u) { if (xb_ld(&bar[XB_TMO])) break; if (sp > XB_SPIN_CAP) { atomicAdd(&bar[XB_TMO], 1u); break; } }
    }
    nloc = mine > 0u ? mine : 1u; nx = cnt > 0u ? cnt : 1u;
}
__device__ __forceinline__ void xcd_barrier(const XcdBarrier& b) {
    asm volatile("s_waitcnt vmcnt(0)" ::: "memory");
    __syncthreads();
    if (threadIdx.x == 0) {
        unsigned* bar = b.bar;
        __builtin_amdgcn_s_waitcnt(0);
        unsigned nloc = b.st[0], nx = b.st[1];
        if (nloc == 0u) { xcd_barrier_complete(bar, b.x, nloc, nx); b.st[0] = nloc; b.st[1] = nx; }
        const unsigned old = xb_add(&bar[XB_XSUB(b.x)], 1u);
        const unsigned gen = old / nloc;
        if (old + 1u == (gen + 1u) * nloc) {
            __builtin_amdgcn_fence(__ATOMIC_RELEASE, "agent");
            asm volatile("s_waitcnt vmcnt(0)" ::: "memory");
            const unsigned og = xb_add(&bar[XB_TOP], 1u);
            const unsigned tg = og / nx;
            if (og + 1u == (tg + 1u) * nx) xb_add(&bar[XB_TOPGEN], 1u);
            else XB_SPIN(xb_ld(&bar[XB_TOPGEN]) == tg, bar);
            __builtin_amdgcn_fence(__ATOMIC_ACQUIRE, "agent");
            xb_add(&bar[XB_XGEN(b.x)], 1u);
            asm volatile("s_waitcnt vmcnt(0)" ::: "memory");
        } else {
            XB_SPIN(xb_ld(&bar[XB_XGEN(b.x)]) == gen, bar);
            __builtin_amdgcn_fence(__ATOMIC_ACQUIRE, "agent");
            asm volatile("s_waitcnt vmcnt(0)" ::: "memory");
        }
    }
    __syncthreads();
}

struct Frame {
    LAS unsigned char* lds; volatile LAS unsigned* MISC; gu32* ctl;
    int tid, lane, wave, vcu, G;
    const float* in[22]; float* out; unsigned char* ws;
};
#define LDS_WAIT() asm volatile("s_waitcnt lgkmcnt(0)" ::: "memory")

template <int MAP> __device__ __forceinline__ int dest_row(int n) { if (MAP == 0) return n; const int b = n >= FFN, nn = n - b * FFN; return 256 * (nn >> 7) + 128 * b + (nn & 127); }
template <int MAP> __device__ __forceinline__ void conv_item(const float* W, int K, int N, bf16* WT, LAS float* scr, int item, int lane) {
    const int nblk = N / 32, kb = item / nblk, nb = item % nblk, k0 = 64 * kb, n0 = 32 * nb;
    { float t_[32];
#pragma unroll
      for (int i = 0; i < 32; ++i) { const int kk = 2 * i + (lane >> 5); t_[i] = __builtin_nontemporal_load(W + (size_t)(k0 + kk) * N + n0 + (lane & 31)); }
#pragma unroll
      for (int i = 0; i < 32; ++i) { const int kk = 2 * i + (lane >> 5); scr[kk * 33 + (lane & 31)] = t_[i]; } }
    LDS_WAIT(); asm volatile("" ::: "memory");
    const int c = lane & 7; const int r0 = dest_row<MAP>(n0);
#pragma unroll
    for (int j = 0; j < 4; ++j) { const int n = (lane >> 3) + 8 * j; const LAS float* s = scr + (8 * c) * 33 + n;
        v4u o; o.x = pk2(s[0 * 33], s[1 * 33]); o.y = pk2(s[2 * 33], s[3 * 33]); o.z = pk2(s[4 * 33], s[5 * 33]); o.w = pk2(s[6 * 33], s[7 * 33]);
        __builtin_nontemporal_store(o, (GAS v4u*)(WT + (size_t)(r0 + n) * K + k0 + 8 * c)); }
    LDS_WAIT(); asm volatile("" ::: "memory");
}
__device__ __forceinline__ unsigned pk4_fp8s(float a, float b, float c, float d, float sc) { return pg8::pk4_fp8(a * sc, b * sc, c * sc, d * sc); }
template <int MAP> __device__ __forceinline__ void conv_item8(const float* W, int K, int N, unsigned char* WT, float scale, LAS float* scr, int item, int lane) {
    const int nblk = N / 32, kb = item / nblk, nb = item % nblk, k0 = 128 * kb, n0 = 32 * nb;
    const int c = lane & 7; const int r0 = dest_row<MAP>(n0);
    v4u o[4];
    float t0_[32], t1_[32];
#pragma unroll
    for (int i = 0; i < 32; ++i) { const int kk = 2 * i + (lane >> 5); t0_[i] = __builtin_nontemporal_load(W + (size_t)(k0 + kk) * N + n0 + (lane & 31)); }
#pragma unroll
    for (int i = 0; i < 32; ++i) { const int kk = 2 * i + (lane >> 5); t1_[i] = __builtin_nontemporal_load(W + (size_t)(k0 + 64 + kk) * N + n0 + (lane & 31)); }
#pragma unroll
    for (int pass = 0; pass < 2; ++pass) {
#pragma unroll
        for (int i = 0; i < 32; ++i) { const int kk = 2 * i + (lane >> 5); scr[kk * 33 + (lane & 31)] = pass == 0 ? t0_[i] : t1_[i]; }
        LDS_WAIT(); asm volatile("" ::: "memory");
        if ((c >> 2) == pass) {
#pragma unroll
            for (int j = 0; j < 4; ++j) { const int n = (lane >> 3) + 8 * j; const LAS float* sp = scr + (16 * (c & 3)) * 33 + n;
                o[j].x = pk4_fp8s(sp[0 * 33], sp[1 * 33], sp[2 * 33], sp[3 * 33], scale); o[j].y = pk4_fp8s(sp[4 * 33], sp[5 * 33], sp[6 * 33], sp[7 * 33], scale);
                o[j].z = pk4_fp8s(sp[8 * 33], sp[9 * 33], sp[10 * 33], sp[11 * 33], scale); o[j].w = pk4_fp8s(sp[12 * 33], sp[13 * 33], sp[14 * 33], sp[15 * 33], scale); } }
        LDS_WAIT(); asm volatile("" ::: "memory");
    }
#pragma unroll
    for (int j = 0; j < 4; ++j) { const int n = (lane >> 3) + 8 * j; __builtin_nontemporal_store(o[j], (GAS v4u*)(WT + (size_t)(r0 + n) * K + k0 + 16 * c)); }
}
constexpr int I_GU8 = (D / 128) * (2 * FFN / 32), I_DN8 = (FFN / 128) * (D / 32), NCONV8 = NEXP * (I_GU8 + I_DN8);
__device__ __forceinline__ void conv_dispatch8(Frame& F, LAS float* scr, int it) {
    int r = it;
    if (r < NEXP * I_GU8) { const int e = r / I_GU8; conv_item8<1>(F.in[20] + (size_t)e * D * 2 * FFN, D, 2 * FFN, F.ws + WS_MGU + (size_t)e * 2 * FFN * D, S_WGU8, scr, r % I_GU8, F.lane); return; } r -= NEXP * I_GU8;
    { const int e = r / I_DN8; conv_item8<0>(F.in[21] + (size_t)e * FFN * D, FFN, D, F.ws + WS_MDN + (size_t)e * D * FFN, S_WDN8, scr, r % I_DN8, F.lane); }
}
constexpr int I_IN = (D / 64) * (INW / 32), I_OUT = (D / 64) * (D / 32), I_GU = (D / 64) * (2 * FFN / 32), I_DN = (FFN / 64) * (D / 32);
constexpr int NCONV = 2 * I_IN + 2 * I_OUT + I_GU + I_DN;
constexpr int MV_B0 = I_GU, MV_B1 = MV_B0 + I_DN, MV_B2 = MV_B1 + I_IN, MV_B = MV_B2 + I_OUT, MV_ITEMS = MV_B + NCONV8, MV_ENT = MV_ITEMS / NWAVES;
constexpr int Q_G10 = 4020, Q_MX0 = 1600, Q_G30 = 3100, Q_G40 = 950, Q_G11 = 2900, Q_MX1 = MV_ENT - (Q_G10 + Q_MX0 + Q_G30 + Q_G40 + Q_G11);
constexpr int QB_G10 = 0, QB_MX0 = QB_G10 + Q_G10, QB_G30 = QB_MX0 + Q_MX0, QB_G40 = QB_G30 + Q_G30, QB_G11 = QB_G40 + Q_G40, QB_MX1 = QB_G11 + Q_G11;
static_assert(MV_ITEMS % NWAVES == 0 && Q_MX1 > 0 && Q_G10 * NWAVES >= MV_B, "the bf16 items (read from G3_0 / G1_1 on) must all sit in the first queue");
__device__ __forceinline__ void conv_dispatch8(Frame& F, LAS float* scr, int it);
template <int MAP> __device__ __forceinline__ void conv_item(const float* W, int K, int N, bf16* WT, LAS float* scr, int item, int lane);
__device__ __forceinline__ void conv_moved(Frame& F, LAS float* scr, int it) {
    if (it < MV_B0) conv_item<1>(F.in[17], D, 2 * FFN, (bf16*)(F.ws + WS_WGU), scr, it, F.lane);
    else if (it < MV_B1) conv_item<0>(F.in[18], FFN, D, (bf16*)(F.ws + WS_WDN), scr, it - MV_B0, F.lane);
    else if (it < MV_B2) conv_item<0>(F.in[10] + (size_t)D * INW, D, INW, (bf16*)(F.ws + WS_WIN) + (size_t)INW * D, scr, it - MV_B1, F.lane);
    else if (it < MV_B) conv_item<0>(F.in[16] + (size_t)D * D, D, D, (bf16*)(F.ws + WS_WOUT) + (size_t)D * D, scr, it - MV_B2, F.lane);
    else conv_dispatch8(F, scr, it - MV_B);
}
__device__ __forceinline__ void conv_queue(Frame& F, gu32* qw, int base_ent, int nent) {
    LAS float* scr = (LAS float*)(F.lds + 32768 + F.wave * 8704); volatile LAS int* tk = (volatile LAS int*)(F.MISC + 24);
    __syncthreads();
    if (F.tid == 0) tk[0] = (int)__hip_atomic_fetch_add(qw, 1u, RLX_AGENT);
    __syncthreads();
    int cv = tk[0];
    while (cv < nent) {
        unsigned nx = 0u;
        if (F.tid == 0) nx = __hip_atomic_fetch_add(qw, 1u, RLX_AGENT);
        conv_moved(F, scr, (base_ent + cv) * NWAVES + F.wave);
        __syncthreads();
        if (F.tid == 0) tk[0] = (int)nx;
        __syncthreads();
        cv = tk[0];
    }
}
constexpr int NCONV_PRO = I_IN + I_OUT;
__device__ __forceinline__ void conv_dispatch(Frame& F, LAS float* scr, int it) {
    if (it < I_IN) conv_item<0>(F.in[10], D, INW, (bf16*)(F.ws + WS_WIN), scr, it, F.lane);
    else conv_item<0>(F.in[16], D, D, (bf16*)(F.ws + WS_WOUT), scr, it - I_IN, F.lane);
}
__device__ __forceinline__ void p_prologue(Frame& F) {
    const int gw = F.vcu * NWAVES + F.wave, NGW = F.G * NWAVES;
    const int MODEQ = 0;
    for (int task = F.vcu; task < 256; task += F.G) {
        LAS float* sv = (LAS float*)F.lds;
        LAS float* red = (LAS float*)(F.lds + 16384);
        for (int k = F.tid; k < 2 * D; k += NTHR) { const float x = k < D ? F.in[1][k] : F.in[3][k - D]; sv[k] = x / (1.f + __expf(-x)); }
        __syncthreads();
        const int l = task >> 7, chunk = task & 127, rg = F.tid / 24, c4 = F.tid % 24;
        if (rg < 21) {
            const float* W = F.in[4] + (size_t)l * D * 6 * D + chunk * 96 + 4 * c4;
            f32x4 a0 = {0.f, 0.f, 0.f, 0.f}, a1 = {0.f, 0.f, 0.f, 0.f};
#pragma unroll 8
            for (int k = rg; k < D; k += 21) { const f32x4 w = __builtin_nontemporal_load((const f32x4*)(W + (size_t)k * 6 * D)); a0 += sv[k] * w; a1 += sv[D + k] * w; }
            *(LAS f32x4*)(red + (rg * 2 + 0) * 96 + 4 * c4) = a0; *(LAS f32x4*)(red + (rg * 2 + 1) * 96 + 4 * c4) = a1;
        }
        __syncthreads();
        if (F.tid < 192) { const int w = F.tid / 96, cc = F.tid % 96; float sacc = 0.f;
#pragma unroll
          for (int q = 0; q < 21; ++q) sacc += red[(q * 2 + w) * 96 + cc];
          ((float*)(F.ws + WS_MOD))[((size_t)l * 2 + w) * 6 * D + chunk * 96 + cc] = sacc + F.in[5][l * 6 * D + chunk * 96 + cc]; }
        __syncthreads();
    }
    { const int gt = blockIdx.x * NTHR + F.tid;
      if (gt < 128 * 32) { const int pos = gt >> 5, i = gt & 31; const float inv = exp2f(-(float)i * (13.287712379549449f / 32.f)); float sn, cs; sincosf((float)pos * inv, &sn, &cs);
          ((float*)(F.ws + WS_ROPE))[gt] = cs; ((float*)(F.ws + WS_ROPE))[4096 + gt] = sn; } }
    LAS float* scr = (LAS float*)(F.lds + 32768 + F.wave * 8704);
    { gu32* head = F.ctl + CW_CHEAD; volatile LAS int* sh = (volatile LAS int*)(F.MISC + 24); constexpr int N8 = 0; constexpr int NALL = NCONV_PRO, PULL = 16;
      (void)gw; (void)NGW; (void)MODEQ;
      if (F.tid == 0) sh[0] = (int)__hip_atomic_fetch_add(head, (unsigned)PULL, RLX_AGENT);
      __syncthreads();
      int h = sh[0];
      while (h < NALL) {
          unsigned nx = 0u;
          if (F.tid == 0) nx = __hip_atomic_fetch_add(head, (unsigned)PULL, RLX_AGENT);
#pragma unroll 1
          for (int k = 0; k < PULL / NWAVES; ++k) { const int it = h + NWAVES * k + F.wave; if (it < N8) conv_dispatch8(F, scr, it); else if (it < NALL) conv_dispatch(F, scr, it - N8); }
          __syncthreads();
          if (F.tid == 0) sh[0] = (int)nx;
          __syncthreads();
          h = sh[0];
      } }
}

__device__ __forceinline__ void p_prenorm0(Frame& F) {
    const int gw = F.wave * F.G + F.vcu, NGW = F.G * NWAVES; const float* MOD = (const float*)(F.ws + WS_MOD); bf16* H = (bf16*)(F.ws + WS_H); const float* gpre = F.in[6]; const int lane = F.lane;
    LAS float* cf = (LAS float*)F.lds;
    { const int col = 4 * F.tid;
#pragma unroll
      for (int pt = 0; pt < 2; ++pt) { const float* mod = MOD + pt * 6 * D;
          *(LAS f32x4*)(cf + (pt * 2 + 0) * D + col) = *(const f32x4*)(gpre + col) * (1.f + *(const f32x4*)(mod + D + col)); *(LAS f32x4*)(cf + (pt * 2 + 1) * D + col) = *(const f32x4*)(mod + col); }
      __syncthreads(); }
    int row = gw; if (row >= MROWS) return;
    f32x4 xc[8];
#define PN_LOAD(R, X) do { const float* src_ = (R) < SEQ ? F.in[0] + (size_t)(R) * D : F.in[2] + (size_t)((R) - SEQ) * D; _Pragma("unroll") for (int j = 0; j < 8; ++j) X[j] = __builtin_nontemporal_load((const f32x4*)(src_ + 4 * lane + 256 * j)); } while (0)
    PN_LOAD(row, xc);
    for (;;) {
        const int nrow = row + NGW; const bool more = nrow < MROWS;
        f32x4 xn[8]; if (more) PN_LOAD(nrow, xn);
        const int pt = row < SEQ ? 0 : 1; const LAS float* cA = cf + (pt * 2 + 0) * D + 4 * lane; const LAS float* cB = cf + (pt * 2 + 1) * D + 4 * lane;
        float ss = 0.f;
#pragma unroll
        for (int j = 0; j < 8; ++j) ss += (xc[j].x * xc[j].x + xc[j].y * xc[j].y) + (xc[j].z * xc[j].z + xc[j].w * xc[j].w);
        const float r = rsqrtf(wave_sum(ss) * (1.f / D) + EPS);
#pragma unroll
        for (int j = 0; j < 8; ++j) { const int col = 4 * lane + 256 * j; const f32x4 h = (xc[j] * r) * *(const LAS f32x4*)(cA + 256 * j) + *(const LAS f32x4*)(cB + 256 * j);
            v2u o; o.x = pk2(h.x, h.y); o.y = pk2(h.z, h.w); *(GAS v2u*)(H + (size_t)row * D + col) = o; }
        if (!more) break;
#pragma unroll
        for (int j = 0; j < 8; ++j) xc[j] = xn[j];
        row = nrow;
    }
#undef PN_LOAD
}
template <bool XF32> __device__ __forceinline__ void p_post(Frame& F, const bf16* Y2, const float* gpost, int gate_off, const float* gmod  ,
                                       const float* xlat_src, const float* xctx_src, bf16* XB, int nrows,
                                       const float* gpre, const float* pmod  , int sh_off, int sc_off, bf16* H, const float* wrouter, int* tok_e, float* tok_w, const bf16* part, int npart) {
    const int gw = F.wave * F.G + F.vcu, NGW = F.G * NWAVES; const int lane = F.lane;
    LAS float* wrt = (LAS float*)F.lds;
    if (wrouter) { const int t = F.tid; f32x4 rw[8];
#pragma unroll
        for (int q = 0; q < 8; ++q) rw[q] = *(const f32x4*)(wrouter + (size_t)(4 * t) * NEXP + 4 * q);
#pragma unroll
        for (int e = 0; e < 8; ++e) { f32x4 o; o.x = rw[0 + (e >> 2)][e & 3]; o.y = rw[2 + (e >> 2)][e & 3]; o.z = rw[4 + (e >> 2)][e & 3]; o.w = rw[6 + (e >> 2)][e & 3]; *(LAS f32x4*)(wrt + e * D + 4 * t) = o; }
        __syncthreads(); }
    LAS float* cf = (LAS float*)(F.lds + 65536);
    { const int col = 4 * F.tid;
#pragma unroll
      for (int pt = 0; pt < 2; ++pt) { const float* gm = gmod + pt * 6 * D; const float* pm = pmod + pt * 6 * D;
          *(LAS f32x4*)(cf + (pt * 3 + 0) * D + col) = *(const f32x4*)(gm + gate_off + col) * *(const f32x4*)(gpost + col);
          *(LAS f32x4*)(cf + (pt * 3 + 1) * D + col) = *(const f32x4*)(gpre + col) * (1.f + *(const f32x4*)(pm + sc_off + col));
          *(LAS f32x4*)(cf + (pt * 3 + 2) * D + col) = *(const f32x4*)(pm + sh_off + col); }
      __syncthreads(); }
#pragma unroll 1
    for (int part_o = 0; part_o < 2; ++part_o) {
        const int part_i = 1 - part_o; const bool lat = part_i == 0;
        const int rend = lat ? (nrows < SEQ ? nrows : SEQ) : nrows;
        int row = lat ? gw : SEQ + gw;
        if (row >= rend) continue;
        const LAS float* cA1 = cf + (part_i * 3 + 0) * D + 4 * lane; const LAS float* cA2 = cf + (part_i * 3 + 1) * D + 4 * lane; const LAS float* cB2 = cf + (part_i * 3 + 2) * D + 4 * lane;
        v2u yc[8]; f32x4 xcf[XF32 ? 8 : 1]; v2u xcb[XF32 ? 1 : 8];
#define PP_LOAD(R, YD, XF, XBD) do { const bf16* y_ = Y2 + (size_t)(R) * D; _Pragma("unroll") for (int j = 0; j < 8; ++j) { const int col = 4 * lane + 256 * j; YD[j] = *(const v2u*)(y_ + col); \
            if constexpr (XF32) { const float* xs_ = (R) < SEQ ? xlat_src + (size_t)(R) * D : xctx_src + (size_t)((R) - SEQ) * D; XF[j] = *(const f32x4*)(xs_ + col); } \
            else XBD[j] = *(const v2u*)(XB + (size_t)(R) * D + col); } } while (0)
        PP_LOAD(row, yc, xcf, xcb);
        for (;;) {
            const int nrow = row + NGW; const bool more = nrow < rend;
            v2u yn[8]; f32x4 xnf[XF32 ? 8 : 1]; v2u xnb[XF32 ? 1 : 8];
            if constexpr (!XF32) { if (more) PP_LOAD(nrow, yn, xnf, xnb); }
            f32x4 v[8]; float ss = 0.f;
#pragma unroll
            for (int j = 0; j < 8; ++j) v[j] = (f32x4){__uint_as_float(yc[j].x << 16), __uint_as_float(yc[j].x & 0xffff0000u), __uint_as_float(yc[j].y << 16), __uint_as_float(yc[j].y & 0xffff0000u)};
            if (!lat) {
#pragma unroll 1
                for (int p = 0; p < npart; ++p) { const bf16* pp = part + ((size_t)p * CTX + (row - SEQ)) * D + 4 * lane; v2u t[8];
#pragma unroll
                    for (int j = 0; j < 8; ++j) t[j] = *(const v2u*)(pp + 256 * j);
#pragma unroll
                    for (int j = 0; j < 8; ++j) v[j] += (f32x4){__uint_as_float(t[j].x << 16), __uint_as_float(t[j].x & 0xffff0000u), __uint_as_float(t[j].y << 16), __uint_as_float(t[j].y & 0xffff0000u)}; } }
#pragma unroll
            for (int j = 0; j < 8; ++j) ss += (v[j].x * v[j].x + v[j].y * v[j].y) + (v[j].z * v[j].z + v[j].w * v[j].w);
            const float r = rsqrtf(wave_sum(ss) * (1.f / D) + EPS);
            float s2 = 0.f; bf16* xb = XB + (size_t)row * D;
#pragma unroll
            for (int j = 0; j < 8; ++j) { const int col = 4 * lane + 256 * j; f32x4 x;
                if constexpr (XF32) x = xcf[j]; else x = (f32x4){__uint_as_float(xcb[j].x << 16), __uint_as_float(xcb[j].x & 0xffff0000u), __uint_as_float(xcb[j].y << 16), __uint_as_float(xcb[j].y & 0xffff0000u)};
                v[j] = x + *(const LAS f32x4*)(cA1 + 256 * j) * (v[j] * r); { v2u xo_; xo_.x = pk2(v[j].x, v[j].y); xo_.y = pk2(v[j].z, v[j].w); __builtin_nontemporal_store(xo_, (GAS v2u*)(xb + col)); } s2 += (v[j].x * v[j].x + v[j].y * v[j].y) + (v[j].z * v[j].z + v[j].w * v[j].w); }
            const float r2 = rsqrtf(wave_sum(s2) * (1.f / D) + EPS);
            float lg[8] = {0.f, 0.f, 0.f, 0.f, 0.f, 0.f, 0.f, 0.f};
#pragma unroll
            for (int j = 0; j < 8; ++j) { const int col = 4 * lane + 256 * j;
                const f32x4 h = (v[j] * r2) * *(const LAS f32x4*)(cA2 + 256 * j) + *(const LAS f32x4*)(cB2 + 256 * j); v2u o; o.x = pk2(h.x, h.y); o.y = pk2(h.z, h.w); *(GAS v2u*)(H + (size_t)row * D + col) = o;
                if (wrouter) {
#pragma unroll
                    for (int e = 0; e < 8; ++e) { const f32x4 we = *(const LAS f32x4*)(wrt + e * D + col); lg[e] += (h.x * we.x + h.y * we.y) + (h.z * we.z + h.w * we.w); } } }
            if (wrouter) {
#pragma unroll
                for (int e = 0; e < 8; ++e) lg[e] = wave_sum(lg[e]);
                int i1 = 0; float v1 = lg[0];
#pragma unroll
                for (int e = 1; e < 8; ++e) if (lg[e] > v1) { v1 = lg[e]; i1 = e; }
                int i2 = -1; float v2 = -3.0e38f;
#pragma unroll
                for (int e = 0; e < 8; ++e) if (e != i1 && lg[e] > v2) { v2 = lg[e]; i2 = e; }
                const float w1 = 1.f / (1.f + __expf(v2 - v1));
                if (lane == 0) { tok_e[2 * row] = i1; tok_e[2 * row + 1] = i2; tok_w[2 * row] = w1; tok_w[2 * row + 1] = 1.f - w1; }
            }
            if (!more) break;
            if constexpr (XF32) { PP_LOAD(nrow, yc, xcf, xcb); }
            else {
#pragma unroll
                for (int j = 0; j < 8; ++j) { yc[j] = yn[j]; xcb[j] = xnb[j]; } }
            row = nrow;
        }
#undef PP_LOAD
    }
}
__device__ __forceinline__ void p_combine(Frame& F, const bf16* Y2e, const int* slot_of, const float* tok_w, const float* gpost, const float* gate, const bf16* xsrc, float* xdst, const bf16* part, const int* pstart) {
    const int gw = F.vcu * NWAVES + F.wave, NGW = F.G * NWAVES; const int lane = F.lane;
    const int Ptot = __builtin_amdgcn_readfirstlane(pstart[8]), ppr = F.G / (D / 256), Pf = (Ptot / ppr) * ppr, rr = Ptot - Pf, sk = pg8::pick_split(rr, D / 256, FFN / 128, F.G);
    const size_t pstride = (size_t)rr * 256 * D; const int slot_f = Pf * 256;
    LAS float* cf = (LAS float*)F.lds;
    { const int col = 4 * F.tid; *(LAS f32x4*)(cf + col) = *(const f32x4*)(gate + col) * *(const f32x4*)(gpost + col); __syncthreads(); }
    const LAS float* cA = cf + 4 * lane;
    int row = gw; if (row >= SEQ) return;
    v2u y1c[8], y2c[8], xc[8]; int s1 = slot_of[2 * row], s2 = slot_of[2 * row + 1]; float w1 = tok_w[2 * row], w2 = tok_w[2 * row + 1];
#define PC_LOAD(R, S1, S2, Y1, Y2_, X) do { _Pragma("unroll") for (int j = 0; j < 8; ++j) { const int col = 4 * lane + 256 * j; Y1[j] = *(const v2u*)(Y2e + (size_t)(S1) * D + col); Y2_[j] = *(const v2u*)(Y2e + (size_t)(S2) * D + col); X[j] = *(const v2u*)(xsrc + (size_t)(R) * D + col); } } while (0)
#define PC_F4(u) ((f32x4){__uint_as_float((u).x << 16), __uint_as_float((u).x & 0xffff0000u), __uint_as_float((u).y << 16), __uint_as_float((u).y & 0xffff0000u)})
    PC_LOAD(row, s1, s2, y1c, y2c, xc);
    for (;;) {
        const int nrow = row + NGW; const bool more = nrow < SEQ;
        v2u y1n[8], y2n[8], xn[8]; int s1n = 0, s2n = 0; float w1n = 0.f, w2n = 0.f;
        if (more) { s1n = slot_of[2 * nrow]; s2n = slot_of[2 * nrow + 1]; w1n = tok_w[2 * nrow]; w2n = tok_w[2 * nrow + 1]; PC_LOAD(nrow, s1n, s2n, y1n, y2n, xn); }
        f32x4 v[8]; float ss = 0.f;
#pragma unroll
        for (int j = 0; j < 8; ++j) v[j] = w1 * PC_F4(y1c[j]) + w2 * PC_F4(y2c[j]);
        if (s1 >= slot_f) {
#pragma unroll 1
            for (int p = 0; p < sk - 1; ++p) { const bf16* pp = part + (size_t)p * pstride + (size_t)(s1 - slot_f) * D + 4 * lane; v2u t[8];
#pragma unroll
                for (int j = 0; j < 8; ++j) t[j] = *(const v2u*)(pp + 256 * j);
#pragma unroll
                for (int j = 0; j < 8; ++j) v[j] += w1 * PC_F4(t[j]); } }
        if (s2 >= slot_f) {
#pragma unroll 1
            for (int p = 0; p < sk - 1; ++p) { const bf16* pp = part + (size_t)p * pstride + (size_t)(s2 - slot_f) * D + 4 * lane; v2u t[8];
#pragma unroll
                for (int j = 0; j < 8; ++j) t[j] = *(const v2u*)(pp + 256 * j);
#pragma unroll
                for (int j = 0; j < 8; ++j) v[j] += w2 * PC_F4(t[j]); } }
#pragma unroll
        for (int j = 0; j < 8; ++j) ss += (v[j].x * v[j].x + v[j].y * v[j].y) + (v[j].z * v[j].z + v[j].w * v[j].w);
        const float r = rsqrtf(wave_sum(ss) * (1.f / D) + EPS);
#pragma unroll
        for (int j = 0; j < 8; ++j) { const int col = 4 * lane + 256 * j;
            __builtin_nontemporal_store(PC_F4(xc[j]) + *(const LAS f32x4*)(cA + 256 * j) * (v[j] * r), (GAS f32x4*)(xdst + (size_t)row * D + col)); }
        if (!more) break;
#pragma unroll
        for (int j = 0; j < 8; ++j) { y1c[j] = y1n[j]; y2c[j] = y2n[j]; xc[j] = xn[j]; }
        s1 = s1n; s2 = s2n; w1 = w1n; w2 = w2n; row = nrow;
    }
#undef PC_LOAD
#undef PC_F4
}

__device__ __forceinline__ void p_route(Frame& F) {
    const int* tok_e = (const int*)(F.ws + WS_TOKE); int* slot_of = (int*)(F.ws + WS_SLOT); int* pstart = (int*)(F.ws + WS_PSTART);
    const bf16* H = (const bf16*)(F.ws + WS_H); unsigned char* HP = F.ws + WS_HP;
    LAS unsigned char* te = F.lds;
    LAS int* cnt = (LAS int*)(F.lds + 16384);
    LAS int* rowtok = (LAS int*)(F.lds + 32768);
    LAS int* ps = (LAS int*)(F.lds + 32768 + MAXSLOT * 4);
    const int t = F.tid;
    int c[8] = {0, 0, 0, 0, 0, 0, 0, 0};
#pragma unroll
    for (int j4 = 0; j4 < 8; ++j4) { const v4u ev = *(const v4u*)(tok_e + 32 * t + 4 * j4); const unsigned ee[4] = {ev.x, ev.y, ev.z, ev.w};
#pragma unroll
        for (int q = 0; q < 4; ++q) { te[32 * t + 4 * j4 + q] = (unsigned char)ee[q];
#pragma unroll
            for (int e = 0; e < 8; ++e) c[e] += (ee[q] == (unsigned)e); } }
#pragma unroll
    for (int e = 0; e < 8; ++e) cnt[t * 8 + e] = c[e];
    for (int s = t; s < MAXSLOT; s += NTHR) rowtok[s] = -1;
    __syncthreads();
    { const int e = F.wave; int loc[8]; int sum = 0;
#pragma unroll
      for (int q = 0; q < 8; ++q) { loc[q] = cnt[(8 * F.lane + q) * 8 + e]; sum += loc[q]; }
      int inc = sum;
#pragma unroll
      for (int o = 1; o < 64; o <<= 1) { const int up = __shfl_up(inc, o); if (F.lane >= o) inc += up; }
      int run = inc - sum;
#pragma unroll
      for (int q = 0; q < 8; ++q) { cnt[(8 * F.lane + q) * 8 + e] = run; run += loc[q]; }
      if (F.lane == 63) ps[9 + e] = inc; }
    __syncthreads();
    if (t == 0) { int p = 0; for (int e = 0; e < 8; ++e) { ps[e] = p; p += (ps[9 + e] + 255) >> 8; } ps[8] = p; }
    __syncthreads();
    if (blockIdx.x == 0 && t < 9) pstart[t] = ps[t];
    { int run[8];
#pragma unroll
      for (int e = 0; e < 8; ++e) run[e] = ps[e] * 256 + cnt[t * 8 + e];
      const bool mine = ((t >> 1) % F.G) == (int)blockIdx.x;
      for (int j = 0; j < 32; ++j) { const int idx = 32 * t + j; const int e = te[idx]; int slot = 0;
#pragma unroll
          for (int q = 0; q < 8; ++q) if (e == q) { slot = run[q]; run[q] = slot + 1; }
          rowtok[slot] = idx >> 1; if (mine) slot_of[idx] = slot; } }
    __syncthreads();
    const int nslot = ps[8] * 256;
    { const int str = F.G * NWAVES;
      for (int s0 = blockIdx.x * NWAVES + F.wave; s0 < nslot; s0 += 4 * str) { v4u rv[4][4]; int tokb[4];
#pragma unroll
        for (int b4 = 0; b4 < 4; ++b4) { const int s = s0 + b4 * str; tokb[b4] = s < nslot ? rowtok[s] : -1; const int tl = tokb[b4] >= 0 ? tokb[b4] : 0;
#pragma unroll
            for (int j = 0; j < 4; ++j) rv[b4][j] = *(const v4u*)(H + (size_t)tl * D + 32 * F.lane + 8 * j); }
#define RT_PK(v) pk4_fp8s(__uint_as_float((v).x << 16), __uint_as_float((v).x & 0xffff0000u), __uint_as_float((v).y << 16), __uint_as_float((v).y & 0xffff0000u), S_H8), pk4_fp8s(__uint_as_float((v).z << 16), __uint_as_float((v).z & 0xffff0000u), __uint_as_float((v).w << 16), __uint_as_float((v).w & 0xffff0000u), S_H8)
#pragma unroll
        for (int b4 = 0; b4 < 4; ++b4) { const int s = s0 + b4 * str;
            if (s < nslot) { v4u o0 = (v4u){RT_PK(rv[b4][0]), RT_PK(rv[b4][1])}, o1 = (v4u){RT_PK(rv[b4][2]), RT_PK(rv[b4][3])};
                if (tokb[b4] < 0) { o0 = (v4u){0u, 0u, 0u, 0u}; o1 = (v4u){0u, 0u, 0u, 0u}; }
                *(GAS v4u*)(HP + (size_t)s * D + 32 * F.lane) = o0; *(GAS v4u*)(HP + (size_t)s * D + 32 * F.lane + 16) = o1; } }
#undef RT_PK
      } }
    __syncthreads();
}

namespace mx {
constexpr int KSTR = 288;
constexpr int TILE_B = 32 * KSTR;
constexpr int OFF_RPB = 6 * TILE_B;
constexpr int OFF_VH = 0;
constexpr float SC_L2 = 0.08838834764831845f * 1.4426950408889634f;
constexpr float L2E = 1.4426950408889634f;
constexpr float NEG = -1e30f;

__device__ __forceinline__ bf16x8 tr_pair(const LAS unsigned char* p, int off0, int off1) {
    const s16x4 a = __builtin_amdgcn_ds_read_tr16_b64_v4i16((LAS s16x4*)(p + off0)); const s16x4 b = __builtin_amdgcn_ds_read_tr16_b64_v4i16((LAS s16x4*)(p + off1));
    return (bf16x8){a[0], a[1], a[2], a[3], b[0], b[1], b[2], b[3]};
}
typedef __bf16 bf16v2 __attribute__((ext_vector_type(2))); typedef float f32v2 __attribute__((ext_vector_type(2)));
__device__ __forceinline__ unsigned cvt_pk(float lo, float hi) { const f32v2 v = {lo, hi}; const bf16v2 b = __builtin_convertvector(v, bf16v2); return __builtin_bit_cast(unsigned, b); }

template <int VAR> __device__ __forceinline__ void attn_unit(Frame& F, const bf16* P, bf16* Y, int u0, int u1, int band, const float* sink, const float* rpb) {
    constexpr int MQ = VAR == 0 ? 3 : 2;
    LAS unsigned char* lds = F.lds;
    int lane_; asm volatile("v_mbcnt_lo_u32_b32 %0, -1, 0\n\tv_mbcnt_hi_u32_b32 %0, -1, %0" : "=v"(lane_));
    const int lane = lane_, w = F.wave, fr = lane & 15, fq = lane >> 4, tid = w * 64 + lane_;
    int qrow[MQ], qcol[MQ], ycol[MQ]; int kcol, vcol;
    int nb = 0, blo = 0;
    int r_w = 0, r0_w = 0, cbase = 0;
    float m[MQ], l[MQ];
    if constexpr (VAR == 0) {
        kcol = C_KB + u1 * 128; vcol = C_VB + u1 * 128;
#pragma unroll
        for (int q = 0; q < MQ; ++q) { const int h = 3 * u1 + q; qrow[q] = u0 + 16 * w + fr; qcol[q] = C_QB + h * 128; ycol[q] = Y_B + h * 128; m[q] = sink[h] * L2E; l[q] = fq == 0 ? 1.f : 0.f; }
        if (band) { const int lo = u0 - 128 < 0 ? 0 : u0 - 128, hi = u0 + 256 > SEQ ? SEQ : u0 + 256; blo = lo; nb = (hi - lo) >> 5; }
    } else {
        kcol = C_KC + u0 * 128; vcol = C_VC + u0 * 128;
        if (band) { r_w = u1 + (w >> 1); cbase = 32 * (w & 1); r0_w = r_w - 4 < 0 ? 0 : (r_w - 4 > 120 ? 120 : r_w - 4);
            const int klo = u1 - 4 < 0 ? 0 : (u1 - 4 > 120 ? 120 : u1 - 4); int khi = u1 + 3 - 4; khi = (khi < 0 ? 0 : (khi > 120 ? 120 : khi)) + 8; blo = klo; nb = 2 * (khi - klo); }
#pragma unroll
        for (int q = 0; q < MQ; ++q) { qrow[q] = band ? 64 * r_w + cbase + 16 * q + fr : SEQ + 32 * w + 16 * q + fr; qcol[q] = C_QC + u0 * 128; ycol[q] = Y_C + u0 * 128; m[q] = NEG; l[q] = 0.f; }
        if (band) { for (int i = tid; i < 15 * 128; i += NTHR) { const int ro = i >> 7, co = (i & 127) - 48; ((LAS float*)(lds + OFF_RPB))[i] = (co >= 0 && co < 31) ? rpb[(u0 * 15 + ro) * 31 + co] * L2E : 0.f; } }
    }
    const int NT = nb + 8;
    bf16x8 qf[MQ][4];
#pragma unroll
    for (int q = 0; q < MQ; ++q)
#pragma unroll
        for (int kk = 0; kk < 4; ++kk) qf[q][kk] = *(const bf16x8*)(P + (size_t)qrow[q] * INW + qcol[q] + 32 * kk + 8 * fq);
    f32x4 o[MQ][8];
#pragma unroll
    for (int q = 0; q < MQ; ++q)
#pragma unroll
        for (int dt = 0; dt < 8; ++dt) o[q][dt] = (f32x4){0.f, 0.f, 0.f, 0.f};
    const int si = tid >> 4, sc16 = tid & 15; const int soff = si * KSTR + sc16 * 16;
#define MX_TILE_ROW(t) (VAR == 0 ? ((t) < nb ? blo + 32 * (t) : SEQ + 32 * ((t) - nb)) : ((t) < 8 ? SEQ + 32 * (t) : 64 * (blo + (((t) - 8) >> 1)) + 32 * (((t) - 8) & 1)))
    constexpr int DEPTH = VAR == 1 ? 2 : 1;
    v4u kA, vA, kB, vB;
    { const int row0 = MX_TILE_ROW(0); kA = *(const v4u*)(P + (size_t)(row0 + si) * INW + kcol + 8 * sc16); vA = *(const v4u*)(P + (size_t)(row0 + si) * INW + vcol + 8 * sc16); }
    if constexpr (DEPTH == 2) { const int row1 = MX_TILE_ROW(1); kB = *(const v4u*)(P + (size_t)(row1 + si) * INW + kcol + 8 * sc16); vB = *(const v4u*)(P + (size_t)(row1 + si) * INW + vcol + 8 * sc16); }
    else { kB = kA; vB = vA; }
    __syncthreads();
    *(LAS v4u*)(lds + soff) = kA; *(LAS v4u*)(lds + TILE_B + soff) = vA;
    __syncthreads();
    const int koff = fr * KSTR + fq * 16;
    const int voff = (4 * fq + (fr >> 2)) * KSTR + (fr & 3) * 8;
    __builtin_amdgcn_s_waitcnt(0);
    for (int t0 = 0; t0 < NT; t0 += DEPTH) {
#pragma unroll
      for (int par = 0; par < DEPTH; ++par) {
        const int t = t0 + par; if (t >= NT) break;
        v4u& kl = par == 0 ? kA : kB; v4u& vl = par == 0 ? vA : vB;
        const v4u& ks_ = (DEPTH == 1 || par == 1) ? kA : kB; const v4u& vs_ = (DEPTH == 1 || par == 1) ? vA : vB;
        const int buf = t % 3, bufn = (t + 1) % 3;
        if (t + DEPTH < NT) { const int row0 = MX_TILE_ROW(t + DEPTH); kl = *(const v4u*)(P + (size_t)(row0 + si) * INW + kcol + 8 * sc16); vl = *(const v4u*)(P + (size_t)(row0 + si) * INW + vcol + 8 * sc16); }
        bool rel = true; int kpos0 = 0, kr = 0, hf = 0;
        const bool is_band = VAR == 0 ? (t < nb) : (t >= 8);
        if constexpr (VAR == 0) { if (is_band) { kpos0 = blo + 32 * t; const int tq0 = u0 + 16 * w; rel = (kpos0 + 31 >= tq0 - 128) && (kpos0 <= tq0 + 15 + 128); } }
        else { if (is_band) { kr = blo + ((t - 8) >> 1); hf = (t - 8) & 1; rel = (kr >= r0_w) && (kr < r0_w + 8); } }
        if (rel) {
            const LAS unsigned char* Kt = lds + buf * 2 * TILE_B; const LAS unsigned char* Vt = Kt + TILE_B;
            float bb[VAR == 1 ? MQ : 1][8]; int c0q[VAR == 1 ? MQ : 1];
            if constexpr (VAR == 1) { if (is_band) {
#pragma unroll
                for (int q = 0; q < MQ; ++q) { const int c = cbase + 16 * q + fr; c0q[q] = c - 8 < 0 ? 0 : (c - 8 > 48 ? 48 : c - 8);
                    const LAS float* bp = (const LAS float*)(lds + OFF_RPB) + (kr - r_w + 7) * 128 + 32 * hf + 4 * fq - c + 63;
#pragma unroll
                    for (int j = 0; j < 8; ++j) bb[q][j] = bp[16 * (j >> 2) + (j & 3)]; } } }
            f32x4 st[MQ][2];
#pragma unroll
            for (int q = 0; q < MQ; ++q) { st[q][0] = (f32x4){0.f, 0.f, 0.f, 0.f}; st[q][1] = (f32x4){0.f, 0.f, 0.f, 0.f}; }
#pragma unroll
            for (int ks = 0; ks < 2; ++ks)
#pragma unroll
                for (int kk = 0; kk < 4; ++kk) { const bf16x8 kf = *(const LAS bf16x8*)(Kt + koff + ks * 16 * KSTR + kk * 64);
#pragma unroll
                    for (int q = 0; q < MQ; ++q) st[q][ks] = __builtin_amdgcn_mfma_f32_16x16x32_bf16(kf, qf[q][kk], st[q][ks], 0, 0, 0); }
            if constexpr (VAR == 1) {
            float s[MQ][8]; float mt[MQ];
#pragma unroll
            for (int q = 0; q < MQ; ++q) {
                if (!is_band) {
#pragma unroll
                    for (int j = 0; j < 8; ++j) s[q][j] = st[q][j >> 2][j & 3] * SC_L2;
                } else if constexpr (VAR == 0) {
                    const int w0 = kpos0 + 4 * fq - qrow[q] + 128;
#pragma unroll
                    for (int j = 0; j < 8; ++j) { const float v = st[q][j >> 2][j & 3] * SC_L2; s[q][j] = ((unsigned)(w0 + 16 * (j >> 2) + (j & 3)) <= 256u) ? v : NEG; }
                } else {
                    const int v0 = 32 * hf + 4 * fq - c0q[q];
#pragma unroll
                    for (int j = 0; j < 8; ++j) { const float v = st[q][j >> 2][j & 3] * SC_L2 + bb[q][j]; s[q][j] = ((unsigned)(v0 + 16 * (j >> 2) + (j & 3)) < 16u) ? v : NEG; }
                }
                float x = fmaxf(fmaxf(fmaxf(s[q][0], s[q][1]), fmaxf(s[q][2], s[q][3])), fmaxf(fmaxf(s[q][4], s[q][5]), fmaxf(s[q][6], s[q][7])));
                x = fmaxf(x, __shfl_xor(x, 16)); x = fmaxf(x, __shfl_xor(x, 32)); mt[q] = x;
            }
            bool grow = false;
#pragma unroll
            for (int q = 0; q < MQ; ++q) grow = grow || (mt[q] > m[q]);
            if (__any(grow)) {
#pragma unroll
                for (int q = 0; q < MQ; ++q) { const float mn = fmaxf(m[q], mt[q]); const float alpha = __builtin_amdgcn_exp2f(m[q] - mn); m[q] = mn; l[q] *= alpha;
#pragma unroll
                    for (int dt = 0; dt < 8; ++dt) o[q][dt] *= alpha; } }
            bf16x8 pb[MQ];
#pragma unroll
            for (int q = 0; q < MQ; ++q) { float ps = 0.f;
#pragma unroll
                for (int j = 0; j < 8; ++j) { s[q][j] = __builtin_amdgcn_exp2f(s[q][j] - m[q]); ps += s[q][j]; }
                l[q] += ps;
                v4u pk; pk.x = cvt_pk(s[q][0], s[q][1]); pk.y = cvt_pk(s[q][2], s[q][3]); pk.z = cvt_pk(s[q][4], s[q][5]); pk.w = cvt_pk(s[q][6], s[q][7]);
                pb[q] = __builtin_bit_cast(bf16x8, pk); }
#pragma unroll
            for (int dt = 0; dt < 8; ++dt) { const bf16x8 vf = tr_pair(Vt + voff, dt * 32, dt * 32 + 16 * KSTR);
#pragma unroll
                for (int q = 0; q < MQ; ++q) o[q][dt] = __builtin_amdgcn_mfma_f32_16x16x32_bf16(vf, pb[q], o[q][dt], 0, 0, 0); }
            } else {
            bf16x8 pb[MQ];
#pragma unroll
            for (int q = 0; q < MQ; ++q) {
                float s[8];
                if (!is_band) {
#pragma unroll
                    for (int j = 0; j < 8; ++j) s[j] = st[q][j >> 2][j & 3] * SC_L2;
                } else if constexpr (VAR == 0) {
                    const int w0 = kpos0 + 4 * fq - qrow[q] + 128;
#pragma unroll
                    for (int j = 0; j < 8; ++j) { const float v = st[q][j >> 2][j & 3] * SC_L2; s[j] = ((unsigned)(w0 + 16 * (j >> 2) + (j & 3)) <= 256u) ? v : NEG; }
                } else {
                    const int c = cbase + 16 * q + fr; const int c0 = c - 8 < 0 ? 0 : (c - 8 > 48 ? 48 : c - 8);
                    const LAS float* bp = (const LAS float*)(lds + OFF_RPB) + (kr - r_w + 7) * 128 + 32 * hf + 4 * fq - c + 63; const int v0 = 32 * hf + 4 * fq - c0;
                    float bb[8];
#pragma unroll
                    for (int j = 0; j < 8; ++j) bb[j] = bp[16 * (j >> 2) + (j & 3)];
#pragma unroll
                    for (int j = 0; j < 8; ++j) { const float v = st[q][j >> 2][j & 3] * SC_L2 + bb[j]; s[j] = ((unsigned)(v0 + 16 * (j >> 2) + (j & 3)) < 16u) ? v : NEG; }
                }
                float mt = fmaxf(fmaxf(fmaxf(s[0], s[1]), fmaxf(s[2], s[3])), fmaxf(fmaxf(s[4], s[5]), fmaxf(s[6], s[7])));
                mt = fmaxf(mt, __shfl_xor(mt, 16)); mt = fmaxf(mt, __shfl_xor(mt, 32));
                if (__any(mt > m[q])) { const float mn = fmaxf(m[q], mt); const float alpha = __builtin_amdgcn_exp2f(m[q] - mn); m[q] = mn; l[q] *= alpha;
#pragma unroll
                    for (int dt = 0; dt < 8; ++dt) o[q][dt] *= alpha; }
                float ps = 0.f;
#pragma unroll
                for (int j = 0; j < 8; ++j) { s[j] = __builtin_amdgcn_exp2f(s[j] - m[q]); ps += s[j]; }
                l[q] += ps;
                v4u pk; pk.x = cvt_pk(s[0], s[1]); pk.y = cvt_pk(s[2], s[3]); pk.z = cvt_pk(s[4], s[5]); pk.w = cvt_pk(s[6], s[7]);
                pb[q] = __builtin_bit_cast(bf16x8, pk);
            }
#pragma unroll
            for (int dt = 0; dt < 8; ++dt) { const bf16x8 vf = tr_pair(Vt + voff, dt * 32, dt * 32 + 16 * KSTR);
#pragma unroll
                for (int q = 0; q < MQ; ++q) o[q][dt] = __builtin_amdgcn_mfma_f32_16x16x32_bf16(vf, pb[q], o[q][dt], 0, 0, 0); }
            }
        }
        if (t + 1 < NT) { *(LAS v4u*)(lds + bufn * 2 * TILE_B + soff) = ks_; *(LAS v4u*)(lds + bufn * 2 * TILE_B + TILE_B + soff) = vs_; }
        __syncthreads();
      }
    }
#undef MX_TILE_ROW
#pragma unroll
    for (int q = 0; q < MQ; ++q) { float lt = l[q]; lt += __shfl_xor(lt, 16); lt += __shfl_xor(lt, 32); const float inv = 1.f / lt;
        bf16* yp = Y + (size_t)qrow[q] * D + ycol[q] + 4 * fq;
#pragma unroll
        for (int dt = 0; dt < 8; ++dt) { v2u w2; w2.x = cvt_pk(o[q][dt][0] * inv, o[q][dt][1] * inv); w2.y = cvt_pk(o[q][dt][2] * inv, o[q][dt][3] * inv); *(GAS v2u*)(yp + 16 * dt) = w2; } }
}

__device__ __forceinline__ void sgu_unit(Frame& F, const bf16* P, bf16* Y, int chunk, int g, const float* lng, const float* Ws, const float* bs) {
    LAS unsigned char* lds = F.lds; const int lane = F.lane, w = F.wave, fr = lane & 15, fq = lane >> 4, tid = F.tid;
    const int row0 = chunk * 128;
    __syncthreads();
    { const int c8 = tid & 15; f32x4 g0 = *(const f32x4*)(lng + g * 128 + 8 * c8), g1 = *(const f32x4*)(lng + g * 128 + 8 * c8 + 4);
#pragma unroll
      for (int p = 0; p < 4; ++p) { const int j = 32 * p + (tid >> 4);
          const v4u raw = *(const v4u*)(P + (size_t)(row0 + j) * INW + 512 + g * 128 + 8 * c8); const unsigned rw[4] = {raw.x, raw.y, raw.z, raw.w};
          float v[8]; float s = 0.f;
#pragma unroll
          for (int q = 0; q < 4; ++q) { v[2 * q] = __uint_as_float(rw[q] << 16); v[2 * q + 1] = __uint_as_float(rw[q] & 0xffff0000u); s += v[2 * q] + v[2 * q + 1]; }
          s += __shfl_xor(s, 1); s += __shfl_xor(s, 2); s += __shfl_xor(s, 4); s += __shfl_xor(s, 8);
          const float mu = s * (1.f / 128.f); float qq = 0.f;
#pragma unroll
          for (int q = 0; q < 8; ++q) { v[q] -= mu; qq += v[q] * v[q]; }
          qq += __shfl_xor(qq, 1); qq += __shfl_xor(qq, 2); qq += __shfl_xor(qq, 4); qq += __shfl_xor(qq, 8);
          const float r = rsqrtf(qq * (1.f / 128.f) + EPS);
          v4u ov; ov.x = pk2(v[0] * r * g0.x, v[1] * r * g0.y); ov.y = pk2(v[2] * r * g0.z, v[3] * r * g0.w); ov.z = pk2(v[4] * r * g1.x, v[5] * r * g1.y); ov.w = pk2(v[6] * r * g1.z, v[7] * r * g1.w);
          *(LAS v4u*)(lds + OFF_VH + j * KSTR + 16 * c8) = ov; } }
    bf16x8 wf[4];
#pragma unroll
    for (int kk = 0; kk < 4; ++kk) { const float* wp = Ws + ((size_t)g * 128 + 16 * w + fr) * 128 + 32 * kk + 8 * fq; const f32x4 a = *(const f32x4*)wp, b = *(const f32x4*)(wp + 4);
        v4u pk; pk.x = pk2(a.x, a.y); pk.y = pk2(a.z, a.w); pk.z = pk2(b.x, b.y); pk.w = pk2(b.z, b.w); wf[kk] = __builtin_bit_cast(bf16x8, pk); }
    __syncthreads();
    const int voff = (8 * fq + (fr >> 2)) * KSTR + (fr & 3) * 8;
    f32x4 acc[8];
#pragma unroll
    for (int ct = 0; ct < 8; ++ct) { acc[ct] = (f32x4){0.f, 0.f, 0.f, 0.f};
#pragma unroll
        for (int kk = 0; kk < 4; ++kk) { const bf16x8 af = tr_pair(lds + OFF_VH + voff, kk * 32 * KSTR + ct * 32, kk * 32 * KSTR + 4 * KSTR + ct * 32);
            acc[ct] = __builtin_amdgcn_mfma_f32_16x16x32_bf16(af, wf[kk], acc[ct], 0, 0, 0); } }
    const int pos = row0 + 16 * w + fr; const float bias = bs[g * 128 + 16 * w + fr];
    v2u uq[8];
#pragma unroll
    for (int ct = 0; ct < 8; ++ct) uq[ct] = *(const v2u*)(P + (size_t)pos * INW + g * 128 + 16 * ct + 4 * fq);
#pragma unroll
    for (int ct = 0; ct < 8; ++ct) { const int col = g * 128 + 16 * ct + 4 * fq; const v2u uu = uq[ct];
        const float u0 = __uint_as_float(uu.x << 16), u1 = __uint_as_float(uu.x & 0xffff0000u), u2 = __uint_as_float(uu.y << 16), u3 = __uint_as_float(uu.y & 0xffff0000u);
        v2u ov; ov.x = cvt_pk(u0 * (acc[ct][0] + bias), u1 * (acc[ct][1] + bias)); ov.y = cvt_pk(u2 * (acc[ct][2] + bias), u3 * (acc[ct][3] + bias));
        *(GAS v2u*)(Y + (size_t)pos * D + col) = ov; }
}
}

template <int L> __device__ __forceinline__ void p_mixers(Frame& F, gu32* qhead) {
    const bf16* P = (const bf16*)(F.ws + WS_P); bf16* Y = (bf16*)(F.ws + WS_Y);
    const float* sink = F.in[14] + L * 6; const float* rpb = F.in[15] + L * 6 * 15 * 31;
    const float* lng = F.in[11] + L * 512; const float* Ws = F.in[12] + (size_t)L * 4 * 128 * 128; const float* bs = F.in[13] + L * 512;
    constexpr int N_NA = 192, N_WA = 128, N_CB = L == 0 ? 4 : 0, N_CC = L == 0 ? 6 : 0, N_SGU = (L == 0 ? 66 : 64) * 4;
    constexpr int NU = N_NA + N_WA + N_CB + N_CC + N_SGU;
    constexpr int CV_BASE = L == 0 ? QB_MX0 : QB_MX1, CV_N = L == 0 ? Q_MX0 : Q_MX1;
    volatile LAS int* tk = (volatile LAS int*)(F.MISC + 16);
    if (F.tid == 0) tk[0] = (int)__hip_atomic_fetch_add(qhead, 1u, RLX_AGENT);
    __syncthreads();
    int cur = tk[0];
    while (cur < NU) {
        unsigned nxt = 0u;
        if (F.tid == 0) nxt = __hip_atomic_fetch_add(qhead, 1u, RLX_AGENT);
        int u = cur;
        if (u < N_NA) { mx::attn_unit<1>(F, P, Y, u / 32, 4 * (u % 32), 1, sink, rpb); }
        else if ((u -= N_NA) < N_WA) { mx::attn_unit<0>(F, P, Y, 128 * (u >> 1), u & 1, 1, sink, rpb); }
        else if ((u -= N_WA) < N_CB) { mx::attn_unit<0>(F, P, Y, SEQ + 128 * (u >> 1), u & 1, 0, sink, rpb); }
        else if ((u -= N_CB) < N_CC) { mx::attn_unit<1>(F, P, Y, u, 0, 0, sink, rpb); }
        else { u -= N_CC; mx::sgu_unit(F, P, Y, u >> 2, u & 3, lng, Ws, bs); }
        __syncthreads();
        if (F.tid == 0) tk[0] = (int)nxt;
        __syncthreads();
        cur = tk[0];
    }
    { gu32* qcv = qhead + 256; LAS float* scr = (LAS float*)(F.lds + 32768 + F.wave * 8704);
      __syncthreads();
      if (F.tid == 0) tk[0] = (int)__hip_atomic_fetch_add(qcv, 1u, RLX_AGENT);
      __syncthreads();
      int cv = tk[0];
      while (cv < CV_N) {
          unsigned nx = 0u;
          if (F.tid == 0) nx = __hip_atomic_fetch_add(qcv, 1u, RLX_AGENT);
          conv_moved(F, scr, (CV_BASE + cv) * NWAVES + F.wave);
          __syncthreads();
          if (F.tid == 0) tk[0] = (int)nx;
          __syncthreads();
          cv = tk[0];
      } }
}

enum { PH_PRO = 0, PH_T0, PH_G1_0, PH_MX_0, PH_G2_0, PH_T2_0, PH_G3_0, PH_G4_0, PH_T3_0, PH_G1_1, PH_MX_1, PH_G2_1, PH_T2_1, PH_RT, PH_G3_1, PH_G4_1, PH_T3_1, NPH };
#ifndef MK_SPLIT
#define MK_SPLIT 0
#endif
struct Args { const float* in[22]; float* out; unsigned char* ws; int ph_lo, ph_hi, li, pad; };
__global__ void __launch_bounds__(NTHR, 2) mk_fwd(Args args) {
    extern __shared__ __attribute__((aligned(16))) unsigned char lds[];
    Frame F;
    F.lds = (LAS unsigned char*)lds; F.MISC = (volatile LAS unsigned*)(F.lds + MISC_OFF);
    F.tid = threadIdx.x; F.lane = F.tid & 63; F.wave = __builtin_amdgcn_readfirstlane(F.tid >> 6);
    F.G = gridDim.x; { const int bx = blockIdx.x; F.vcu = (F.G % 8 == 0) ? (bx % 8) * (F.G / 8) + bx / 8 : bx; }
    F.ws = args.ws; F.out = args.out; F.ctl = (gu32*)(args.ws + WS_CTL);
#pragma unroll
    for (int i = 0; i < 22; ++i) F.in[i] = args.in[i];
    for (int u = F.tid; u < (LDS_BYTES - LDSCTL_OFF) / 4; u += NTHR) ((LAS unsigned*)(F.lds + LDSCTL_OFF))[u] = 0u;
    __syncthreads();
    XcdBarrier bar; bar.bar = (unsigned*)(F.ctl + CW_BAR); bar.x = 0; bar.st = nullptr;
    if (!MK_SPLIT) bar = xcd_barrier_post((unsigned*)(F.ctl + CW_BAR), F.MISC + 8);
    const int lo = args.ph_lo, hi = args.ph_hi;
#define IN(k) (lo <= (k) && (k) < hi)
#define PH_BEGIN() do { int l_; asm volatile("v_mbcnt_lo_u32_b32 %0, -1, 0\n\tv_mbcnt_hi_u32_b32 %0, -1, %0" : "=v"(l_)); F.lane = l_; F.tid = F.wave * 64 + l_; } while (0)
#define SEAM(k) do { if (IN(k) && IN((k) + 1)) xcd_barrier(bar); } while (0)
    float* MOD = (float*)(F.ws + WS_MOD); bf16* H = (bf16*)(F.ws + WS_H); bf16* P = (bf16*)(F.ws + WS_P); bf16* Y = (bf16*)(F.ws + WS_Y); bf16* Y2 = (bf16*)(F.ws + WS_Y2); bf16* XB = (bf16*)(F.ws + WS_XB);
    bf16* PART = (bf16*)(F.ws + WS_PART); bf16* ACT = (bf16*)(F.ws + WS_ACT); unsigned char* HP = F.ws + WS_HP; float* Z = (float*)(F.ws + WS_Z);
    int* tok_e = (int*)(F.ws + WS_TOKE); float* tok_w = (float*)(F.ws + WS_TOKW); int* slot_of = (int*)(F.ws + WS_SLOT); int* pstart = (int*)(F.ws + WS_PSTART);
    const float* cosT = (const float*)(F.ws + WS_ROPE); const float* sinT = cosT + 4096;
    const pg8::bf16_t* Wt_in = (const pg8::bf16_t*)(F.ws + WS_WIN); const pg8::bf16_t* Wt_out = (const pg8::bf16_t*)(F.ws + WS_WOUT);
    PG8_LAS unsigned char* ring = (PG8_LAS unsigned char*)F.lds;

    PH_BEGIN(); if (IN(PH_PRO)) { p_prologue(F); } SEAM(PH_PRO);
    PH_BEGIN(); if (IN(PH_T0)) { p_prenorm0(F); } SEAM(PH_T0);
    PH_BEGIN(); if (IN(PH_G1_0)) { pg8::Gemm g{H, Wt_in, MROWS, INW, D, 0}; pg8::StaticOrder S; S.init(MROWS, INW, D / 64, F.G == 256 ? 200 : F.G, (int)blockIdx.x); pg8::EpiInProjRope E{P, INW, cosT, sinT, SEQ};
        pg8::TableOrder TS; TS.build(S, (volatile PG8_LAS int*)(F.MISC + 64)); pg8::gemm_phase<pg8::EpiInProjRope, pg8::TableOrder, true, true>(ring, g, TS, E); conv_queue(F, F.ctl + CW_QUEUE + 512, QB_G10, Q_G10); } SEAM(PH_G1_0);
    PH_BEGIN(); if (IN(PH_MX_0)) { p_mixers<0>(F, F.ctl + CW_QUEUE); } SEAM(PH_MX_0);
    PH_BEGIN(); if (IN(PH_G2_0)) { pg8::Gemm g{Y, Wt_out, MROWS, D, D, 0}; pg8::DenseSplitOrder S; S.init(D, D / 64, F.G, (int)blockIdx.x, 8); pg8::EpiB16 E{Y2, D, PART, (size_t)CTX * D, SEQ, 1.f};
        pg8::TableOrder TS; TS.build(S, (volatile PG8_LAS int*)(F.MISC + 64)); pg8::gemm_phase<pg8::EpiB16, pg8::TableOrder, true, true>(ring, g, TS, E); } SEAM(PH_G2_0);
    PH_BEGIN(); if (IN(PH_T2_0)) { p_post<true>(F, Y2, F.in[7], 2 * D, MOD, F.in[0], F.in[2], XB, MROWS, F.in[8], MOD, 3 * D, 4 * D, H, nullptr, tok_e, tok_w, PART, 7); } SEAM(PH_T2_0);
    PH_BEGIN(); if (IN(PH_G3_0)) { pg8::Gemm g{H, (const pg8::bf16_t*)(F.ws + WS_WGU), MROWS, 2 * FFN, D, 0}; pg8::StaticOrder S; S.init(MROWS, 2 * FFN, D / 64, F.G == 256 ? 232 : F.G, (int)blockIdx.x); pg8::EpiSwiGLU E{ACT, FFN};
        pg8::TableOrder TS; TS.build(S, (volatile PG8_LAS int*)(F.MISC + 64)); pg8::gemm_phase<pg8::EpiSwiGLU, pg8::TableOrder, true, true>(ring, g, TS, E); conv_queue(F, F.ctl + CW_QUEUE + 576, QB_G30, Q_G30); } SEAM(PH_G3_0);
    PH_BEGIN(); if (IN(PH_G4_0)) { pg8::Gemm g{ACT, (const pg8::bf16_t*)(F.ws + WS_WDN), MROWS, D, FFN, 0}; pg8::DenseSplitOrder S; S.init(D, FFN / 64, F.G, (int)blockIdx.x, 14); pg8::EpiB16 E{Y2, D, PART, (size_t)CTX * D, SEQ, 1.f};
        pg8::TableOrder TS; TS.build(S, (volatile PG8_LAS int*)(F.MISC + 64)); pg8::gemm_phase<pg8::EpiB16, pg8::TableOrder, true, true>(ring, g, TS, E); conv_queue(F, F.ctl + CW_QUEUE + 640, QB_G40, Q_G40); } SEAM(PH_G4_0);
    PH_BEGIN(); if (IN(PH_T3_0)) { p_post<false>(F, Y2, F.in[9], 5 * D, MOD, nullptr, nullptr, XB, MROWS, F.in[6] + D, MOD + 2 * 6 * D, 0 * D, 1 * D, H, nullptr, tok_e, tok_w, PART, 13); } SEAM(PH_T3_0);
    PH_BEGIN(); if (IN(PH_G1_1)) { pg8::Gemm g{H, Wt_in + (size_t)INW * D, MROWS, INW, D, 0}; pg8::InProjLastOrder S; S.init(F.G == 256 ? 200 : F.G, (int)blockIdx.x); pg8::EpiInProjRope E{P, INW, cosT, sinT, SEQ};
        pg8::TableOrder TS; TS.build(S, (volatile PG8_LAS int*)(F.MISC + 64)); pg8::gemm_phase<pg8::EpiInProjRope, pg8::TableOrder, true, true>(ring, g, TS, E); conv_queue(F, F.ctl + CW_QUEUE + 704, QB_G11, Q_G11); } SEAM(PH_G1_1);
    PH_BEGIN(); if (IN(PH_MX_1)) { p_mixers<1>(F, F.ctl + CW_QUEUE + 64); } SEAM(PH_MX_1);
    PH_BEGIN(); if (IN(PH_G2_1)) { pg8::Gemm g{Y, Wt_out + (size_t)D * D, SEQ, D, D, 0}; pg8::StaticOrder S; S.init(SEQ, D, D / 64, F.G, (int)blockIdx.x); pg8::EpiB16 E{Y2, D, PART, 0, 0, 1.f};
        pg8::TableOrder TS; TS.build(S, (volatile PG8_LAS int*)(F.MISC + 64)); pg8::gemm_phase<pg8::EpiB16, pg8::TableOrder, true, true>(ring, g, TS, E); } SEAM(PH_G2_1);
    PH_BEGIN(); if (IN(PH_T2_1)) { p_post<false>(F, Y2, F.in[7] + D, 2 * D, MOD + 2 * 6 * D, nullptr, nullptr, XB, SEQ, F.in[8] + D, MOD + 2 * 6 * D, 3 * D, 4 * D, H, F.in[19], tok_e, tok_w, PART, 0); } SEAM(PH_T2_1);
    PH_BEGIN(); if (IN(PH_RT)) { p_route(F); } SEAM(PH_RT);
    PH_BEGIN(); if (IN(PH_G3_1)) { pg8::Gemm g{HP, F.ws + WS_MGU, MAXSLOT, 2 * FFN, D, (size_t)2 * FFN * D}; pg8::GroupedOrder S; S.init(pstart, (volatile PG8_LAS int*)(F.MISC + 32), 2 * FFN, D / 128, F.G, (int)blockIdx.x);
        pg8::EpiSwiGLU8 E{(unsigned char*)ACT, FFN, 1.f / (S_H8 * S_WGU8), S_ACT8};
        pg8::TableOrder TS; TS.build(S, (volatile PG8_LAS int*)(F.MISC + 64)); pg8::gemm_phase<pg8::EpiSwiGLU8, pg8::TableOrder, true, true, 1>(ring, g, TS, E); } SEAM(PH_G3_1);
    PH_BEGIN(); if (IN(PH_G4_1)) { pg8::Gemm g{ACT, F.ws + WS_MDN, MAXSLOT, D, FFN, (size_t)D * FFN}; pg8::GroupedSplitOrder S; S.init(pstart, (volatile PG8_LAS int*)(F.MISC + 32), D, FFN / 128, F.G, (int)blockIdx.x);
        pg8::EpiB16 E{Y2, D, PART, (size_t)S.r * 256 * D, S.Pf * 256, 1.f / (S_ACT8 * S_WDN8)};
        pg8::TableOrder TS; TS.build(S, (volatile PG8_LAS int*)(F.MISC + 64)); pg8::gemm_phase<pg8::EpiB16, pg8::TableOrder, true, true, 1>(ring, g, TS, E); } SEAM(PH_G4_1);
    PH_BEGIN(); if (IN(PH_T3_1)) { p_combine(F, Y2, slot_of, tok_w, F.in[9] + D, MOD + 2 * 6 * D + 5 * D, XB, F.out, PART, pstart); }
#undef IN
#undef SEAM
}

extern "C" void kernel_launch(void* const* d_in, const int* in_sizes, int n_in, void* d_out, int out_size, void* d_ws, size_t ws_size, hipStream_t stream) {
    static int grid = 0;
    if (grid == 0) {
        if (n_in != 22 || out_size != SEQ * D || ws_size < WS_END) { fprintf(stderr, "kernel_launch: unexpected arguments (n_in %d, out %d, ws %zu < %zu); nothing launched\n", n_in, out_size, ws_size, (size_t)WS_END); grid = -1; return; }
        int dev = 0, cus = 0, per_cu = 0;
        if (hipGetDevice(&dev) != hipSuccess || hipDeviceGetAttribute(&cus, hipDeviceAttributeMultiprocessorCount, dev) != hipSuccess) { grid = -1; return; }
        if (hipFuncSetAttribute((const void*)mk_fwd, hipFuncAttributeMaxDynamicSharedMemorySize, LDS_BYTES) != hipSuccess) { fprintf(stderr, "kernel_launch: hipFuncSetAttribute failed\n"); grid = -1; return; }
        if (hipOccupancyMaxActiveBlocksPerMultiprocessor(&per_cu, (const void*)mk_fwd, NTHR, LDS_BYTES) != hipSuccess || per_cu < 1) { fprintf(stderr, "kernel_launch: occupancy query says %d blocks per CU\n", per_cu); }
        (void)hipGetLastError();
        grid = cus;
    }
    if (grid < 0) return;
    (void)hipMemsetAsync((char*)d_ws + WS_CTL, 0, CTL_ZERO_BYTES, stream);
    Args a{};
    for (int i = 0; i < 22; ++i) a.in[i] = (const float*)d_in[i];
    a.out = (float*)d_out; a.ws = (unsigned char*)d_ws; a.li = 0; a.pad = 0;
#if MK_SPLIT
    for (int p = 0; p < NPH; ++p) { a.ph_lo = p; a.ph_hi = p + 1; hipLaunchKernelGGL(mk_fwd, dim3(grid), dim3(NTHR), LDS_BYTES, stream, a); }
#else
    a.ph_lo = 0; a.ph_hi = NPH; hipLaunchKernelGGL(mk_fwd, dim3(grid), dim3(NTHR), LDS_BYTES, stream, a);
#endif
}
```

```cpp
#include <hip/hip_runtime.h>
#include <cstdio>
#include <cstdint>
namespace pg8 {
#define PG8_LAS __attribute__((address_space(3)))
typedef unsigned short bf16_t;
typedef short bf16x8 __attribute__((ext_vector_type(8)));
typedef float f32x4 __attribute__((ext_vector_type(4)));
typedef unsigned u32x4 __attribute__((ext_vector_type(4)));
typedef int i32x4 __attribute__((ext_vector_type(4)));
typedef int i32x8 __attribute__((ext_vector_type(8)));
__device__ __forceinline__ bf16x8 as_bf16x8(i32x4 v) { return __builtin_bit_cast(bf16x8, v); }
constexpr int BM = 256, BK = 64, HALF = 128, HTB = HALF * BK * 2  , STAGE_BYTES = 8 * HTB, NXCD = 8, WGM = 4;

__host__ __device__ __forceinline__ int lds_byte(int r, int c) { const int st = (r >> 4) * 2 + (c >> 5), rr = r & 15, cc = c & 31, ob = rr * 64 + cc * 2; return st * 1024 + (ob ^ (((ob >> 9) & 1) << 5)); }
__host__ __device__ __forceinline__ void stage_rc(int b, int& R, int& C) { const int st = b / 1024, sb = b % 1024, swz = sb ^ (((sb >> 9) & 1) << 5); R = (st >> 1) * 16 + swz / 64; C = (st & 1) * 32 + (swz % 64) / 2; }
__host__ __device__ __forceinline__ int perm32(int rho) { const int n = rho >> 4, i = rho & 15; return 8 * (i >> 2) + 4 * n + (i & 3); }

__host__ __device__ __forceinline__ int sigma128(int s) { const int wc = s >> 5, n = (s >> 4) & 1, q4 = s & 15; return 64 * (wc >> 1) + 32 * n + 16 * (wc & 1) + q4; }

struct Unit { int pm, pn, eks, nt; __device__ __host__ __forceinline__ int e() const { return eks & 0xff; } __device__ __host__ __forceinline__ int ks() const { return eks >> 8; } };
struct Gemm { const void* A; const void* Bt; int M, N, K; size_t estride; };

struct StaticOrder {
    int nM, nN, nwg, G, c, ntK;
    __host__ __device__ __forceinline__ void init(int M, int N, int ntK_, int G_, int c_) { nM = M / BM; nN = N / BM; nwg = nM * nN; G = G_; c = c_; ntK = ntK_; }
    __host__ __device__ __forceinline__ bool next(int i, Unit& u) const {
        const long L = (long)i * G + c; if (L >= nwg || c >= G) return false;
        int wgid = (int)L; { const int q = nwg / NXCD, r = nwg % NXCD, xcd = wgid % NXCD, off = wgid / NXCD; wgid = (xcd < r ? xcd * (q + 1) : r * (q + 1) + (xcd - r) * q) + off; }
        const int nig = WGM * nN, gid = wgid / nig, fm = gid * WGM, gsz = (nM - fm) < WGM ? (nM - fm) : WGM;
        u.pm = fm + ((wgid % nig) % gsz); u.pn = (wgid % nig) / gsz; u.eks = 0; u.nt = ntK; return true;
    }
    __device__ __forceinline__ void a_ready(const Unit&) const {}
    __device__ __forceinline__ void done(const Unit&) const {}
};

struct GroupedOrder {
    int nN, nwg, G, c, ntK; const volatile PG8_LAS int* ps;
    __device__ __forceinline__ void init(const int* pstart, volatile PG8_LAS int* tab, int N, int ntK_, int G_, int c_, int plim = 1 << 30) { nN = N / BM; G = G_; c = c_; ntK = ntK_;
        if (threadIdx.x < 9) { const int p = pstart[threadIdx.x]; tab[threadIdx.x] = p < plim ? p : plim; }
        __syncthreads(); ps = tab; nwg = __builtin_amdgcn_readfirstlane(tab[8]) * nN; }
    __device__ __forceinline__ bool next(int i, Unit& u) const {
        const long L = (long)i * G + c; if (L >= nwg) return false;
        int wgid = (int)L; { const int q = nwg / NXCD, r = nwg % NXCD, xcd = wgid % NXCD, off = wgid / NXCD; wgid = (xcd < r ? xcd * (q + 1) : r * (q + 1) + (xcd - r) * q) + off; }
        int e = 0, s0 = 0, np = 1;
#pragma unroll
        for (int k = 0; k < 8; ++k) { const int a = __builtin_amdgcn_readfirstlane(ps[k]), b = __builtin_amdgcn_readfirstlane(ps[k + 1]); if (wgid >= a * nN && wgid < b * nN) { e = k; s0 = a; np = b - a; } }
        const int r = wgid - s0 * nN;
        const int nig = WGM * nN, gid = r / nig, fm = gid * WGM, gsz = (np - fm) < WGM ? (np - fm) : WGM;
        u.pm = s0 + fm + ((r % nig) % gsz); u.pn = (r % nig) / gsz; u.eks = e; u.nt = ntK; return true;
    }
    __device__ __forceinline__ void a_ready(const Unit&) const {}
    __device__ __forceinline__ void done(const Unit&) const {}
};

struct TableOrder {
    const volatile PG8_LAS int* tab;
    template <class Sched> __device__ __forceinline__ void build(const Sched& S, volatile PG8_LAS int* t) {
        if (threadIdx.x < 32) { Unit u; u.pm = 0; u.pn = 0; u.eks = 0; u.nt = 0; const bool ok = S.next((int)threadIdx.x, u);
            t[4 * threadIdx.x + 0] = ok ? u.pm : -1; t[4 * threadIdx.x + 1] = u.pn; t[4 * threadIdx.x + 2] = u.eks; t[4 * threadIdx.x + 3] = u.nt; }
        __syncthreads(); tab = t; }
    __device__ __forceinline__ bool next(int i, Unit& u) const {
        if (i >= 32) return false;
        const i32x4 e = *(const PG8_LAS i32x4*)(tab + 4 * i);
        const int pm = __builtin_amdgcn_readfirstlane(e.x);
        u.pm = pm; u.pn = __builtin_amdgcn_readfirstlane(e.y); u.eks = __builtin_amdgcn_readfirstlane(e.z); u.nt = __builtin_amdgcn_readfirstlane(e.w);
        return pm >= 0; }
    __device__ __forceinline__ void a_ready(const Unit&) const {}
    __device__ __forceinline__ void done(const Unit&) const {}
};

typedef __bf16 bf16v2_t __attribute__((ext_vector_type(2))); typedef float f32v2_t __attribute__((ext_vector_type(2)));
__device__ __forceinline__ unsigned cvt_pk_bf16(float lo, float hi) { const f32v2_t v = {lo, hi}; const bf16v2_t b = __builtin_convertvector(v, bf16v2_t); return __builtin_bit_cast(unsigned, b); }
__device__ __forceinline__ float gelu_tanh(float x) { const float t = x + 0.044715f * x * x * x; const float e = __builtin_amdgcn_exp2f(-2.3022082f * t); return x * __builtin_amdgcn_rcpf(1.0f + e); }
__device__ __forceinline__ float silu_f(float x) { const float e = __builtin_amdgcn_exp2f(-1.44269504f * x); return x * __builtin_amdgcn_rcpf(1.0f + e); }

struct EpiF32 {
    static constexpr int PERM = 0; static constexpr bool AFTER_DRAIN = false;
    float* C; int ldc; float* Cpart; size_t part_stride; int part_row0; float oscale;
    __device__ __forceinline__ void operator()(const f32x4 (&acc)[2][2][4][2], const Unit& u, int wr, int wc, int fr, int fq) const {
        const int row0 = u.pm * BM + wr * 64 + fr, col0 = u.pn * BM + wc * 32 + 4 * fq;
        const int ks = u.ks(); float* base = ks == 0 ? C + (size_t)row0 * ldc : Cpart + (size_t)(ks - 1) * part_stride + (size_t)(row0 - part_row0) * ldc;
#pragma unroll
        for (int ai = 0; ai < 2; ++ai)
#pragma unroll
            for (int m = 0; m < 4; ++m) { float* rowp = base + (size_t)(ai * HALF + m * 16) * ldc + col0;
#pragma unroll
                for (int bj = 0; bj < 2; ++bj)
#pragma unroll
                    for (int n = 0; n < 2; ++n) *(f32x4*)(rowp + bj * HALF + n * 16) = acc[ai][bj][m][n] * oscale; }
    }
};
struct EpiB16 {
    static constexpr int PERM = 1; static constexpr bool AFTER_DRAIN = false;
    bf16_t* C; int ldc; bf16_t* Cpart; size_t part_stride; int part_row0; float oscale;
    __device__ __forceinline__ void operator()(const f32x4 (&acc)[2][2][4][2], const Unit& u, int wr, int wc, int fr, int fq) const {
        const int row0 = u.pm * BM + wr * 64 + fr, col0 = u.pn * BM + wc * 32 + 8 * fq;
        const int ks = u.ks(); bf16_t* base = ks == 0 ? C + (size_t)row0 * ldc : Cpart + (size_t)(ks - 1) * part_stride + (size_t)(row0 - part_row0) * ldc;
#pragma unroll
        for (int ai = 0; ai < 2; ++ai)
#pragma unroll
            for (int m = 0; m < 4; ++m) { bf16_t* rowp = base + (size_t)(ai * HALF + m * 16) * ldc + col0;
#pragma unroll
                for (int bj = 0; bj < 2; ++bj) { const f32x4 v0 = acc[ai][bj][m][0] * oscale, v1 = acc[ai][bj][m][1] * oscale;
                    u32x4 w; w.x = cvt_pk_bf16(v0[0], v0[1]); w.y = cvt_pk_bf16(v0[2], v0[3]); w.z = cvt_pk_bf16(v1[0], v1[1]); w.w = cvt_pk_bf16(v1[2], v1[3]);
                    *(u32x4*)(rowp + bj * HALF) = w; } }
    }
};
struct EpiInProj {
    static constexpr int PERM = 1; static constexpr bool AFTER_DRAIN = false;
    bf16_t* O; int ldc; int gelu_tiles;
    __device__ __forceinline__ void operator()(const f32x4 (&acc)[2][2][4][2], const Unit& u, int wr, int wc, int fr, int fq) const {
        const int row0 = u.pm * BM + wr * 64 + fr, col0 = u.pn * BM + wc * 32 + 8 * fq; const bool act = u.pn < gelu_tiles;
#pragma unroll
        for (int ai = 0; ai < 2; ++ai)
#pragma unroll
            for (int m = 0; m < 4; ++m) { bf16_t* rowp = O + (size_t)(row0 + ai * HALF + m * 16) * ldc + col0;
#pragma unroll
                for (int bj = 0; bj < 2; ++bj) { f32x4 v0 = acc[ai][bj][m][0], v1 = acc[ai][bj][m][1];
                    if (act) {
#pragma unroll
                        for (int j = 0; j < 4; ++j) { v0[j] = gelu_tanh(v0[j]); v1[j] = gelu_tanh(v1[j]); } }
                    u32x4 w; w.x = cvt_pk_bf16(v0[0], v0[1]); w.y = cvt_pk_bf16(v0[2], v0[3]); w.z = cvt_pk_bf16(v1[0], v1[1]); w.w = cvt_pk_bf16(v1[2], v1[3]);
                    *(u32x4*)(rowp + bj * HALF) = w; } }
    }
};
struct EpiSwiGLU {
    static constexpr int PERM = 1; static constexpr bool AFTER_DRAIN = false;
    bf16_t* O; int ldc;
    __device__ __forceinline__ void operator()(const f32x4 (&acc)[2][2][4][2], const Unit& u, int wr, int wc, int fr, int fq) const {
        const int row0 = u.pm * BM + wr * 64 + fr, col0 = u.pn * HALF + wc * 32 + 8 * fq;
#pragma unroll
        for (int ai = 0; ai < 2; ++ai)
#pragma unroll
            for (int m = 0; m < 4; ++m) { bf16_t* rowp = O + (size_t)(row0 + ai * HALF + m * 16) * ldc + col0;
                f32x4 v0, v1;
#pragma unroll
                for (int j = 0; j < 4; ++j) { v0[j] = silu_f(acc[ai][0][m][0][j]) * acc[ai][1][m][0][j]; v1[j] = silu_f(acc[ai][0][m][1][j]) * acc[ai][1][m][1][j]; }
                u32x4 w; w.x = cvt_pk_bf16(v0[0], v0[1]); w.y = cvt_pk_bf16(v0[2], v0[3]); w.z = cvt_pk_bf16(v1[0], v1[1]); w.w = cvt_pk_bf16(v1[2], v1[3]);
                *(u32x4*)rowp = w; }
    }
};

__device__ __forceinline__ float clamp448(float x) { return __builtin_fminf(__builtin_fmaxf(x, -448.f), 448.f); }
__device__ __forceinline__ unsigned pk4_fp8(float a, float b, float c, float d) { int w = 0; w = __builtin_amdgcn_cvt_pk_fp8_f32(clamp448(a), clamp448(b), w, false); w = __builtin_amdgcn_cvt_pk_fp8_f32(clamp448(c), clamp448(d), w, true); return (unsigned)w; }
struct EpiSwiGLU8 {
    static constexpr int PERM = 1; static constexpr bool AFTER_DRAIN = false;
    unsigned char* O; int ldc; float iscale, oscale;
    __device__ __forceinline__ void operator()(const f32x4 (&acc)[2][2][4][2], const Unit& u, int wr, int wc, int fr, int fq) const {
        typedef unsigned u32x2 __attribute__((ext_vector_type(2)));
        const int row0 = u.pm * BM + wr * 64 + fr, col0 = u.pn * HALF + wc * 32 + 8 * fq;
#pragma unroll
        for (int ai = 0; ai < 2; ++ai)
#pragma unroll
            for (int m = 0; m < 4; ++m) { unsigned char* rowp = O + (size_t)(row0 + ai * HALF + m * 16) * ldc + col0;
                f32x4 v0, v1;
#pragma unroll
                for (int j = 0; j < 4; ++j) { v0[j] = silu_f(acc[ai][0][m][0][j] * iscale) * (acc[ai][1][m][0][j] * iscale) * oscale; v1[j] = silu_f(acc[ai][0][m][1][j] * iscale) * (acc[ai][1][m][1][j] * iscale) * oscale; }
                u32x2 w; w.x = pk4_fp8(v0[0], v0[1], v0[2], v0[3]); w.y = pk4_fp8(v1[0], v1[1], v1[2], v1[3]);
                *(u32x2*)rowp = w; }
    }
};
struct EpiInProjRope {
    static constexpr int PERM = 2; static constexpr bool AFTER_DRAIN = false;
    bf16_t* O; int ldc; const float* cosT; const float* sinT; int nlat;
    __device__ __forceinline__ void operator()(const f32x4 (&acc)[2][2][4][2], const Unit& u, int wr, int wc, int fr, int fq) const {
        typedef unsigned u32x2 __attribute__((ext_vector_type(2)));
        const int row0 = u.pm * BM + wr * 64 + fr, col0 = u.pn * BM + 64 * (wc >> 1) + 16 * (wc & 1) + 4 * fq;
        const bool act = u.pn < 4; const bool rope = (u.pn == 4 || u.pn == 5 || u.pn == 6 || u.pn == 10) && (u.pm * BM < nlat);
        const int fi = 16 * (wc & 1) + 4 * fq;
        f32x4 csa[8], sna[8];
#pragma unroll
        for (int q = 0; q < 8; ++q) { csa[q] = (f32x4){1.f, 1.f, 1.f, 1.f}; sna[q] = (f32x4){0.f, 0.f, 0.f, 0.f}; }
        if (rope) {
#pragma unroll
            for (int q = 0; q < 8; ++q) { const int row = row0 + (q >> 2) * HALF + (q & 3) * 16; const int pos = (wc >> 1) ? (row & 63) : (row >> 6); csa[q] = *(const f32x4*)(cosT + pos * 32 + fi); sna[q] = *(const f32x4*)(sinT + pos * 32 + fi); } }
#pragma unroll
        for (int ai = 0; ai < 2; ++ai)
#pragma unroll
            for (int m = 0; m < 4; ++m) { const int row = row0 + ai * HALF + m * 16; bf16_t* rowp = O + (size_t)row * ldc + col0;
                const f32x4 cs = csa[ai * 4 + m], sn = sna[ai * 4 + m];
#pragma unroll
                for (int bj = 0; bj < 2; ++bj) { f32x4 v0 = acc[ai][bj][m][0], v1 = acc[ai][bj][m][1];
                    if (act) {
#pragma unroll
                        for (int j = 0; j < 4; ++j) { v0[j] = gelu_tanh(v0[j]); v1[j] = gelu_tanh(v1[j]); } }
                    const f32x4 o0 = v0 * cs - v1 * sn, o1 = v0 * sn + v1 * cs;
                    u32x2 w0, w1; w0.x = cvt_pk_bf16(o0[0], o0[1]); w0.y = cvt_pk_bf16(o0[2], o0[3]); w1.x = cvt_pk_bf16(o1[0], o1[1]); w1.y = cvt_pk_bf16(o1[2], o1[3]);
                    *(u32x2*)(rowp + bj * HALF) = w0; *(u32x2*)(rowp + bj * HALF + 32) = w1; } }
    }
};
__device__ __forceinline__ int pick_split(int r, int nN, int ntK, int G) {
    int s = 1;
#define PG8_TRY(q) if (ntK % (q) == 0 && ((ntK / (q)) & 1) == 0 && ntK / (q) >= 4 && r * nN * (q) <= G) s = (q)
    PG8_TRY(2); PG8_TRY(4); PG8_TRY(7); PG8_TRY(8); PG8_TRY(14); PG8_TRY(28);
#undef PG8_TRY
    return s;
}
struct DenseSplitOrder {
    StaticOrder so; int nNc, sk, ntsub;
    __device__ __forceinline__ void init(int N, int ntK_, int G_, int c_, int sk_) { so.init(8192, N, ntK_, G_, c_); nNc = N / BM; sk = sk_; ntsub = ntK_ / sk_; }
    __device__ __forceinline__ bool next(int i, Unit& u) const {
        long L = (long)i * so.G + so.c; Unit t; t.pm = 0; t.pn = 0; t.eks = 0; t.nt = 0; bool ok;
        if (L < so.nwg) ok = so.next(i, t);
        else { L -= so.nwg; ok = L < nNc * sk; t.pm = 32; t.pn = (int)(L % nNc); t.eks = (int)(L / nNc) << 8; t.nt = ntsub; }
        u.pm = t.pm; u.pn = t.pn; u.eks = t.eks; u.nt = t.nt; return ok;
    }
    __device__ __forceinline__ void a_ready(const Unit&) const {}
    __device__ __forceinline__ void done(const Unit&) const {}
};
struct GroupedSplitOrder {
    GroupedOrder go; const volatile PG8_LAS int* ps; int Pf, r, sk, ntsub;
    __device__ __forceinline__ void init(const int* pstart, volatile PG8_LAS int* tab  , int N, int ntK_, int G_, int c_) {
        if (threadIdx.x < 9) tab[9 + threadIdx.x] = pstart[threadIdx.x];
        const int P = __builtin_amdgcn_readfirstlane(pstart[8]);
        const int nN = N / BM, ppr = G_ / nN; Pf = (P / ppr) * ppr; r = P - Pf; sk = pick_split(r, nN, ntK_, G_); ntsub = ntK_ / sk;
        go.init(pstart, tab, N, ntK_, G_, c_, Pf); ps = tab + 9;
    }
    __device__ __forceinline__ bool next(int i, Unit& u) const {
        long L = (long)i * go.G + go.c; Unit t; t.pm = 0; t.pn = 0; t.eks = 0; t.nt = 0; bool ok;
        if (L < go.nwg) ok = go.next(i, t);
        else { L -= go.nwg; const int per = go.nN * sk; ok = L < (long)r * per;
            const int pl = (int)(L / per), rem = (int)(L % per); t.pm = Pf + pl; t.pn = rem % go.nN; const int ks = rem / go.nN; t.nt = ntsub;
            int e = 0;
#pragma unroll
            for (int k = 0; k < 8; ++k) { const int a = __builtin_amdgcn_readfirstlane(ps[k]), b = __builtin_amdgcn_readfirstlane(ps[k + 1]); if (t.pm >= a && t.pm < b) e = k; }
            t.eks = e | (ks << 8); }
        u.pm = t.pm; u.pn = t.pn; u.eks = t.eks; u.nt = t.nt; return ok;
    }
    __device__ __forceinline__ void a_ready(const Unit&) const {}
    __device__ __forceinline__ void done(const Unit&) const {}
};
struct InProjLastOrder {
    StaticOrder so;
    __device__ __forceinline__ void init(int G_, int c_) { so.init(8192, 4608, 32, G_, c_); }
    __device__ __forceinline__ bool next(int i, Unit& u) const {
        const long L = (long)i * so.G + so.c; Unit t; t.pm = 0; t.pn = 0; t.eks = 0; t.nt = 0; bool ok;
        if (L < so.nwg) ok = so.next(i, t);
        else { ok = L < so.nwg + 8 && so.c < so.G; t.pm = 32; t.pn = 10 + (int)(L - so.nwg); t.eks = 0; t.nt = so.ntK; }
        u.pm = t.pm; u.pn = t.pn; u.eks = t.eks; u.nt = t.nt; return ok;
    }
    __device__ __forceinline__ void a_ready(const Unit&) const {}
    __device__ __forceinline__ void done(const Unit&) const {}
};

template <class Epi, class Sched, bool ALIGN_EPI = false, bool SP2 = false, int ES = 2>
__device__ __forceinline__ void gemm_phase(PG8_LAS unsigned char* lds, const Gemm g, const Sched& S, const Epi& E) {
    const int tid = threadIdx.x, wid = __builtin_amdgcn_readfirstlane(tid >> 6), lane = tid & 63, wr = wid >> 2, wc = wid & 3, fr = lane & 15, fq = lane >> 4;
    const int K = g.K;
    unsigned voffA[2], voffB[2];
#pragma unroll
    for (int i = 0; i < 2; ++i) { int R, C; stage_rc(tid * 16 + i * 8192, R, C); const int Rb = Epi::PERM == 1 ? ((R & ~31) + perm32(R & 31)) : (Epi::PERM == 2 ? sigma128(R) : R);
        voffA[i] = (unsigned)(R * K * ES + C * 2); voffB[i] = (unsigned)(Rb * K * ES + C * 2); }
    const size_t kstep = (size_t)(BK * 2);
    const size_t hstep = (size_t)HALF * K * ES;
    const size_t tstep = 2 * hstep;
    const unsigned ldsw = (unsigned)wid * 1024u;
    const int aoff = lds_byte(wr * 64 + fr, fq * 8), boff = lds_byte(wc * 32 + fr, fq * 8);
#define PG8_SA(b, h) (((b) * 2 + (h)) * HTB)
#define PG8_SB(b, h) ((4 + (b) * 2 + (h)) * HTB)
#define PG8_STAGE(bufoff, gbase, voff) do { _Pragma("unroll") for (int _i = 0; _i < 2; ++_i) \
        __builtin_amdgcn_global_load_lds((const unsigned*)((const char*)(gbase) + (voff)[_i]), (PG8_LAS unsigned*)(lds + (bufoff) + ldsw + _i * 8192), 16, 0, 0); } while (0)
#define PG8_LDA(dst, b, h) do { _Pragma("unroll") for (int m = 0; m < 4; ++m) { dst[m].lo = *(const PG8_LAS i32x4*)(lds + PG8_SA(b, h) + aoff + m * 2048); dst[m].hi = *(const PG8_LAS i32x4*)(lds + PG8_SA(b, h) + aoff + m * 2048 + 1024); } } while (0)
#define PG8_LDB(dst, b, h) do { _Pragma("unroll") for (int n = 0; n < 2; ++n) { dst[n].lo = *(const PG8_LAS i32x4*)(lds + PG8_SB(b, h) + boff + n * 2048); dst[n].hi = *(const PG8_LAS i32x4*)(lds + PG8_SB(b, h) + boff + n * 2048 + 1024); } } while (0)
#define PG8_MMA(ai, bj, At, Bt) do { __builtin_amdgcn_s_setprio(1); _Pragma("unroll") for (int m = 0; m < 4; ++m) _Pragma("unroll") for (int n = 0; n < 2; ++n) { \
        if constexpr (ES == 2) { acc[ai][bj][m][n] = __builtin_amdgcn_mfma_f32_16x16x32_bf16(as_bf16x8(Bt[n].lo), as_bf16x8(At[m].lo), acc[ai][bj][m][n], 0, 0, 0); \
                                 acc[ai][bj][m][n] = __builtin_amdgcn_mfma_f32_16x16x32_bf16(as_bf16x8(Bt[n].hi), as_bf16x8(At[m].hi), acc[ai][bj][m][n], 0, 0, 0); } \
        else { asm volatile("v_mfma_f32_16x16x128_f8f6f4 %0, %1, %2, %0" : "+v"(acc[ai][bj][m][n]) : "v"(Bt[n]), "v"(At[m])); } } \
        __builtin_amdgcn_s_setprio(0); } while (0)
#define PG8_WAIT_V(n) asm volatile("s_waitcnt vmcnt(" #n ")" ::: "memory")
#define PG8_WAIT_L(n) asm volatile("s_waitcnt lgkmcnt(" #n ")" ::: "memory")
#define PG8_BAR __builtin_amdgcn_s_barrier()
#define PG8_SCHED __builtin_amdgcn_sched_barrier(0)
    Unit cur, nxt; int ui = 0;
    if (!S.next(0, cur)) return;
    f32x4 acc[2][2][4][2];
#pragma unroll
    for (int a = 0; a < 2; ++a)
#pragma unroll
        for (int b = 0; b < 2; ++b)
#pragma unroll
            for (int m = 0; m < 4; ++m)
#pragma unroll
                for (int n = 0; n < 2; ++n) acc[a][b][m][n] = (f32x4){0.f, 0.f, 0.f, 0.f};
    i32x8 At[4], B0[2], B1[2];
    const char* cA = (const char*)g.A + (size_t)cur.pm * tstep + (size_t)(cur.ks() * cur.nt) * kstep; const char* cB = (const char*)g.Bt + (size_t)cur.e() * g.estride * ES + (size_t)cur.pn * tstep + (size_t)(cur.ks() * cur.nt) * kstep;
    S.a_ready(cur);
    if constexpr (SP2) {
        PG8_STAGE(PG8_SB(0, 0), cB, voffB); PG8_STAGE(PG8_SB(0, 1), cB + hstep, voffB); PG8_STAGE(PG8_SA(0, 0), cA, voffA); PG8_STAGE(PG8_SA(0, 1), cA + hstep, voffA);
        if (wr == 1) PG8_BAR;
        PG8_WAIT_V(2); PG8_BAR;
        PG8_STAGE(PG8_SB(1, 0), cB + kstep, voffB); PG8_STAGE(PG8_SA(1, 0), cA + kstep, voffA); PG8_STAGE(PG8_SB(1, 1), cB + hstep + kstep, voffB);
        PG8_WAIT_V(6); PG8_BAR;
    } else {
        PG8_STAGE(PG8_SB(0, 0), cB, voffB); PG8_STAGE(PG8_SA(0, 0), cA, voffA); PG8_STAGE(PG8_SB(0, 1), cB + hstep, voffB); PG8_STAGE(PG8_SA(0, 1), cA + hstep, voffA);
        if (wr == 1) PG8_BAR;
        PG8_WAIT_V(4); PG8_BAR;
        PG8_STAGE(PG8_SB(1, 0), cB + kstep, voffB); PG8_STAGE(PG8_SA(1, 0), cA + kstep, voffA); PG8_STAGE(PG8_SB(1, 1), cB + hstep + kstep, voffB);
        PG8_WAIT_V(6); PG8_BAR;
    }
    for (;;) {
        const bool has_next = S.next(ui + 1, nxt);
        const char* nA = has_next ? (const char*)g.A + (size_t)nxt.pm * tstep + (size_t)(nxt.ks() * nxt.nt) * kstep : cA; const char* nB = has_next ? (const char*)g.Bt + (size_t)nxt.e() * g.estride * ES + (size_t)nxt.pn * tstep + (size_t)(nxt.ks() * nxt.nt) * kstep : cB;
        const int nt = cur.nt;
        for (int t = 0; t < nt; t += 2) {
            const bool last = (t == nt - 2);
            const char* a1 = cA + (size_t)(t + 1) * kstep;
            const char* a2 = last ? nA : cA + (size_t)(t + 2) * kstep; const char* b2 = last ? nB : cB + (size_t)(t + 2) * kstep;
            const char* a3 = a2 + kstep; const char* b3 = b2 + kstep;
            if (last && has_next) S.a_ready(nxt);
            if constexpr (SP2) {
            PG8_LDB(B0, 0, 0); PG8_LDB(B1, 0, 1); PG8_SCHED; PG8_LDA(At, 0, 0); PG8_STAGE(PG8_SA(1, 1), a1 + hstep, voffA);
            PG8_WAIT_V(8); PG8_WAIT_L(0); PG8_BAR; PG8_MMA(0, 0, At, B0); PG8_MMA(0, 1, At, B1); PG8_BAR; PG8_SCHED;
            PG8_LDA(At, 0, 1); PG8_STAGE(PG8_SB(0, 0), b2, voffB); PG8_STAGE(PG8_SB(0, 1), b2 + hstep, voffB); PG8_STAGE(PG8_SA(0, 0), a2, voffA);
            PG8_WAIT_V(8); PG8_WAIT_L(0); PG8_BAR; PG8_MMA(1, 0, At, B0); PG8_MMA(1, 1, At, B1); PG8_BAR; PG8_SCHED;
            PG8_LDB(B0, 1, 0); PG8_LDB(B1, 1, 1); PG8_SCHED; PG8_LDA(At, 1, 0); PG8_STAGE(PG8_SA(0, 1), a2 + hstep, voffA);
            PG8_WAIT_V(8); PG8_WAIT_L(0); PG8_BAR; PG8_MMA(0, 0, At, B0); PG8_MMA(0, 1, At, B1); PG8_BAR; PG8_SCHED;
            PG8_LDA(At, 1, 1); PG8_STAGE(PG8_SB(1, 0), b3, voffB); PG8_STAGE(PG8_SB(1, 1), b3 + hstep, voffB); PG8_STAGE(PG8_SA(1, 0), a3, voffA);
            PG8_WAIT_V(8); PG8_WAIT_L(0); PG8_BAR; PG8_MMA(1, 0, At, B0); PG8_MMA(1, 1, At, B1); PG8_BAR; PG8_SCHED;
            } else {
            PG8_LDB(B0, 0, 0); PG8_SCHED; PG8_LDA(At, 0, 0); PG8_STAGE(PG8_SA(1, 1), a1 + hstep, voffA);
            PG8_WAIT_L(8); PG8_BAR; PG8_WAIT_L(0); PG8_MMA(0, 0, At, B0); PG8_BAR; PG8_SCHED;
            PG8_LDB(B1, 0, 1); PG8_STAGE(PG8_SB(0, 0), b2, voffB);
            PG8_BAR; PG8_WAIT_L(0); PG8_MMA(0, 1, At, B1); PG8_BAR;
            PG8_LDA(At, 0, 1); PG8_STAGE(PG8_SA(0, 0), a2, voffA);
            PG8_BAR; PG8_WAIT_L(0); PG8_MMA(1, 0, At, B0); PG8_BAR; PG8_SCHED;
            PG8_STAGE(PG8_SB(0, 1), b2 + hstep, voffB);
            PG8_WAIT_V(6); PG8_BAR; PG8_MMA(1, 1, At, B1); PG8_BAR;
            PG8_LDB(B0, 1, 0); PG8_SCHED; PG8_LDA(At, 1, 0); PG8_STAGE(PG8_SA(0, 1), a2 + hstep, voffA);
            PG8_WAIT_L(8); PG8_BAR; PG8_WAIT_L(0); PG8_MMA(0, 0, At, B0); PG8_BAR; PG8_SCHED;
            PG8_LDB(B1, 1, 1); PG8_STAGE(PG8_SB(1, 0), b3, voffB);
            PG8_BAR; PG8_WAIT_L(0); PG8_MMA(0, 1, At, B1); PG8_BAR;
            PG8_LDA(At, 1, 1); PG8_STAGE(PG8_SA(1, 0), a3, voffA);
            PG8_BAR; PG8_WAIT_L(0); PG8_MMA(1, 0, At, B0); PG8_BAR; PG8_SCHED;
            PG8_STAGE(PG8_SB(1, 1), b3 + hstep, voffB);
            PG8_WAIT_V(6); PG8_BAR; PG8_MMA(1, 1, At, B1); PG8_BAR;
            }
        }
        if constexpr (ES == 1) asm volatile("s_nop 15\n\ts_nop 15" ::: "memory");
        if constexpr (ALIGN_EPI) { if (wr == 0) PG8_BAR; }
        if constexpr (!Epi::AFTER_DRAIN) { E(acc, cur, wr, wc, fr, fq); S.done(cur); }
        if (!has_next) break;
#pragma unroll
        for (int a = 0; a < 2; ++a)
#pragma unroll
            for (int b = 0; b < 2; ++b)
#pragma unroll
                for (int m = 0; m < 4; ++m)
#pragma unroll
                    for (int n = 0; n < 2; ++n) acc[a][b][m][n] = (f32x4){0.f, 0.f, 0.f, 0.f};
        cur = nxt; cA = nA; cB = nB; ++ui;
        if constexpr (ALIGN_EPI) { if (wr == 1) PG8_BAR; }
    }
    PG8_WAIT_V(0);
    if constexpr (!ALIGN_EPI) { if (wr == 0) PG8_BAR; }
    PG8_BAR;
    if constexpr (Epi::AFTER_DRAIN) { E.fused(acc, cur, wr, wc, fr, fq, lds, wid, lane); S.done(cur); }
#undef PG8_SA
#undef PG8_SB
#undef PG8_STAGE
#undef PG8_LDA
#undef PG8_LDB
#undef PG8_MMA
#undef PG8_WAIT_V
#undef PG8_WAIT_L
#undef PG8_BAR
#undef PG8_SCHED
}
}

constexpr int D = 2048, SEQ = 8192, CTX = 256, MROWS = SEQ + CTX;
constexpr int INW = 4608, FFN = 7168, NEXP = 8;
constexpr int C_QB = 1024, C_QC = 1792, C_KB = 2560, C_VB = 2816, C_KC = 3072, C_VC = 3840;
constexpr int Y_B = 512, Y_C = 1280;
constexpr int MAXPAN = 72, MAXSLOT = MAXPAN * 256;
constexpr float EPS = 1e-6f;
constexpr float S_H8 = 16.f, S_WGU8 = 256.f, S_ACT8 = 8.f, S_WDN8 = 512.f;
constexpr int NWAVES = 8, NTHR = 512;

#define GAS __attribute__((address_space(1)))
#define LAS __attribute__((address_space(3)))
typedef unsigned short bf16;
typedef float f32x4 __attribute__((ext_vector_type(4)));
typedef unsigned v4u __attribute__((ext_vector_type(4)));
typedef unsigned v2u __attribute__((ext_vector_type(2)));
typedef short bf16x8 __attribute__((ext_vector_type(8)));
typedef short s16x4 __attribute__((ext_vector_type(4)));
typedef GAS unsigned gu32;
#define RLX_AGENT __ATOMIC_RELAXED, __HIP_MEMORY_SCOPE_AGENT
__device__ __forceinline__ float bf2f(bf16 v) { return __uint_as_float(((unsigned)v) << 16); }
__device__ __forceinline__ unsigned f2bf(float f) { unsigned u = __float_as_uint(f); return (u + 0x7fffu + ((u >> 16) & 1u)) >> 16; }
__device__ __forceinline__ unsigned pk2(float lo, float hi) { return f2bf(lo) | (f2bf(hi) << 16); }
__device__ __forceinline__ f32x4 ld4bf(const bf16* p) { const v2u u = *(const v2u*)p; return (f32x4){__uint_as_float(u.x << 16), __uint_as_float(u.x & 0xffff0000u), __uint_as_float(u.y << 16), __uint_as_float(u.y & 0xffff0000u)}; }
__device__ __forceinline__ void st4bf(bf16* p, f32x4 v) { v2u o; o.x = pk2(v.x, v.y); o.y = pk2(v.z, v.w); *(GAS v2u*)p = o; }
__device__ __forceinline__ float wave_sum(float v) {
#pragma unroll
    for (int o = 1; o < 64; o <<= 1) v += __shfl_xor(v, o);
    return v;
}

constexpr size_t MiB = 1u << 20;
constexpr size_t al(size_t x) { return (x + MiB - 1) / MiB * MiB; }
constexpr size_t WS_CTL = 0, CTL_ZERO_BYTES = 1 * MiB;
constexpr size_t WS_MOD = 1 * MiB;
constexpr size_t WS_ROPE = WS_MOD + 512 * 1024;
constexpr size_t WS_TOKE = 2 * MiB, WS_TOKW = WS_TOKE + 65536, WS_SLOT = WS_TOKW + 65536, WS_PSTART = WS_SLOT + 65536;
constexpr size_t WS_WIN = 4 * MiB;
constexpr size_t WS_WOUT = WS_WIN + al((size_t)2 * INW * D * 2);
constexpr size_t WS_WGU = WS_WOUT + al((size_t)2 * D * D * 2);
constexpr size_t WS_WDN = WS_WGU + al((size_t)2 * FFN * D * 2);
constexpr size_t WS_MGU = WS_WDN + al((size_t)D * FFN * 2);
constexpr size_t WS_MDN = WS_MGU + al((size_t)NEXP * 2 * FFN * D * 2);
constexpr size_t WS_H = WS_MDN + al((size_t)NEXP * D * FFN * 2);
constexpr size_t WS_P = WS_H + al((size_t)MROWS * D * 2);
constexpr size_t WS_Y = WS_P + al((size_t)MROWS * INW * 2);
constexpr size_t WS_Y2 = WS_Y + al((size_t)MROWS * D * 2);
constexpr size_t WS_ACT = WS_Y2 + al((size_t)MAXSLOT * D * 4);
constexpr size_t WS_HP = WS_ACT + al((size_t)MAXSLOT * FFN * 2);
constexpr size_t WS_Z = WS_HP + al((size_t)MAXSLOT * D * 2);
constexpr size_t WS_PART = WS_Z + al((size_t)CTX * D * 4);
constexpr size_t WS_XB = WS_PART + 64 * MiB;
constexpr size_t WS_END = WS_XB + al((size_t)MROWS * D * 2);
constexpr int CW_TMO = 0, CW_CODE = 1;
constexpr int CW_BAR = 4096;
constexpr int CW_CHEAD = 8192;
constexpr int CW_QUEUE = 16384;

constexpr int RING_BYTES = 131072;
constexpr int LDSCTL_OFF = RING_BYTES, MISC_OFF = LDSCTL_OFF + 320;
constexpr int LDS_BYTES = 147456;

#define XB_TMO      128
#define XB_XCNT(j)  (256  + 64 * (j))
#define XB_XSUB(j)  (1280 + 64 * (j))
#define XB_XGEN(j)  (2304 + 64 * (j))
#define XB_TOP      3328
#define XB_TOPGEN   3392
#define XCD_BAR_WORDS 3456
#define XB_SPIN_CAP (1u << 18)
__device__ __forceinline__ unsigned xb_ld(unsigned* p)              { return __hip_atomic_load(p, __ATOMIC_RELAXED, __HIP_MEMORY_SCOPE_AGENT); }
__device__ __forceinline__ unsigned xb_add(unsigned* p, unsigned v) { return __hip_atomic_fetch_add(p, v, __ATOMIC_RELAXED, __HIP_MEMORY_SCOPE_AGENT); }
__device__ __forceinline__ unsigned xb_xcc_id() { return (unsigned)__builtin_amdgcn_s_getreg((3 << 11) | 20) & 0xFu; }
#define XB_SPIN(cond, bar) do { unsigned _sp = 0; while (cond) { __builtin_amdgcn_s_sleep(1); \
    if ((++_sp & 255u) == 0u) { if (xb_ld(&(bar)[XB_TMO])) break; if (_sp > XB_SPIN_CAP) { atomicAdd(&(bar)[XB_TMO], 1u); break; } } } } while (0)
struct XcdBarrier { unsigned* bar; unsigned x; volatile LAS unsigned* st; };
__device__ __forceinline__ XcdBarrier xcd_barrier_post(unsigned* bar, volatile LAS unsigned* st) {
    XcdBarrier b; b.bar = bar; b.x = xb_xcc_id(); b.st = st;
    if (threadIdx.x == 0) (void)xb_add(&bar[XB_XCNT(b.x)], 1u);
    return b;
}
__device__ __forceinline__ void xcd_barrier_complete(unsigned* bar, unsigned x, unsigned& nloc, unsigned& nx) {
    const unsigned G = gridDim.x * gridDim.y * gridDim.z;
    unsigned sum, cnt, mine, sp = 0u;
    for (;;) {
        sum = 0u; cnt = 0u; mine = 0u;
#pragma unroll
        for (unsigned j = 0; j < 16; ++j) { const unsigned c = xb_ld(&bar[XB_XCNT(j)]); sum += c; cnt += (c > 0u) ? 1u : 0u; mine = (j == x) ? c : mine; }
        if (sum == G) break;
        __builtin_amdgcn_s_sleep(1);
        if ((++sp & 255u) == 0u) { if (xb_ld(&bar[XB_TMO])) break; if (sp > XB_SPIN_CAP) { atomicAdd(&bar[XB_TMO], 1u); break; } }
    }
    nloc = mine > 0u ? mine : 1u; nx = cnt > 0u ? cnt : 1u;
}
__device__ __forceinline__ void xcd_barrier(const XcdBarrier& b) {
    asm volatile("s_waitcnt vmcnt(0)" ::: "memory");
    __syncthreads();
    if (threadIdx.x == 0) {
        unsigned* bar = b.bar;
        __builtin_amdgcn_s_waitcnt(0);
        unsigned nloc = b.st[0], nx = b.st[1];
        if (nloc == 0u) { xcd_barrier_complete(bar, b.x, nloc, nx); b.st[0] = nloc; b.st[1] = nx; }
        const unsigned old = xb_add(&bar[XB_XSUB(b.x)], 1u);
        const unsigned gen = old / nloc;
        if (old + 1u == (gen + 1u) * nloc) {
            __builtin_amdgcn_fence(__ATOMIC_RELEASE, "agent");
            asm volatile("s_waitcnt vmcnt(0)" ::: "memory");
            const unsigned og = xb_add(&bar[XB_TOP], 1u);
            const unsigned tg = og / nx;
            if (og + 1u == (tg + 1u) * nx) xb_add(&bar[XB_TOPGEN], 1u);
            else XB_SPIN(xb_ld(&bar[XB_TOPGEN]) == tg, bar);
            __builtin_amdgcn_fence(__ATOMIC_ACQUIRE, "agent");
            xb_add(&bar[XB_XGEN(b.x)], 1u);
            asm volatile("s_waitcnt vmcnt(0)" ::: "memory");
        } else {
            XB_SPIN(xb_ld(&bar[XB_XGEN(b.x)]) == gen, bar);
            __builtin_amdgcn_fence(__ATOMIC_ACQUIRE, "agent");
            asm volatile("s_waitcnt vmcnt(0)" ::: "memory");
        }
    }
    __syncthreads();
}

struct Frame {
    LAS unsigned char* lds; volatile LAS unsigned* MISC; gu32* ctl;
    int tid, lane, wave, vcu, G;
    const float* in[22]; float* out; unsigned char* ws;
};
#define LDS_WAIT() asm volatile("s_waitcnt lgkmcnt(0)" ::: "memory")

template <int MAP> __device__ __forceinline__ int dest_row(int n) { if (MAP == 0) return n; const int b = n >= FFN, nn = n - b * FFN; return 256 * (nn >> 7) + 128 * b + (nn & 127); }
template <int MAP> __device__ __forceinline__ void conv_item(const float* W, int K, int N, bf16* WT, LAS float* scr, int item, int lane) {
    const int nblk = N / 32, kb = item / nblk, nb = item % nblk, k0 = 64 * kb, n0 = 32 * nb;
    { float t_[32];
#pragma unroll
      for (int i = 0; i < 32; ++i) { const int kk = 2 * i + (lane >> 5); t_[i] = __builtin_nontemporal_load(W + (size_t)(k0 + kk) * N + n0 + (lane & 31)); }
#pragma unroll
      for (int i = 0; i < 32; ++i) { const int kk = 2 * i + (lane >> 5); scr[kk * 33 + (lane & 31)] = t_[i]; } }
    LDS_WAIT(); asm volatile("" ::: "memory");
    const int c = lane & 7; const int r0 = dest_row<MAP>(n0);
#pragma unroll
    for (int j = 0; j < 4; ++j) { const int n = (lane >> 3) + 8 * j; const LAS float* s = scr + (8 * c) * 33 + n;
        v4u o; o.x = pk2(s[0 * 33], s[1 * 33]); o.y = pk2(s[2 * 33], s[3 * 33]); o.z = pk2(s[4 * 33], s[5 * 33]); o.w = pk2(s[6 * 33], s[7 * 33]);
        __builtin_nontemporal_store(o, (GAS v4u*)(WT + (size_t)(r0 + n) * K + k0 + 8 * c)); }
    LDS_WAIT(); asm volatile("" ::: "memory");
}
__device__ __forceinline__ unsigned pk4_fp8s(float a, float b, float c, float d, float sc) { return pg8::pk4_fp8(a * sc, b * sc, c * sc, d * sc); }
template <int MAP> __device__ __forceinline__ void conv_item8(const float* W, int K, int N, unsigned char* WT, float scale, LAS float* scr, int item, int lane) {
    const int nblk = N / 32, kb = item / nblk, nb = item % nblk, k0 = 128 * kb, n0 = 32 * nb;
    const int c = lane & 7; const int r0 = dest_row<MAP>(n0);
    v4u o[4];
    float t0_[32], t1_[32];
#pragma unroll
    for (int i = 0; i < 32; ++i) { const int kk = 2 * i + (lane >> 5); t0_[i] = __builtin_nontemporal_load(W + (size_t)(k0 + kk) * N + n0 + (lane & 31)); }
#pragma unroll
    for (int i = 0; i < 32; ++i) { const int kk = 2 * i + (lane >> 5); t1_[i] = __builtin_nontemporal_load(W + (size_t)(k0 + 64 + kk) * N + n0 + (lane & 31)); }
#pragma unroll
    for (int pass = 0; pass < 2; ++pass) {
#pragma unroll
        for (int i = 0; i < 32; ++i) { const int kk = 2 * i + (lane >> 5); scr[kk * 33 + (lane & 31)] = pass == 0 ? t0_[i] : t1_[i]; }
        LDS_WAIT(); asm volatile("" ::: "memory");
        if ((c >> 2) == pass) {
#pragma unroll
            for (int j = 0; j < 4; ++j) { const int n = (lane >> 3) + 8 * j; const LAS float* sp = scr + (16 * (c & 3)) * 33 + n;
                o[j].x = pk4_fp8s(sp[0 * 33], sp[1 * 33], sp[2 * 33], sp[3 * 33], scale); o[j].y = pk4_fp8s(sp[4 * 33], sp[5 * 33], sp[6 * 33], sp[7 * 33], scale);
                o[j].z = pk4_fp8s(sp[8 * 33], sp[9 * 33], sp[10 * 33], sp[11 * 33], scale); o[j].w = pk4_fp8s(sp[12 * 33], sp[13 * 33], sp[14 * 33], sp[15 * 33], scale); } }
        LDS_WAIT(); asm volatile("" ::: "memory");
    }
#pragma unroll
    for (int j = 0; j < 4; ++j) { const int n = (lane >> 3) + 8 * j; __builtin_nontemporal_store(o[j], (GAS v4u*)(WT + (size_t)(r0 + n) * K + k0 + 16 * c)); }
}
constexpr int I_GU8 = (D / 128) * (2 * FFN / 32), I_DN8 = (FFN / 128) * (D / 32), NCONV8 = NEXP * (I_GU8 + I_DN8);
__device__ __forceinline__ void conv_dispatch8(Frame& F, LAS float* scr, int it) {
    int r = it;
    if (r < NEXP * I_GU8) { const int e = r / I_GU8; conv_item8<1>(F.in[20] + (size_t)e * D * 2 * FFN, D, 2 * FFN, F.ws + WS_MGU + (size_t)e * 2 * FFN * D, S_WGU8, scr, r % I_GU8, F.lane); return; } r -= NEXP * I_GU8;
    { const int e = r / I_DN8; conv_item8<0>(F.in[21] + (size_t)e * FFN * D, FFN, D, F.ws + WS_MDN + (size_t)e * D * FFN, S_WDN8, scr, r % I_DN8, F.lane); }
}
constexpr int I_IN = (D / 64) * (INW / 32), I_OUT = (D / 64) * (D / 32), I_GU = (D / 64) * (2 * FFN / 32), I_DN = (FFN / 64) * (D / 32);
constexpr int NCONV = 2 * I_IN + 2 * I_OUT + I_GU + I_DN;
constexpr int MV_B0 = I_GU, MV_B1 = MV_B0 + I_DN, MV_B2 = MV_B1 + I_IN, MV_B = MV_B2 + I_OUT, MV_ITEMS = MV_B + NCONV8, MV_ENT = MV_ITEMS / NWAVES;
constexpr int Q_G10 = 4020, Q_MX0 = 1600, Q_G30 = 3100, Q_G40 = 950, Q_G11 = 2900, Q_MX1 = MV_ENT - (Q_G10 + Q_MX0 + Q_G30 + Q_G40 + Q_G11);
constexpr int QB_G10 = 0, QB_MX0 = QB_G10 + Q_G10, QB_G30 = QB_MX0 + Q_MX0, QB_G40 = QB_G30 + Q_G30, QB_G11 = QB_G40 + Q_G40, QB_MX1 = QB_G11 + Q_G11;
static_assert(MV_ITEMS % NWAVES == 0 && Q_MX1 > 0 && Q_G10 * NWAVES >= MV_B, "the bf16 items (read from G3_0 / G1_1 on) must all sit in the first queue");
__device__ __forceinline__ void conv_dispatch8(Frame& F, LAS float* scr, int it);
template <int MAP> __device__ __forceinline__ void conv_item(const float* W, int K, int N, bf16* WT, LAS float* scr, int item, int lane);
__device__ __forceinline__ void conv_moved(Frame& F, LAS float* scr, int it) {
    if (it < MV_B0) conv_item<1>(F.in[17], D, 2 * FFN, (bf16*)(F.ws + WS_WGU), scr, it, F.lane);
    else if (it < MV_B1) conv_item<0>(F.in[18], FFN, D, (bf16*)(F.ws + WS_WDN), scr, it - MV_B0, F.lane);
    else if (it < MV_B2) conv_item<0>(F.in[10] + (size_t)D * INW, D, INW, (bf16*)(F.ws + WS_WIN) + (size_t)INW * D, scr, it - MV_B1, F.lane);
    else if (it < MV_B) conv_item<0>(F.in[16] + (size_t)D * D, D, D, (bf16*)(F.ws + WS_WOUT) + (size_t)D * D, scr, it - MV_B2, F.lane);
    else conv_dispatch8(F, scr, it - MV_B);
}
__device__ __forceinline__ void conv_queue(Frame& F, gu32* qw, int base_ent, int nent) {
    LAS float* scr = (LAS float*)(F.lds + 32768 + F.wave * 8704); volatile LAS int* tk = (volatile LAS int*)(F.MISC + 24);
    __syncthreads();
    if (F.tid == 0) tk[0] = (int)__hip_atomic_fetch_add(qw, 1u, RLX_AGENT);
    __syncthreads();
    int cv = tk[0];
    while (cv < nent) {
        unsigned nx = 0u;
        if (F.tid == 0) nx = __hip_atomic_fetch_add(qw, 1u, RLX_AGENT);
        conv_moved(F, scr, (base_ent + cv) * NWAVES + F.wave);
        __syncthreads();
        if (F.tid == 0) tk[0] = (int)nx;
        __syncthreads();
        cv = tk[0];
    }
}
constexpr int NCONV_PRO = I_IN + I_OUT;
__device__ __forceinline__ void conv_dispatch(Frame& F, LAS float* scr, int it) {
    if (it < I_IN) conv_item<0>(F.in[10], D, INW, (bf16*)(F.ws + WS_WIN), scr, it, F.lane);
    else conv_item<0>(F.in[16], D, D, (bf16*)(F.ws + WS_WOUT), scr, it - I_IN, F.lane);
}
__device__ __forceinline__ void p_prologue(Frame& F) {
    const int gw = F.vcu * NWAVES + F.wave, NGW = F.G * NWAVES;
    const int MODEQ = 0;
    for (int task = F.vcu; task < 256; task += F.G) {
        LAS float* sv = (LAS float*)F.lds;
        LAS float* red = (LAS float*)(F.lds + 16384);
        for (int k = F.tid; k < 2 * D; k += NTHR) { const float x = k < D ? F.in[1][k] : F.in[3][k - D]; sv[k] = x / (1.f + __expf(-x)); }
        __syncthreads();
        const int l = task >> 7, chunk = task & 127, rg = F.tid / 24, c4 = F.tid % 24;
        if (rg < 21) {
            const float* W = F.in[4] + (size_t)l * D * 6 * D + chunk * 96 + 4 * c4;
            f32x4 a0 = {0.f, 0.f, 0.f, 0.f}, a1 = {0.f, 0.f, 0.f, 0.f};
#pragma unroll 8
            for (int k = rg; k < D; k += 21) { const f32x4 w = __builtin_nontemporal_load((const f32x4*)(W + (size_t)k * 6 * D)); a0 += sv[k] * w; a1 += sv[D + k] * w; }
            *(LAS f32x4*)(red + (rg * 2 + 0) * 96 + 4 * c4) = a0; *(LAS f32x4*)(red + (rg * 2 + 1) * 96 + 4 * c4) = a1;
        }
        __syncthreads();
        if (F.tid < 192) { const int w = F.tid / 96, cc = F.tid % 96; float sacc = 0.f;
#pragma unroll
          for (int q = 0; q < 21; ++q) sacc += red[(q * 2 + w) * 96 + cc];
          ((float*)(F.ws + WS_MOD))[((size_t)l * 2 + w) * 6 * D + chunk * 96 + cc] = sacc + F.in[5][l * 6 * D + chunk * 96 + cc]; }
        __syncthreads();
    }
    { const int gt = blockIdx.x * NTHR + F.tid;
      if (gt < 128 * 32) { const int pos = gt >> 5, i = gt & 31; const float inv = exp2f(-(float)i * (13.287712379549449f / 32.f)); float sn, cs; sincosf((float)pos * inv, &sn, &cs);
          ((float*)(F.ws + WS_ROPE))[gt] = cs; ((float*)(F.ws + WS_ROPE))[4096 + gt] = sn; } }
    LAS float* scr = (LAS float*)(F.lds + 32768 + F.wave * 8704);
    { gu32* head = F.ctl + CW_CHEAD; volatile LAS int* sh = (volatile LAS int*)(F.MISC + 24); constexpr int N8 = 0; constexpr int NALL = NCONV_PRO, PULL = 16;
      (void)gw; (void)NGW; (void)MODEQ;
      if (F.tid == 0) sh[0] = (int)__hip_atomic_fetch_add(head, (unsigned)PULL, RLX_AGENT);
      __syncthreads();
      int h = sh[0];
      while (h < NALL) {
          unsigned nx = 0u;
          if (F.tid == 0) nx = __hip_atomic_fetch_add(head, (unsigned)PULL, RLX_AGENT);
#pragma unroll 1
          for (int k = 0; k < PULL / NWAVES; ++k) { const int it = h + NWAVES * k + F.wave; if (it < N8) conv_dispatch8(F, scr, it); else if (it < NALL) conv_dispatch(F, scr, it - N8); }
          __syncthreads();
          if (F.tid == 0) sh[0] = (int)nx;
          __syncthreads();
          h = sh[0];
      } }
}

__device__ __forceinline__ void p_prenorm0(Frame& F) {
    const int gw = F.wave * F.G + F.vcu, NGW = F.G * NWAVES; const float* MOD = (const float*)(F.ws + WS_MOD); bf16* H = (bf16*)(F.ws + WS_H); const float* gpre = F.in[6]; const int lane = F.lane;
    LAS float* cf = (LAS float*)F.lds;
    { const int col = 4 * F.tid;
#pragma unroll
      for (int pt = 0; pt < 2; ++pt) { const float* mod = MOD + pt * 6 * D;
          *(LAS f32x4*)(cf + (pt * 2 + 0) * D + col) = *(const f32x4*)(gpre + col) * (1.f + *(const f32x4*)(mod + D + col)); *(LAS f32x4*)(cf + (pt * 2 + 1) * D + col) = *(const f32x4*)(mod + col); }
      __syncthreads(); }
    int row = gw; if (row >= MROWS) return;
    f32x4 xc[8];
#define PN_LOAD(R, X) do { const float* src_ = (R) < SEQ ? F.in[0] + (size_t)(R) * D : F.in[2] + (size_t)((R) - SEQ) * D; _Pragma("unroll") for (int j = 0; j < 8; ++j) X[j] = __builtin_nontemporal_load((const f32x4*)(src_ + 4 * lane + 256 * j)); } while (0)
    PN_LOAD(row, xc);
    for (;;) {
        const int nrow = row + NGW; const bool more = nrow < MROWS;
        f32x4 xn[8]; if (more) PN_LOAD(nrow, xn);
        const int pt = row < SEQ ? 0 : 1; const LAS float* cA = cf + (pt * 2 + 0) * D + 4 * lane; const LAS float* cB = cf + (pt * 2 + 1) * D + 4 * lane;
        float ss = 0.f;
#pragma unroll
        for (int j = 0; j < 8; ++j) ss += (xc[j].x * xc[j].x + xc[j].y * xc[j].y) + (xc[j].z * xc[j].z + xc[j].w * xc[j].w);
        const float r = rsqrtf(wave_sum(ss) * (1.f / D) + EPS);
#pragma unroll
        for (int j = 0; j < 8; ++j) { const int col = 4 * lane + 256 * j; const f32x4 h = (xc[j] * r) * *(const LAS f32x4*)(cA + 256 * j) + *(const LAS f32x4*)(cB + 256 * j);
            v2u o; o.x = pk2(h.x, h.y); o.y = pk2(h.z, h.w); __builtin_nontemporal_store(o, (GAS v2u*)(H + (size_t)row * D + col)); }
        if (!more) break;
#pragma unroll
        for (int j = 0; j < 8; ++j) xc[j] = xn[j];
        row = nrow;
    }
#undef PN_LOAD
}
template <bool XF32> __device__ __forceinline__ void p_post(Frame& F, const bf16* Y2, const float* gpost, int gate_off, const float* gmod  ,
                                       const float* xlat_src, const float* xctx_src, bf16* XB, int nrows,
                                       const float* gpre, const float* pmod  , int sh_off, int sc_off, bf16* H, const float* wrouter, int* tok_e, float* tok_w, const bf16* part, int npart) {
    const int gw = F.wave * F.G + F.vcu, NGW = F.G * NWAVES; const int lane = F.lane;
    LAS float* wrt = (LAS float*)F.lds;
    if (wrouter) { const int t = F.tid; f32x4 rw[8];
#pragma unroll
        for (int q = 0; q < 8; ++q) rw[q] = *(const f32x4*)(wrouter + (size_t)(4 * t) * NEXP + 4 * q);
#pragma unroll
        for (int e = 0; e < 8; ++e) { f32x4 o; o.x = rw[0 + (e >> 2)][e & 3]; o.y = rw[2 + (e >> 2)][e & 3]; o.z = rw[4 + (e >> 2)][e & 3]; o.w = rw[6 + (e >> 2)][e & 3]; *(LAS f32x4*)(wrt + e * D + 4 * t) = o; }
        __syncthreads(); }
    LAS float* cf = (LAS float*)(F.lds + 65536);
    { const int col = 4 * F.tid;
#pragma unroll
      for (int pt = 0; pt < 2; ++pt) { const float* gm = gmod + pt * 6 * D; const float* pm = pmod + pt * 6 * D;
          *(LAS f32x4*)(cf + (pt * 3 + 0) * D + col) = *(const f32x4*)(gm + gate_off + col) * *(const f32x4*)(gpost + col);
          *(LAS f32x4*)(cf + (pt * 3 + 1) * D + col) = *(const f32x4*)(gpre + col) * (1.f + *(const f32x4*)(pm + sc_off + col));
          *(LAS f32x4*)(cf + (pt * 3 + 2) * D + col) = *(const f32x4*)(pm + sh_off + col); }
      __syncthreads(); }
#pragma unroll 1
    for (int part_o = 0; part_o < 2; ++part_o) {
        const int part_i = 1 - part_o; const bool lat = part_i == 0;
        const int rend = lat ? (nrows < SEQ ? nrows : SEQ) : nrows;
        int row = lat ? gw : SEQ + gw;
        if (row >= rend) continue;
        const LAS float* cA1 = cf + (part_i * 3 + 0) * D + 4 * lane; const LAS float* cA2 = cf + (part_i * 3 + 1) * D + 4 * lane; const LAS float* cB2 = cf + (part_i * 3 + 2) * D + 4 * lane;
        v2u yc[8]; f32x4 xcf[XF32 ? 8 : 1]; v2u xcb[XF32 ? 1 : 8];
#define PP_LOAD(R, YD, XF, XBD) do { const bf16* y_ = Y2 + (size_t)(R) * D; _Pragma("unroll") for (int j = 0; j < 8; ++j) { const int col = 4 * lane + 256 * j; YD[j] = __builtin_nontemporal_load((const v2u*)(y_ + col)); \
            if constexpr (XF32) { const float* xs_ = (R) < SEQ ? xlat_src + (size_t)(R) * D : xctx_src + (size_t)((R) - SEQ) * D; XF[j] = __builtin_nontemporal_load((const f32x4*)(xs_ + col)); } \
            else XBD[j] = __builtin_nontemporal_load((const v2u*)(XB + (size_t)(R) * D + col)); } } while (0)
        PP_LOAD(row, yc, xcf, xcb);
        for (;;) {
            const int nrow = row + NGW; const bool more = nrow < rend;
            v2u yn[8]; f32x4 xnf[XF32 ? 8 : 1]; v2u xnb[XF32 ? 1 : 8];
            if constexpr (!XF32) { if (more) PP_LOAD(nrow, yn, xnf, xnb); }
            f32x4 v[8]; float ss = 0.f;
#pragma unroll
            for (int j = 0; j < 8; ++j) v[j] = (f32x4){__uint_as_float(yc[j].x << 16), __uint_as_float(yc[j].x & 0xffff0000u), __uint_as_float(yc[j].y << 16), __uint_as_float(yc[j].y & 0xffff0000u)};
            if (!lat) {
#pragma unroll 1
                for (int p = 0; p < npart; ++p) { const bf16* pp = part + ((size_t)p * CTX + (row - SEQ)) * D + 4 * lane; v2u t[8];
#pragma unroll
                    for (int j = 0; j < 8; ++j) t[j] = *(const v2u*)(pp + 256 * j);
#pragma unroll
                    for (int j = 0; j < 8; ++j) v[j] += (f32x4){__uint_as_float(t[j].x << 16), __uint_as_float(t[j].x & 0xffff0000u), __uint_as_float(t[j].y << 16), __uint_as_float(t[j].y & 0xffff0000u)}; } }
#pragma unroll
            for (int j = 0; j < 8; ++j) ss += (v[j].x * v[j].x + v[j].y * v[j].y) + (v[j].z * v[j].z + v[j].w * v[j].w);
            const float r = rsqrtf(wave_sum(ss) * (1.f / D) + EPS);
            float s2 = 0.f; bf16* xb = XB + (size_t)row * D;
#pragma unroll
            for (int j = 0; j < 8; ++j) { const int col = 4 * lane + 256 * j; f32x4 x;
                if constexpr (XF32) x = xcf[j]; else x = (f32x4){__uint_as_float(xcb[j].x << 16), __uint_as_float(xcb[j].x & 0xffff0000u), __uint_as_float(xcb[j].y << 16), __uint_as_float(xcb[j].y & 0xffff0000u)};
                v[j] = x + *(const LAS f32x4*)(cA1 + 256 * j) * (v[j] * r); { v2u xo_; xo_.x = pk2(v[j].x, v[j].y); xo_.y = pk2(v[j].z, v[j].w); __builtin_nontemporal_store(xo_, (GAS v2u*)(xb + col)); } s2 += (v[j].x * v[j].x + v[j].y * v[j].y) + (v[j].z * v[j].z + v[j].w * v[j].w); }
            const float r2 = rsqrtf(wave_sum(s2) * (1.f / D) + EPS);
            float lg[8] = {0.f, 0.f, 0.f, 0.f, 0.f, 0.f, 0.f, 0.f};
#pragma unroll
            for (int j = 0; j < 8; ++j) { const int col = 4 * lane + 256 * j;
                const f32x4 h = (v[j] * r2) * *(const LAS f32x4*)(cA2 + 256 * j) + *(const LAS f32x4*)(cB2 + 256 * j); v2u o; o.x = pk2(h.x, h.y); o.y = pk2(h.z, h.w); __builtin_nontemporal_store(o, (GAS v2u*)(H + (size_t)row * D + col));
                if (wrouter) {
#pragma unroll
                    for (int e = 0; e < 8; ++e) { const f32x4 we = *(const LAS f32x4*)(wrt + e * D + col); lg[e] += (h.x * we.x + h.y * we.y) + (h.z * we.z + h.w * we.w); } } }
            if (wrouter) {
#pragma unroll
                for (int e = 0; e < 8; ++e) lg[e] = wave_sum(lg[e]);
                int i1 = 0; float v1 = lg[0];
#pragma unroll
                for (int e = 1; e < 8; ++e) if (lg[e] > v1) { v1 = lg[e]; i1 = e; }
                int i2 = -1; float v2 = -3.0e38f;
#pragma unroll
                for (int e = 0; e < 8; ++e) if (e != i1 && lg[e] > v2) { v2 = lg[e]; i2 = e; }
                const float w1 = 1.f / (1.f + __expf(v2 - v1));
                if (lane == 0) { tok_e[2 * row] = i1; tok_e[2 * row + 1] = i2; tok_w[2 * row] = w1; tok_w[2 * row + 1] = 1.f - w1; }
            }
            if (!more) break;
            if constexpr (XF32) { PP_LOAD(nrow, yc, xcf, xcb); }
            else {
#pragma unroll
                for (int j = 0; j < 8; ++j) { yc[j] = yn[j]; xcb[j] = xnb[j]; } }
            row = nrow;
        }
#undef PP_LOAD
    }
}
__device__ __forceinline__ void p_combine(Frame& F, const bf16* Y2e, const int* slot_of, const float* tok_w, const float* gpost, const float* gate, const bf16* xsrc, float* xdst, const bf16* part, const int* pstart) {
    const int gw = F.vcu * NWAVES + F.wave, NGW = F.G * NWAVES; const int lane = F.lane;
    const int Ptot = __builtin_amdgcn_readfirstlane(pstart[8]), ppr = F.G / (D / 256), Pf = (Ptot / ppr) * ppr, rr = Ptot - Pf, sk = pg8::pick_split(rr, D / 256, FFN / 128, F.G);
    const size_t pstride = (size_t)rr * 256 * D; const int slot_f = Pf * 256;
    LAS float* cf = (LAS float*)F.lds;
    { const int col = 4 * F.tid; *(LAS f32x4*)(cf + col) = *(const f32x4*)(gate + col) * *(const f32x4*)(gpost + col); __syncthreads(); }
    const LAS float* cA = cf + 4 * lane;
    int row = gw; if (row >= SEQ) return;
    v2u y1c[8], y2c[8], xc[8]; int s1 = slot_of[2 * row], s2 = slot_of[2 * row + 1]; float w1 = tok_w[2 * row], w2 = tok_w[2 * row + 1];
#define PC_LOAD(R, S1, S2, Y1, Y2_, X) do { _Pragma("unroll") for (int j = 0; j < 8; ++j) { const int col = 4 * lane + 256 * j; Y1[j] = __builtin_nontemporal_load((const v2u*)(Y2e + (size_t)(S1) * D + col)); Y2_[j] = __builtin_nontemporal_load((const v2u*)(Y2e + (size_t)(S2) * D + col)); X[j] = __builtin_nontemporal_load((const v2u*)(xsrc + (size_t)(R) * D + col)); } } while (0)
#define PC_F4(u) ((f32x4){__uint_as_float((u).x << 16), __uint_as_float((u).x & 0xffff0000u), __uint_as_float((u).y << 16), __uint_as_float((u).y & 0xffff0000u)})
    PC_LOAD(row, s1, s2, y1c, y2c, xc);
    for (;;) {
        const int nrow = row + NGW; const bool more = nrow < SEQ;
        v2u y1n[8], y2n[8], xn[8]; int s1n = 0, s2n = 0; float w1n = 0.f, w2n = 0.f;
        if (more) { s1n = slot_of[2 * nrow]; s2n = slot_of[2 * nrow + 1]; w1n = tok_w[2 * nrow]; w2n = tok_w[2 * nrow + 1]; PC_LOAD(nrow, s1n, s2n, y1n, y2n, xn); }
        f32x4 v[8]; float ss = 0.f;
#pragma unroll
        for (int j = 0; j < 8; ++j) v[j] = w1 * PC_F4(y1c[j]) + w2 * PC_F4(y2c[j]);
        if (s1 >= slot_f) {
#pragma unroll 1
            for (int p = 0; p < sk - 1; ++p) { const bf16* pp = part + (size_t)p * pstride + (size_t)(s1 - slot_f) * D + 4 * lane; v2u t[8];
#pragma unroll
                for (int j = 0; j < 8; ++j) t[j] = *(const v2u*)(pp + 256 * j);
#pragma unroll
                for (int j = 0; j < 8; ++j) v[j] += w1 * PC_F4(t[j]); } }
        if (s2 >= slot_f) {
#pragma unroll 1
            for (int p = 0; p < sk - 1; ++p) { const bf16* pp = part + (size_t)p * pstride + (size_t)(s2 - slot_f) * D + 4 * lane; v2u t[8];
#pragma unroll
                for (int j = 0; j < 8; ++j) t[j] = *(const v2u*)(pp + 256 * j);
#pragma unroll
                for (int j = 0; j < 8; ++j) v[j] += w2 * PC_F4(t[j]); } }
#pragma unroll
        for (int j = 0; j < 8; ++j) ss += (v[j].x * v[j].x + v[j].y * v[j].y) + (v[j].z * v[j].z + v[j].w * v[j].w);
        const float r = rsqrtf(wave_sum(ss) * (1.f / D) + EPS);
#pragma unroll
        for (int j = 0; j < 8; ++j) { const int col = 4 * lane + 256 * j;
            __builtin_nontemporal_store(PC_F4(xc[j]) + *(const LAS f32x4*)(cA + 256 * j) * (v[j] * r), (GAS f32x4*)(xdst + (size_t)row * D + col)); }
        if (!more) break;
#pragma unroll
        for (int j = 0; j < 8; ++j) { y1c[j] = y1n[j]; y2c[j] = y2n[j]; xc[j] = xn[j]; }
        s1 = s1n; s2 = s2n; w1 = w1n; w2 = w2n; row = nrow;
    }
#undef PC_LOAD
#undef PC_F4
}

__device__ __forceinline__ void p_route(Frame& F) {
    const int* tok_e = (const int*)(F.ws + WS_TOKE); int* slot_of = (int*)(F.ws + WS_SLOT); int* pstart = (int*)(F.ws + WS_PSTART);
    const bf16* H = (const bf16*)(F.ws + WS_H); unsigned char* HP = F.ws + WS_HP;
    LAS unsigned char* te = F.lds;
    LAS int* cnt = (LAS int*)(F.lds + 16384);
    LAS int* rowtok = (LAS int*)(F.lds + 32768);
    LAS int* ps = (LAS int*)(F.lds + 32768 + MAXSLOT * 4);
    const int t = F.tid;
    int c[8] = {0, 0, 0, 0, 0, 0, 0, 0};
#pragma unroll
    for (int j4 = 0; j4 < 8; ++j4) { const v4u ev = *(const v4u*)(tok_e + 32 * t + 4 * j4); const unsigned ee[4] = {ev.x, ev.y, ev.z, ev.w};
#pragma unroll
        for (int q = 0; q < 4; ++q) { te[32 * t + 4 * j4 + q] = (unsigned char)ee[q];
#pragma unroll
            for (int e = 0; e < 8; ++e) c[e] += (ee[q] == (unsigned)e); } }
#pragma unroll
    for (int e = 0; e < 8; ++e) cnt[t * 8 + e] = c[e];
    for (int s = t; s < MAXSLOT; s += NTHR) rowtok[s] = -1;
    __syncthreads();
    { const int e = F.wave; int loc[8]; int sum = 0;
#pragma unroll
      for (int q = 0; q < 8; ++q) { loc[q] = cnt[(8 * F.lane + q) * 8 + e]; sum += loc[q]; }
      int inc = sum;
#pragma unroll
      for (int o = 1; o < 64; o <<= 1) { const int up = __shfl_up(inc, o); if (F.lane >= o) inc += up; }
      int run = inc - sum;
#pragma unroll
      for (int q = 0; q < 8; ++q) { cnt[(8 * F.lane + q) * 8 + e] = run; run += loc[q]; }
      if (F.lane == 63) ps[9 + e] = inc; }
    __syncthreads();
    if (t == 0) { int p = 0; for (int e = 0; e < 8; ++e) { ps[e] = p; p += (ps[9 + e] + 255) >> 8; } ps[8] = p; }
    __syncthreads();
    if (blockIdx.x == 0 && t < 9) pstart[t] = ps[t];
    { int run[8];
#pragma unroll
      for (int e = 0; e < 8; ++e) run[e] = ps[e] * 256 + cnt[t * 8 + e];
      const bool mine = ((t >> 1) % F.G) == (int)blockIdx.x;
      for (int j = 0; j < 32; ++j) { const int idx = 32 * t + j; const int e = te[idx]; int slot = 0;
#pragma unroll
          for (int q = 0; q < 8; ++q) if (e == q) { slot = run[q]; run[q] = slot + 1; }
          rowtok[slot] = idx >> 1; if (mine) slot_of[idx] = slot; } }
    __syncthreads();
    const int nslot = ps[8] * 256;
    { const int str = F.G * NWAVES;
      for (int s0 = blockIdx.x * NWAVES + F.wave; s0 < nslot; s0 += 4 * str) { v4u rv[4][4]; int tokb[4];
#pragma unroll
        for (int b4 = 0; b4 < 4; ++b4) { const int s = s0 + b4 * str; tokb[b4] = s < nslot ? rowtok[s] : -1; const int tl = tokb[b4] >= 0 ? tokb[b4] : 0;
#pragma unroll
            for (int j = 0; j < 4; ++j) rv[b4][j] = *(const v4u*)(H + (size_t)tl * D + 32 * F.lane + 8 * j); }
#define RT_PK(v) pk4_fp8s(__uint_as_float((v).x << 16), __uint_as_float((v).x & 0xffff0000u), __uint_as_float((v).y << 16), __uint_as_float((v).y & 0xffff0000u), S_H8), pk4_fp8s(__uint_as_float((v).z << 16), __uint_as_float((v).z & 0xffff0000u), __uint_as_float((v).w << 16), __uint_as_float((v).w & 0xffff0000u), S_H8)
#pragma unroll
        for (int b4 = 0; b4 < 4; ++b4) { const int s = s0 + b4 * str;
            if (s < nslot) { v4u o0 = (v4u){RT_PK(rv[b4][0]), RT_PK(rv[b4][1])}, o1 = (v4u){RT_PK(rv[b4][2]), RT_PK(rv[b4][3])};
                if (tokb[b4] < 0) { o0 = (v4u){0u, 0u, 0u, 0u}; o1 = (v4u){0u, 0u, 0u, 0u}; }
                *(GAS v4u*)(HP + (size_t)s * D + 32 * F.lane) = o0; *(GAS v4u*)(HP + (size_t)s * D + 32 * F.lane + 16) = o1; } }
#undef RT_PK
      } }
    __syncthreads();
}

namespace mx {
constexpr int KSTR = 288;
constexpr int TILE_B = 32 * KSTR;
constexpr int OFF_RPB = 6 * TILE_B;
constexpr int OFF_VH = 0;
constexpr float SC_L2 = 0.08838834764831845f * 1.4426950408889634f;
constexpr float L2E = 1.4426950408889634f;
constexpr float NEG = -1e30f;

__device__ __forceinline__ bf16x8 tr_pair(const LAS unsigned char* p, int off0, int off1) {
    const s16x4 a = __builtin_amdgcn_ds_read_tr16_b64_v4i16((LAS s16x4*)(p + off0)); const s16x4 b = __builtin_amdgcn_ds_read_tr16_b64_v4i16((LAS s16x4*)(p + off1));
    return (bf16x8){a[0], a[1], a[2], a[3], b[0], b[1], b[2], b[3]};
}
typedef __bf16 bf16v2 __attribute__((ext_vector_type(2))); typedef float f32v2 __attribute__((ext_vector_type(2)));
__device__ __forceinline__ unsigned cvt_pk(float lo, float hi) { const f32v2 v = {lo, hi}; const bf16v2 b = __builtin_convertvector(v, bf16v2); return __builtin_bit_cast(unsigned, b); }

template <int VAR> __device__ __forceinline__ void attn_unit(Frame& F, const bf16* P, bf16* Y, int u0, int u1, int band, const float* sink, const float* rpb) {
    constexpr int MQ = VAR == 0 ? 3 : 2;
    LAS unsigned char* lds = F.lds;
    int lane_; asm volatile("v_mbcnt_lo_u32_b32 %0, -1, 0\n\tv_mbcnt_hi_u32_b32 %0, -1, %0" : "=v"(lane_));
    const int lane = lane_, w = F.wave, fr = lane & 15, fq = lane >> 4, tid = w * 64 + lane_;
    int qrow[MQ], qcol[MQ], ycol[MQ]; int kcol, vcol;
    int nb = 0, blo = 0;
    int r_w = 0, r0_w = 0, cbase = 0;
    float m[MQ], l[MQ];
    if constexpr (VAR == 0) {
        kcol = C_KB + u1 * 128; vcol = C_VB + u1 * 128;
#pragma unroll
        for (int q = 0; q < MQ; ++q) { const int h = 3 * u1 + q; qrow[q] = u0 + 16 * w + fr; qcol[q] = C_QB + h * 128; ycol[q] = Y_B + h * 128; m[q] = sink[h] * L2E; l[q] = fq == 0 ? 1.f : 0.f; }
        if (band) { const int lo = u0 - 128 < 0 ? 0 : u0 - 128, hi = u0 + 256 > SEQ ? SEQ : u0 + 256; blo = lo; nb = (hi - lo) >> 5; }
    } else {
        kcol = C_KC + u0 * 128; vcol = C_VC + u0 * 128;
        if (band) { r_w = u1 + (w >> 1); cbase = 32 * (w & 1); r0_w = r_w - 4 < 0 ? 0 : (r_w - 4 > 120 ? 120 : r_w - 4);
            const int klo = u1 - 4 < 0 ? 0 : (u1 - 4 > 120 ? 120 : u1 - 4); int khi = u1 + 3 - 4; khi = (khi < 0 ? 0 : (khi > 120 ? 120 : khi)) + 8; blo = klo; nb = 2 * (khi - klo); }
#pragma unroll
        for (int q = 0; q < MQ; ++q) { qrow[q] = band ? 64 * r_w + cbase + 16 * q + fr : SEQ + 32 * w + 16 * q + fr; qcol[q] = C_QC + u0 * 128; ycol[q] = Y_C + u0 * 128; m[q] = NEG; l[q] = 0.f; }
        if (band) { for (int i = tid; i < 15 * 128; i += NTHR) { const int ro = i >> 7, co = (i & 127) - 48; ((LAS float*)(lds + OFF_RPB))[i] = (co >= 0 && co < 31) ? rpb[(u0 * 15 + ro) * 31 + co] * L2E : 0.f; } }
    }
    const int NT = nb + 8;
    bf16x8 qf[MQ][4];
#pragma unroll
    for (int q = 0; q < MQ; ++q)
#pragma unroll
        for (int kk = 0; kk < 4; ++kk) qf[q][kk] = *(const bf16x8*)(P + (size_t)qrow[q] * INW + qcol[q] + 32 * kk + 8 * fq);
    f32x4 o[MQ][8];
#pragma unroll
    for (int q = 0; q < MQ; ++q)
#pragma unroll
        for (int dt = 0; dt < 8; ++dt) o[q][dt] = (f32x4){0.f, 0.f, 0.f, 0.f};
    const int si = tid >> 4, sc16 = tid & 15; const int soff = si * KSTR + sc16 * 16;
#define MX_TILE_ROW(t) (VAR == 0 ? ((t) < nb ? blo + 32 * (t) : SEQ + 32 * ((t) - nb)) : ((t) < 8 ? SEQ + 32 * (t) : 64 * (blo + (((t) - 8) >> 1)) + 32 * (((t) - 8) & 1)))
    constexpr int DEPTH = VAR == 1 ? 2 : 1;
    v4u kA, vA, kB, vB;
    { const int row0 = MX_TILE_ROW(0); kA = *(const v4u*)(P + (size_t)(row0 + si) * INW + kcol + 8 * sc16); vA = *(const v4u*)(P + (size_t)(row0 + si) * INW + vcol + 8 * sc16); }
    if constexpr (DEPTH == 2) { const int row1 = MX_TILE_ROW(1); kB = *(const v4u*)(P + (size_t)(row1 + si) * INW + kcol + 8 * sc16); vB = *(const v4u*)(P + (size_t)(row1 + si) * INW + vcol + 8 * sc16); }
    else { kB = kA; vB = vA; }
    __syncthreads();
    *(LAS v4u*)(lds + soff) = kA; *(LAS v4u*)(lds + TILE_B + soff) = vA;
    __syncthreads();
    const int koff = fr * KSTR + fq * 16;
    const int voff = (4 * fq + (fr >> 2)) * KSTR + (fr & 3) * 8;
    __builtin_amdgcn_s_waitcnt(0);
    for (int t0 = 0; t0 < NT; t0 += DEPTH) {
#pragma unroll
      for (int par = 0; par < DEPTH; ++par) {
        const int t = t0 + par; if (t >= NT) break;
        v4u& kl = par == 0 ? kA : kB; v4u& vl = par == 0 ? vA : vB;
        const v4u& ks_ = (DEPTH == 1 || par == 1) ? kA : kB; const v4u& vs_ = (DEPTH == 1 || par == 1) ? vA : vB;
        const int buf = t % 3, bufn = (t + 1) % 3;
        if (t + DEPTH < NT) { const int row0 = MX_TILE_ROW(t + DEPTH); kl = *(const v4u*)(P + (size_t)(row0 + si) * INW + kcol + 8 * sc16); vl = *(const v4u*)(P + (size_t)(row0 + si) * INW + vcol + 8 * sc16); }
        bool rel = true; int kpos0 = 0, kr = 0, hf = 0;
        const bool is_band = VAR == 0 ? (t < nb) : (t >= 8);
        if constexpr (VAR == 0) { if (is_band) { kpos0 = blo + 32 * t; const int tq0 = u0 + 16 * w; rel = (kpos0 + 31 >= tq0 - 128) && (kpos0 <= tq0 + 15 + 128); } }
        else { if (is_band) { kr = blo + ((t - 8) >> 1); hf = (t - 8) & 1; rel = (kr >= r0_w) && (kr < r0_w + 8); } }
        if (rel) {
            const LAS unsigned char* Kt = lds + buf * 2 * TILE_B; const LAS unsigned char* Vt = Kt + TILE_B;
            float bb[VAR == 1 ? MQ : 1][8]; int c0q[VAR == 1 ? MQ : 1];
            if constexpr (VAR == 1) { if (is_band) {
#pragma unroll
                for (int q = 0; q < MQ; ++q) { const int c = cbase + 16 * q + fr; c0q[q] = c - 8 < 0 ? 0 : (c - 8 > 48 ? 48 : c - 8);
                    const LAS float* bp = (const LAS float*)(lds + OFF_RPB) + (kr - r_w + 7) * 128 + 32 * hf + 4 * fq - c + 63;
#pragma unroll
                    for (int j = 0; j < 8; ++j) bb[q][j] = bp[16 * (j >> 2) + (j & 3)]; } } }
            f32x4 st[MQ][2];
#pragma unroll
            for (int q = 0; q < MQ; ++q) { st[q][0] = (f32x4){0.f, 0.f, 0.f, 0.f}; st[q][1] = (f32x4){0.f, 0.f, 0.f, 0.f}; }
#pragma unroll
            for (int ks = 0; ks < 2; ++ks)
#pragma unroll
                for (int kk = 0; kk < 4; ++kk) { const bf16x8 kf = *(const LAS bf16x8*)(Kt + koff + ks * 16 * KSTR + kk * 64);
#pragma unroll
                    for (int q = 0; q < MQ; ++q) st[q][ks] = __builtin_amdgcn_mfma_f32_16x16x32_bf16(kf, qf[q][kk], st[q][ks], 0, 0, 0); }
            if constexpr (VAR == 1) {
            float s[MQ][8]; float mt[MQ];
#pragma unroll
            for (int q = 0; q < MQ; ++q) {
                if (!is_band) {
#pragma unroll
                    for (int j = 0; j < 8; ++j) s[q][j] = st[q][j >> 2][j & 3] * SC_L2;
                } else if constexpr (VAR == 0) {
                    const int w0 = kpos0 + 4 * fq - qrow[q] + 128;
#pragma unroll
                    for (int j = 0; j < 8; ++j) { const float v = st[q][j >> 2][j & 3] * SC_L2; s[q][j] = ((unsigned)(w0 + 16 * (j >> 2) + (j & 3)) <= 256u) ? v : NEG; }
                } else {
                    const int v0 = 32 * hf + 4 * fq - c0q[q];
#pragma unroll
                    for (int j = 0; j < 8; ++j) { const float v = st[q][j >> 2][j & 3] * SC_L2 + bb[q][j]; s[q][j] = ((unsigned)(v0 + 16 * (j >> 2) + (j & 3)) < 16u) ? v : NEG; }
                }
                float x = fmaxf(fmaxf(fmaxf(s[q][0], s[q][1]), fmaxf(s[q][2], s[q][3])), fmaxf(fmaxf(s[q][4], s[q][5]), fmaxf(s[q][6], s[q][7])));
                x = fmaxf(x, __shfl_xor(x, 16)); x = fmaxf(x, __shfl_xor(x, 32)); mt[q] = x;
            }
            bool grow = false;
#pragma unroll
            for (int q = 0; q < MQ; ++q) grow = grow || (mt[q] > m[q]);
            if (__any(grow)) {
#pragma unroll
                for (int q = 0; q < MQ; ++q) { const float mn = fmaxf(m[q], mt[q]); const float alpha = __builtin_amdgcn_exp2f(m[q] - mn); m[q] = mn; l[q] *= alpha;
#pragma unroll
                    for (int dt = 0; dt < 8; ++dt) o[q][dt] *= alpha; } }
            bf16x8 pb[MQ];
#pragma unroll
            for (int q = 0; q < MQ; ++q) { float ps = 0.f;
#pragma unroll
                for (int j = 0; j < 8; ++j) { s[q][j] = __builtin_amdgcn_exp2f(s[q][j] - m[q]); ps += s[q][j]; }
                l[q] += ps;
                v4u pk; pk.x = cvt_pk(s[q][0], s[q][1]); pk.y = cvt_pk(s[q][2], s[q][3]); pk.z = cvt_pk(s[q][4], s[q][5]); pk.w = cvt_pk(s[q][6], s[q][7]);
                pb[q] = __builtin_bit_cast(bf16x8, pk); }
#pragma unroll
            for (int dt = 0; dt < 8; ++dt) { const bf16x8 vf = tr_pair(Vt + voff, dt * 32, dt * 32 + 16 * KSTR);
#pragma unroll
                for (int q = 0; q < MQ; ++q) o[q][dt] = __builtin_amdgcn_mfma_f32_16x16x32_bf16(vf, pb[q], o[q][dt], 0, 0, 0); }
            } else {
            bf16x8 pb[MQ];
#pragma unroll
            for (int q = 0; q < MQ; ++q) {
                float s[8];
                if (!is_band) {
#pragma unroll
                    for (int j = 0; j < 8; ++j) s[j] = st[q][j >> 2][j & 3] * SC_L2;
                } else if constexpr (VAR == 0) {
                    const int w0 = kpos0 + 4 * fq - qrow[q] + 128;
#pragma unroll
                    for (int j = 0; j < 8; ++j) { const float v = st[q][j >> 2][j & 3] * SC_L2; s[j] = ((unsigned)(w0 + 16 * (j >> 2) + (j & 3)) <= 256u) ? v : NEG; }
                } else {
                    const int c = cbase + 16 * q + fr; const int c0 = c - 8 < 0 ? 0 : (c - 8 > 48 ? 48 : c - 8);
                    const LAS float* bp = (const LAS float*)(lds + OFF_RPB) + (kr - r_w + 7) * 128 + 32 * hf + 4 * fq - c + 63; const int v0 = 32 * hf + 4 * fq - c0;
                    float bb[8];
#pragma unroll
                    for (int j = 0; j < 8; ++j) bb[j] = bp[16 * (j >> 2) + (j & 3)];
#pragma unroll
                    for (int j = 0; j < 8; ++j) { const float v = st[q][j >> 2][j & 3] * SC_L2 + bb[j]; s[j] = ((unsigned)(v0 + 16 * (j >> 2) + (j & 3)) < 16u) ? v : NEG; }
                }
                float mt = fmaxf(fmaxf(fmaxf(s[0], s[1]), fmaxf(s[2], s[3])), fmaxf(fmaxf(s[4], s[5]), fmaxf(s[6], s[7])));
                mt = fmaxf(mt, __shfl_xor(mt, 16)); mt = fmaxf(mt, __shfl_xor(mt, 32));
                if (__any(mt > m[q])) { const float mn = fmaxf(m[q], mt); const float alpha = __builtin_amdgcn_exp2f(m[q] - mn); m[q] = mn; l[q] *= alpha;
#pragma unroll
                    for (int dt = 0; dt < 8; ++dt) o[q][dt] *= alpha; }
                float ps = 0.f;
#pragma unroll
                for (int j = 0; j < 8; ++j) { s[j] = __builtin_amdgcn_exp2f(s[j] - m[q]); ps += s[j]; }
                l[q] += ps;
                v4u pk; pk.x = cvt_pk(s[0], s[1]); pk.y = cvt_pk(s[2], s[3]); pk.z = cvt_pk(s[4], s[5]); pk.w = cvt_pk(s[6], s[7]);
                pb[q] = __builtin_bit_cast(bf16x8, pk);
            }
#pragma unroll
            for (int dt = 0; dt < 8; ++dt) { const bf16x8 vf = tr_pair(Vt + voff, dt * 32, dt * 32 + 16 * KSTR);
#pragma unroll
                for (int q = 0; q < MQ; ++q) o[q][dt] = __builtin_amdgcn_mfma_f32_16x16x32_bf16(vf, pb[q], o[q][dt], 0, 0, 0); }
            }
        }
        if (t + 1 < NT) { *(LAS v4u*)(lds + bufn * 2 * TILE_B + soff) = ks_; *(LAS v4u*)(lds + bufn * 2 * TILE_B + TILE_B + soff) = vs_; }
        __syncthreads();
      }
    }
#undef MX_TILE_ROW
#pragma unroll
    for (int q = 0; q < MQ; ++q) { float lt = l[q]; lt += __shfl_xor(lt, 16); lt += __shfl_xor(lt, 32); const float inv = 1.f / lt;
        bf16* yp = Y + (size_t)qrow[q] * D + ycol[q] + 4 * fq;
#pragma unroll
        for (int dt = 0; dt < 8; ++dt) { v2u w2; w2.x = cvt_pk(o[q][dt][0] * inv, o[q][dt][1] * inv); w2.y = cvt_pk(o[q][dt][2] * inv, o[q][dt][3] * inv); *(GAS v2u*)(yp + 16 * dt) = w2; } }
}

__device__ __forceinline__ void sgu_unit(Frame& F, const bf16* P, bf16* Y, int chunk, int g, const float* lng, const float* Ws, const float* bs) {
    LAS unsigned char* lds = F.lds; const int lane = F.lane, w = F.wave, fr = lane & 15, fq = lane >> 4, tid = F.tid;
    const int row0 = chunk * 128;
    __syncthreads();
    { const int c8 = tid & 15; f32x4 g0 = *(const f32x4*)(lng + g * 128 + 8 * c8), g1 = *(const f32x4*)(lng + g * 128 + 8 * c8 + 4);
#pragma unroll
      for (int p = 0; p < 4; ++p) { const int j = 32 * p + (tid >> 4);
          const v4u raw = *(const v4u*)(P + (size_t)(row0 + j) * INW + 512 + g * 128 + 8 * c8); const unsigned rw[4] = {raw.x, raw.y, raw.z, raw.w};
          float v[8]; float s = 0.f;
#pragma unroll
          for (int q = 0; q < 4; ++q) { v[2 * q] = __uint_as_float(rw[q] << 16); v[2 * q + 1] = __uint_as_float(rw[q] & 0xffff0000u); s += v[2 * q] + v[2 * q + 1]; }
          s += __shfl_xor(s, 1); s += __shfl_xor(s, 2); s += __shfl_xor(s, 4); s += __shfl_xor(s, 8);
          const float mu = s * (1.f / 128.f); float qq = 0.f;
#pragma unroll
          for (int q = 0; q < 8; ++q) { v[q] -= mu; qq += v[q] * v[q]; }
          qq += __shfl_xor(qq, 1); qq += __shfl_xor(qq, 2); qq += __shfl_xor(qq, 4); qq += __shfl_xor(qq, 8);
          const float r = rsqrtf(qq * (1.f / 128.f) + EPS);
          v4u ov; ov.x = pk2(v[0] * r * g0.x, v[1] * r * g0.y); ov.y = pk2(v[2] * r * g0.z, v[3] * r * g0.w); ov.z = pk2(v[4] * r * g1.x, v[5] * r * g1.y); ov.w = pk2(v[6] * r * g1.z, v[7] * r * g1.w);
          *(LAS v4u*)(lds + OFF_VH + j * KSTR + 16 * c8) = ov; } }
    bf16x8 wf[4];
#pragma unroll
    for (int kk = 0; kk < 4; ++kk) { const float* wp = Ws + ((size_t)g * 128 + 16 * w + fr) * 128 + 32 * kk + 8 * fq; const f32x4 a = *(const f32x4*)wp, b = *(const f32x4*)(wp + 4);
        v4u pk; pk.x = pk2(a.x, a.y); pk.y = pk2(a.z, a.w); pk.z = pk2(b.x, b.y); pk.w = pk2(b.z, b.w); wf[kk] = __builtin_bit_cast(bf16x8, pk); }
    __syncthreads();
    const int voff = (8 * fq + (fr >> 2)) * KSTR + (fr & 3) * 8;
    f32x4 acc[8];
#pragma unroll
    for (int ct = 0; ct < 8; ++ct) { acc[ct] = (f32x4){0.f, 0.f, 0.f, 0.f};
#pragma unroll
        for (int kk = 0; kk < 4; ++kk) { const bf16x8 af = tr_pair(lds + OFF_VH + voff, kk * 32 * KSTR + ct * 32, kk * 32 * KSTR + 4 * KSTR + ct * 32);
            acc[ct] = __builtin_amdgcn_mfma_f32_16x16x32_bf16(af, wf[kk], acc[ct], 0, 0, 0); } }
    const int pos = row0 + 16 * w + fr; const float bias = bs[g * 128 + 16 * w + fr];
    v2u uq[8];
#pragma unroll
    for (int ct = 0; ct < 8; ++ct) uq[ct] = *(const v2u*)(P + (size_t)pos * INW + g * 128 + 16 * ct + 4 * fq);
#pragma unroll
    for (int ct = 0; ct < 8; ++ct) { const int col = g * 128 + 16 * ct + 4 * fq; const v2u uu = uq[ct];
        const float u0 = __uint_as_float(uu.x << 16), u1 = __uint_as_float(uu.x & 0xffff0000u), u2 = __uint_as_float(uu.y << 16), u3 = __uint_as_float(uu.y & 0xffff0000u);
        v2u ov; ov.x = cvt_pk(u0 * (acc[ct][0] + bias), u1 * (acc[ct][1] + bias)); ov.y = cvt_pk(u2 * (acc[ct][2] + bias), u3 * (acc[ct][3] + bias));
        *(GAS v2u*)(Y + (size_t)pos * D + col) = ov; }
}
}

template <int L> __device__ __forceinline__ void p_mixers(Frame& F, gu32* qhead) {
    const bf16* P = (const bf16*)(F.ws + WS_P); bf16* Y = (bf16*)(F.ws + WS_Y);
    const float* sink = F.in[14] + L * 6; const float* rpb = F.in[15] + L * 6 * 15 * 31;
    const float* lng = F.in[11] + L * 512; const float* Ws = F.in[12] + (size_t)L * 4 * 128 * 128; const float* bs = F.in[13] + L * 512;
    constexpr int N_NA = 192, N_WA = 128, N_CB = L == 0 ? 4 : 0, N_CC = L == 0 ? 6 : 0, N_SGU = (L == 0 ? 66 : 64) * 4;
    constexpr int NU = N_NA + N_WA + N_CB + N_CC + N_SGU;
    constexpr int CV_BASE = L == 0 ? QB_MX0 : QB_MX1, CV_N = L == 0 ? Q_MX0 : Q_MX1;
    volatile LAS int* tk = (volatile LAS int*)(F.MISC + 16);
    if (F.tid == 0) tk[0] = (int)__hip_atomic_fetch_add(qhead, 1u, RLX_AGENT);
    __syncthreads();
    int cur = tk[0];
    while (cur < NU) {
        unsigned nxt = 0u;
        if (F.tid == 0) nxt = __hip_atomic_fetch_add(qhead, 1u, RLX_AGENT);
        int u = cur;
        if (u < N_NA) { mx::attn_unit<1>(F, P, Y, u / 32, 4 * (u % 32), 1, sink, rpb); }
        else if ((u -= N_NA) < N_WA) { mx::attn_unit<0>(F, P, Y, 128 * (u >> 1), u & 1, 1, sink, rpb); }
        else if ((u -= N_WA) < N_CB) { mx::attn_unit<0>(F, P, Y, SEQ + 128 * (u >> 1), u & 1, 0, sink, rpb); }
        else if ((u -= N_CB) < N_CC) { mx::attn_unit<1>(F, P, Y, u, 0, 0, sink, rpb); }
        else { u -= N_CC; mx::sgu_unit(F, P, Y, u >> 2, u & 3, lng, Ws, bs); }
        __syncthreads();
        if (F.tid == 0) tk[0] = (int)nxt;
        __syncthreads();
        cur = tk[0];
    }
    { gu32* qcv = qhead + 256; LAS float* scr = (LAS float*)(F.lds + 32768 + F.wave * 8704);
      __syncthreads();
      if (F.tid == 0) tk[0] = (int)__hip_atomic_fetch_add(qcv, 1u, RLX_AGENT);
      __syncthreads();
      int cv = tk[0];
      while (cv < CV_N) {
          unsigned nx = 0u;
          if (F.tid == 0) nx = __hip_atomic_fetch_add(qcv, 1u, RLX_AGENT);
          conv_moved(F, scr, (CV_BASE + cv) * NWAVES + F.wave);
          __syncthreads();
          if (F.tid == 0) tk[0] = (int)nx;
          __syncthreads();
          cv = tk[0];
      } }
}

enum { PH_PRO = 0, PH_T0, PH_G1_0, PH_MX_0, PH_G2_0, PH_T2_0, PH_G3_0, PH_G4_0, PH_T3_0, PH_G1_1, PH_MX_1, PH_G2_1, PH_T2_1, PH_RT, PH_G3_1, PH_G4_1, PH_T3_1, NPH };
#ifndef MK_SPLIT
#define MK_SPLIT 0
#endif
struct Args { const float* in[22]; float* out; unsigned char* ws; int ph_lo, ph_hi, li, pad; };
__global__ void __launch_bounds__(NTHR, 2) mk_fwd(Args args) {
    extern __shared__ __attribute__((aligned(16))) unsigned char lds[];
    Frame F;
    F.lds = (LAS unsigned char*)lds; F.MISC = (volatile LAS unsigned*)(F.lds + MISC_OFF);
    F.tid = threadIdx.x; F.lane = F.tid & 63; F.wave = __builtin_amdgcn_readfirstlane(F.tid >> 6);
    F.G = gridDim.x; { const int bx = blockIdx.x; F.vcu = (F.G % 8 == 0) ? (bx % 8) * (F.G / 8) + bx / 8 : bx; }
    F.ws = args.ws; F.out = args.out; F.ctl = (gu32*)(args.ws + WS_CTL);
#pragma unroll
    for (int i = 0; i < 22; ++i) F.in[i] = args.in[i];
    for (int u = F.tid; u < (LDS_BYTES - LDSCTL_OFF) / 4; u += NTHR) ((LAS unsigned*)(F.lds + LDSCTL_OFF))[u] = 0u;
    __syncthreads();
    XcdBarrier bar; bar.bar = (unsigned*)(F.ctl + CW_BAR); bar.x = 0; bar.st = nullptr;
    if (!MK_SPLIT) bar = xcd_barrier_post((unsigned*)(F.ctl + CW_BAR), F.MISC + 8);
    const int lo = args.ph_lo, hi = args.ph_hi;
#define IN(k) (lo <= (k) && (k) < hi)
#define PH_BEGIN() do { int l_; asm volatile("v_mbcnt_lo_u32_b32 %0, -1, 0\n\tv_mbcnt_hi_u32_b32 %0, -1, %0" : "=v"(l_)); F.lane = l_; F.tid = F.wave * 64 + l_; } while (0)
#define SEAM(k) do { if (IN(k) && IN((k) + 1)) xcd_barrier(bar); } while (0)
    float* MOD = (float*)(F.ws + WS_MOD); bf16* H = (bf16*)(F.ws + WS_H); bf16* P = (bf16*)(F.ws + WS_P); bf16* Y = (bf16*)(F.ws + WS_Y); bf16* Y2 = (bf16*)(F.ws + WS_Y2); bf16* XB = (bf16*)(F.ws + WS_XB);
    bf16* PART = (bf16*)(F.ws + WS_PART); bf16* ACT = (bf16*)(F.ws + WS_ACT); unsigned char* HP = F.ws + WS_HP; float* Z = (float*)(F.ws + WS_Z);
    int* tok_e = (int*)(F.ws + WS_TOKE); float* tok_w = (float*)(F.ws + WS_TOKW); int* slot_of = (int*)(F.ws + WS_SLOT); int* pstart = (int*)(F.ws + WS_PSTART);
    const float* cosT = (const float*)(F.ws + WS_ROPE); const float* sinT = cosT + 4096;
    const pg8::bf16_t* Wt_in = (const pg8::bf16_t*)(F.ws + WS_WIN); const pg8::bf16_t* Wt_out = (const pg8::bf16_t*)(F.ws + WS_WOUT);
    PG8_LAS unsigned char* ring = (PG8_LAS unsigned char*)F.lds;

    PH_BEGIN(); if (IN(PH_PRO)) { p_prologue(F); } SEAM(PH_PRO);
    PH_BEGIN(); if (IN(PH_T0)) { p_prenorm0(F); } SEAM(PH_T0);
    PH_BEGIN(); if (IN(PH_G1_0)) { pg8::Gemm g{H, Wt_in, MROWS, INW, D, 0}; pg8::StaticOrder S; S.init(MROWS, INW, D / 64, F.G == 256 ? 200 : F.G, (int)blockIdx.x); pg8::EpiInProjRope E{P, INW, cosT, sinT, SEQ};
        pg8::TableOrder TS; TS.build(S, (volatile PG8_LAS int*)(F.MISC + 64)); pg8::gemm_phase<pg8::EpiInProjRope, pg8::TableOrder, true, true>(ring, g, TS, E); conv_queue(F, F.ctl + CW_QUEUE + 512, QB_G10, Q_G10); } SEAM(PH_G1_0);
    PH_BEGIN(); if (IN(PH_MX_0)) { p_mixers<0>(F, F.ctl + CW_QUEUE); } SEAM(PH_MX_0);
    PH_BEGIN(); if (IN(PH_G2_0)) { pg8::Gemm g{Y, Wt_out, MROWS, D, D, 0}; pg8::DenseSplitOrder S; S.init(D, D / 64, F.G, (int)blockIdx.x, 8); pg8::EpiB16 E{Y2, D, PART, (size_t)CTX * D, SEQ, 1.f};
        pg8::TableOrder TS; TS.build(S, (volatile PG8_LAS int*)(F.MISC + 64)); pg8::gemm_phase<pg8::EpiB16, pg8::TableOrder, true, true>(ring, g, TS, E); } SEAM(PH_G2_0);
    PH_BEGIN(); if (IN(PH_T2_0)) { p_post<true>(F, Y2, F.in[7], 2 * D, MOD, F.in[0], F.in[2], XB, MROWS, F.in[8], MOD, 3 * D, 4 * D, H, nullptr, tok_e, tok_w, PART, 7); } SEAM(PH_T2_0);
    PH_BEGIN(); if (IN(PH_G3_0)) { pg8::Gemm g{H, (const pg8::bf16_t*)(F.ws + WS_WGU), MROWS, 2 * FFN, D, 0}; pg8::StaticOrder S; S.init(MROWS, 2 * FFN, D / 64, F.G == 256 ? 232 : F.G, (int)blockIdx.x); pg8::EpiSwiGLU E{ACT, FFN};
        pg8::TableOrder TS; TS.build(S, (volatile PG8_LAS int*)(F.MISC + 64)); pg8::gemm_phase<pg8::EpiSwiGLU, pg8::TableOrder, true, true>(ring, g, TS, E); conv_queue(F, F.ctl + CW_QUEUE + 576, QB_G30, Q_G30); } SEAM(PH_G3_0);
    PH_BEGIN(); if (IN(PH_G4_0)) { pg8::Gemm g{ACT, (const pg8::bf16_t*)(F.ws + WS_WDN), MROWS, D, FFN, 0}; pg8::DenseSplitOrder S; S.init(D, FFN / 64, F.G, (int)blockIdx.x, 14); pg8::EpiB16 E{Y2, D, PART, (size_t)CTX * D, SEQ, 1.f};
        pg8::TableOrder TS; TS.build(S, (volatile PG8_LAS int*)(F.MISC + 64)); pg8::gemm_phase<pg8::EpiB16, pg8::TableOrder, true, true>(ring, g, TS, E); conv_queue(F, F.ctl + CW_QUEUE + 640, QB_G40, Q_G40); } SEAM(PH_G4_0);
    PH_BEGIN(); if (IN(PH_T3_0)) { p_post<false>(F, Y2, F.in[9], 5 * D, MOD, nullptr, nullptr, XB, MROWS, F.in[6] + D, MOD + 2 * 6 * D, 0 * D, 1 * D, H, nullptr, tok_e, tok_w, PART, 13); } SEAM(PH_T3_0);
    PH_BEGIN(); if (IN(PH_G1_1)) { pg8::Gemm g{H, Wt_in + (size_t)INW * D, MROWS, INW, D, 0}; pg8::InProjLastOrder S; S.init(F.G == 256 ? 200 : F.G, (int)blockIdx.x); pg8::EpiInProjRope E{P, INW, cosT, sinT, SEQ};
        pg8::TableOrder TS; TS.build(S, (volatile PG8_LAS int*)(F.MISC + 64)); pg8::gemm_phase<pg8::EpiInProjRope, pg8::TableOrder, true, true>(ring, g, TS, E); conv_queue(F, F.ctl + CW_QUEUE + 704, QB_G11, Q_G11); } SEAM(PH_G1_1);
    PH_BEGIN(); if (IN(PH_MX_1)) { p_mixers<1>(F, F.ctl + CW_QUEUE + 64); } SEAM(PH_MX_1);
    PH_BEGIN(); if (IN(PH_G2_1)) { pg8::Gemm g{Y, Wt_out + (size_t)D * D, SEQ, D, D, 0}; pg8::StaticOrder S; S.init(SEQ, D, D / 64, F.G, (int)blockIdx.x); pg8::EpiB16 E{Y2, D, PART, 0, 0, 1.f};
        pg8::TableOrder TS; TS.build(S, (volatile PG8_LAS int*)(F.MISC + 64)); pg8::gemm_phase<pg8::EpiB16, pg8::TableOrder, true, true>(ring, g, TS, E); } SEAM(PH_G2_1);
    PH_BEGIN(); if (IN(PH_T2_1)) { p_post<false>(F, Y2, F.in[7] + D, 2 * D, MOD + 2 * 6 * D, nullptr, nullptr, XB, SEQ, F.in[8] + D, MOD + 2 * 6 * D, 3 * D, 4 * D, H, F.in[19], tok_e, tok_w, PART, 0); } SEAM(PH_T2_1);
    PH_BEGIN(); if (IN(PH_RT)) { p_route(F); } SEAM(PH_RT);
    PH_BEGIN(); if (IN(PH_G3_1)) { pg8::Gemm g{HP, F.ws + WS_MGU, MAXSLOT, 2 * FFN, D, (size_t)2 * FFN * D}; pg8::GroupedOrder S; S.init(pstart, (volatile PG8_LAS int*)(F.MISC + 32), 2 * FFN, D / 128, F.G, (int)blockIdx.x);
        pg8::EpiSwiGLU8 E{(unsigned char*)ACT, FFN, 1.f / (S_H8 * S_WGU8), S_ACT8};
        pg8::TableOrder TS; TS.build(S, (volatile PG8_LAS int*)(F.MISC + 64)); pg8::gemm_phase<pg8::EpiSwiGLU8, pg8::TableOrder, true, true, 1>(ring, g, TS, E); } SEAM(PH_G3_1);
    PH_BEGIN(); if (IN(PH_G4_1)) { pg8::Gemm g{ACT, F.ws + WS_MDN, MAXSLOT, D, FFN, (size_t)D * FFN}; pg8::GroupedSplitOrder S; S.init(pstart, (volatile PG8_LAS int*)(F.MISC + 32), D, FFN / 128, F.G, (int)blockIdx.x);
        pg8::EpiB16 E{Y2, D, PART, (size_t)S.r * 256 * D, S.Pf * 256, 1.f / (S_ACT8 * S_WDN8)};
        pg8::TableOrder TS; TS.build(S, (volatile PG8_LAS int*)(F.MISC + 64)); pg8::gemm_phase<pg8::EpiB16, pg8::TableOrder, true, true, 1>(ring, g, TS, E); } SEAM(PH_G4_1);
    PH_BEGIN(); if (IN(PH_T3_1)) { p_combine(F, Y2, slot_of, tok_w, F.in[9] + D, MOD + 2 * 6 * D + 5 * D, XB, F.out, PART, pstart); }
#undef IN
#undef SEAM
}

extern "C" void kernel_launch(void* const* d_in, const int* in_sizes, int n_in, void* d_out, int out_size, void* d_ws, size_t ws_size, hipStream_t stream) {
    static int grid = 0;
    if (grid == 0) {
        if (n_in != 22 || out_size != SEQ * D || ws_size < WS_END) { fprintf(stderr, "kernel_launch: unexpected arguments (n_in %d, out %d, ws %zu < %zu); nothing launched\n", n_in, out_size, ws_size, (size_t)WS_END); grid = -1; return; }
        int dev = 0, cus = 0, per_cu = 0;
        if (hipGetDevice(&dev) != hipSuccess || hipDeviceGetAttribute(&cus, hipDeviceAttributeMultiprocessorCount, dev) != hipSuccess) { grid = -1; return; }
        if (hipFuncSetAttribute((const void*)mk_fwd, hipFuncAttributeMaxDynamicSharedMemorySize, LDS_BYTES) != hipSuccess) { fprintf(stderr, "kernel_launch: hipFuncSetAttribute failed\n"); grid = -1; return; }
        if (hipOccupancyMaxActiveBlocksPerMultiprocessor(&per_cu, (const void*)mk_fwd, NTHR, LDS_BYTES) != hipSuccess || per_cu < 1) { fprintf(stderr, "kernel_launch: occupancy query says %d blocks per CU\n", per_cu); }
        (void)hipGetLastError();
        grid = cus;
    }
    if (grid < 0) return;
    (void)hipMemsetAsync((char*)d_ws + WS_CTL, 0, CTL_ZERO_BYTES, stream);
    Args a{};
    for (int i = 0; i < 22; ++i) a.in[i] = (const float*)d_in[i];
    a.out = (float*)d_out; a.ws = (unsigned char*)d_ws; a.li = 0; a.pad = 0;
#if MK_SPLIT
    for (int p = 0; p < NPH; ++p) { a.ph_lo = p; a.ph_hi = p + 1; hipLaunchKernelGGL(mk_fwd, dim3(grid), dim3(NTHR), LDS_BYTES, stream, a); }
#else
    a.ph_lo = 0; a.ph_hi = NPH; hipLaunchKernelGGL(mk_fwd, dim3(grid), dim3(NTHR), LDS_BYTES, stream, a);
#endif
}
```
